# Optimizing an MI355X kernel written in HIP

```python
import jax, jax.numpy as jnp
from jax import lax
import numpy as np

D_MODEL = 1024
BATCH = 8
SEQ = 8192
DEPTH = 1
DEC_BATCH = 1
DEC_SEQ = 16384
PAST_LEN = 128

POOL_WIDTH = 256
POOL_WINDOWS = (2, 4, 8, 16)
N_POOL_GROUPS = 4
POOL_GROUP_DIM = POOL_WIDTH // N_POOL_GROUPS
N_HEADS = 6
QK_NOPE_DIM = 128
QK_ROPE_DIM = 64
QK_HEAD_DIM = QK_NOPE_DIM + QK_ROPE_DIM
V_HEAD_DIM = 128
ATTN_WIDTH = N_HEADS * V_HEAD_DIM
MIX_WIDTH = POOL_WIDTH + ATTN_WIDTH
Q_LORA_RANK = 384
KV_LORA_RANK = 256
IN_WIDTH = POOL_WIDTH + Q_LORA_RANK + KV_LORA_RANK + QK_ROPE_DIM
D_FF = -(-8 * D_MODEL // (3 * 256)) * 256
Q_BLOCK = 128
ROPE_THETA = 10000.0
EPS = 1e-6
N_MOD = 6

kernel_name = 'hybrid_pool_mla_sandwich_adaln_encoder'


def rms_norm(x, g):
    xf = x.astype(jnp.float32)
    y = xf * lax.rsqrt(jnp.mean(xf * xf, axis=-1, keepdims=True) + EPS)
    return (y * g.astype(jnp.float32)).astype(x.dtype)


def rope_tables(S):
    inv_freq = ROPE_THETA ** (-jnp.arange(0, QK_ROPE_DIM, 2, dtype=jnp.float32) / QK_ROPE_DIM)
    ang = jnp.arange(S, dtype=jnp.float32)[:, None] * inv_freq[None, :]
    return jnp.cos(ang), jnp.sin(ang)


def apply_rope(x, cos, sin):
    half = QK_ROPE_DIM // 2
    x1, x2 = x[..., :half], x[..., half:]
    cos = cos.astype(x.dtype)
    sin = sin.astype(x.dtype)
    return jnp.concatenate([x1 * cos - x2 * sin, x2 * cos + x1 * sin], axis=-1)


def multiscale_pool(u, pool_w, pool_scale):
    B, S, _ = u.shape
    ug = u.astype(jnp.float32).reshape(B, S, N_POOL_GROUPS, POOL_GROUP_DIM)
    cs = jnp.concatenate([jnp.zeros((B, 1, N_POOL_GROUPS, POOL_GROUP_DIM), jnp.float32),
                          jnp.cumsum(ug, axis=1)], axis=1)
    t = jnp.arange(S)[:, None]
    w = jnp.array(POOL_WINDOWS, dtype=jnp.int32)[None, :]
    lo = jnp.clip(t - w // 2, 0, S)
    hi = jnp.clip(t + w - w // 2, 0, S)
    gidx = jnp.arange(N_POOL_GROUPS)[None, :]
    win_sum = cs[:, hi, gidx] - cs[:, lo, gidx]
    count = (hi - lo).astype(jnp.float32)[None, :, :, None]
    pooled = win_sum / count - ug
    mixed = jnp.einsum('bsgc,gcd->bsgd', pooled.astype(u.dtype), pool_w)
    return mixed.reshape(B, S, POOL_WIDTH) * pool_scale


def mla_attention(cq, ckv, k_pe, g_q_a, w_uq, g_kv_a, w_ukv):
    B, S, _ = cq.shape
    cos, sin = rope_tables(S)
    q = (rms_norm(cq, g_q_a) @ w_uq).reshape(B, S, N_HEADS, QK_HEAD_DIM)
    kv = (rms_norm(ckv, g_kv_a) @ w_ukv).reshape(B, S, N_HEADS, QK_NOPE_DIM + V_HEAD_DIM)
    scale = QK_HEAD_DIM ** -0.5
    q_nope = q[..., :QK_NOPE_DIM] * scale
    q_pe = apply_rope(q[..., QK_NOPE_DIM:], cos[:, None, :], sin[:, None, :]) * scale
    k_nope = kv[..., :QK_NOPE_DIM]
    v = kv[..., QK_NOPE_DIM:]
    k_rot = apply_rope(k_pe, cos, sin)
    nb = S // Q_BLOCK
    qn_b = q_nope.reshape(B, nb, Q_BLOCK, N_HEADS, QK_NOPE_DIM).transpose(1, 0, 2, 3, 4)
    qr_b = q_pe.reshape(B, nb, Q_BLOCK, N_HEADS, QK_ROPE_DIM).transpose(1, 0, 2, 3, 4)

    def block(args):
        qn, qr = args
        s = (jnp.einsum('bqhd,bkhd->bhqk', qn, k_nope)
             + jnp.einsum('bqhr,bkr->bhqk', qr, k_rot)).astype(jnp.float32)
        p = jax.nn.softmax(s, axis=-1).astype(v.dtype)
        return jnp.einsum('bhqk,bkhd->bqhd', p, v)

    o = lax.map(block, (qn_b, qr_b))
    return o.transpose(1, 0, 2, 3, 4).reshape(B, S, ATTN_WIDTH)


def encoder_layer(x, c, w_ada, b_ada, g_mix_pre, g_mix_post, w_in, pool_w, pool_scale,
                  g_q_a, w_uq, g_kv_a, w_ukv, g_pool_out, g_attn_out, w_out,
                  g_ffn_pre, g_ffn_post, w_gate, w_up, w_down):
    B, S, D = x.shape
    mod = (jax.nn.silu(c) @ w_ada + b_ada).reshape(B, N_MOD, 1, D)
    shift1, scale1, gate1 = mod[:, 0], mod[:, 1], mod[:, 2]
    shift2, scale2, gate2 = mod[:, 3], mod[:, 4], mod[:, 5]

    h = rms_norm(x, g_mix_pre) * (1 + scale1) + shift1
    z = h @ w_in
    u, cq, ckv, k_pe = jnp.split(
        z, [POOL_WIDTH, POOL_WIDTH + Q_LORA_RANK, POOL_WIDTH + Q_LORA_RANK + KV_LORA_RANK], axis=-1)
    pool_out = multiscale_pool(u, pool_w, pool_scale)
    attn_out = mla_attention(cq, ckv, k_pe, g_q_a, w_uq, g_kv_a, w_ukv)
    merged = jnp.concatenate([rms_norm(pool_out, g_pool_out),
                              rms_norm(attn_out, g_attn_out)], axis=-1) @ w_out
    x = x + gate1 * rms_norm(merged, g_mix_post)

    h = rms_norm(x, g_ffn_pre) * (1 + scale2) + shift2
    f = (jax.nn.silu(h @ w_gate) * (h @ w_up)) @ w_down
    return x + gate2 * rms_norm(f, g_ffn_post)


def setup_inputs(seed: int = 0) -> dict:
    key = jax.random.key(seed)
    ks = jax.random.split(key, 32)
    f32 = jnp.float32
    L = DEPTH

    def nrm(k, shape, scale):
        return jax.random.normal(k, shape, f32) * scale

    def gain(k, n):
        return 1.0 + 0.05 * jax.random.normal(k, (L, n), f32)

    return {
        'x_prompt': nrm(ks[0], (BATCH, SEQ, D_MODEL), 1.0),
        'x_sample': nrm(ks[1], (DEC_BATCH, DEC_SEQ, D_MODEL), 1.0),
        'c_prompt': nrm(ks[2], (BATCH, D_MODEL), 1.0),
        'c_sample': nrm(ks[3], (DEC_BATCH, D_MODEL), 1.0),
        'w_ada': nrm(ks[4], (L, D_MODEL, N_MOD * D_MODEL), D_MODEL ** -0.5),
        'b_ada': nrm(ks[5], (L, N_MOD * D_MODEL), 0.1),
        'g_mix_pre': gain(ks[6], D_MODEL),
        'g_mix_post': gain(ks[7], D_MODEL),
        'w_in': nrm(ks[8], (L, D_MODEL, IN_WIDTH), D_MODEL ** -0.5),
        'pool_w': nrm(ks[9], (L, N_POOL_GROUPS, POOL_GROUP_DIM, POOL_GROUP_DIM), POOL_GROUP_DIM ** -0.5),
        'pool_scale': gain(ks[10], POOL_WIDTH),
        'g_q_a': gain(ks[11], Q_LORA_RANK),
        'w_uq': nrm(ks[12], (L, Q_LORA_RANK, N_HEADS * QK_HEAD_DIM), Q_LORA_RANK ** -0.5),
        'g_kv_a': gain(ks[13], KV_LORA_RANK),
        'w_ukv': nrm(ks[14], (L, KV_LORA_RANK, N_HEADS * (QK_NOPE_DIM + V_HEAD_DIM)), KV_LORA_RANK ** -0.5),
        'g_pool_out': gain(ks[15], POOL_WIDTH),
        'g_attn_out': gain(ks[16], ATTN_WIDTH),
        'w_out': nrm(ks[17], (L, MIX_WIDTH, D_MODEL), MIX_WIDTH ** -0.5),
        'g_ffn_pre': gain(ks[18], D_MODEL),
        'g_ffn_post': gain(ks[19], D_MODEL),
        'w_gate': nrm(ks[20], (L, D_MODEL, D_FF), D_MODEL ** -0.5),
        'w_up': nrm(ks[21], (L, D_MODEL, D_FF), D_MODEL ** -0.5),
        'w_down': nrm(ks[22], (L, D_FF, D_MODEL), D_FF ** -0.5),
    }


def reference(x_prompt, x_sample, c_prompt, c_sample, w_ada, b_ada, g_mix_pre, g_mix_post,
              w_in, pool_w, pool_scale, g_q_a, w_uq, g_kv_a, w_ukv, g_pool_out, g_attn_out,
              w_out, g_ffn_pre, g_ffn_post, w_gate, w_up, w_down):
    def run(x, c):
        for l in range(DEPTH):
            x = encoder_layer(x, c, w_ada[l], b_ada[l], g_mix_pre[l], g_mix_post[l], w_in[l],
                              pool_w[l], pool_scale[l], g_q_a[l], w_uq[l], g_kv_a[l], w_ukv[l],
                              g_pool_out[l], g_attn_out[l], w_out[l], g_ffn_pre[l], g_ffn_post[l],
                              w_gate[l], w_up[l], w_down[l])
        return x

    y_prompt = run(x_prompt, c_prompt)
    y_sample = run(x_sample, c_sample)
    return (y_prompt, y_sample)
```

```cpp
#include <hip/hip_runtime.h>
#include <hip/hip_cooperative_groups.h>
#include <cstdio>
#include <cstdint>
namespace cg = cooperative_groups;

#ifndef MK_PER_PHASE
#define MK_PER_PHASE 0
#endif

constexpr int DM = 1024, T_P = 65536, T_S = 16384, TT = T_P + T_S, SEQ_P = 8192, SEQ_S = 16384, NBATCH = 9;
constexpr int NH = 6, DQK = 192, DNOPE = 128, DROPE = 64, DV = 128, QLR = 384, KVLR = 256, DFF = 2816, POOLW = 256;
constexpr int LDQ_ = NH * DQK  , LDKV_ = NH * DNOPE  ;
constexpr float EPS = 1e-6f;
constexpr float QSCALE = 0.07216878364870322f * 1.4426950408889634f;

namespace pg8 {
#define PG8_LAS __attribute__((address_space(3)))
typedef unsigned short bf16_t;
typedef short bf16x8 __attribute__((ext_vector_type(8)));
typedef float f32x4 __attribute__((ext_vector_type(4)));
typedef unsigned u32x4 __attribute__((ext_vector_type(4)));
constexpr int BM = 256, BK = 64, HALF = 128, HTB = HALF * BK * 2  , STAGE_BYTES = 8 * HTB, NXCD = 8, WGM = 8;

__host__ __device__ __forceinline__ int lds_byte(int r, int c) { const int st = (r >> 4) * 2 + (c >> 5), rr = r & 15, cc = c & 31, ob = rr * 64 + cc * 2; return st * 1024 + (ob ^ (((ob >> 9) & 1) << 5)); }
__host__ __device__ __forceinline__ void stage_rc(int b, int& R, int& C) { const int st = b / 1024, sb = b % 1024, swz = sb ^ (((sb >> 9) & 1) << 5); R = (st >> 1) * 16 + swz / 64; C = (st & 1) * 32 + (swz % 64) / 2; }
__host__ __device__ __forceinline__ int perm32(int rho) { const int n = rho >> 4, i = rho & 15; return 8 * (i >> 2) + 4 * n + (i & 3); }

struct Unit { int pm, pn; };
struct Gemm { const bf16_t* A; const bf16_t* Bt; int M, N, K; };

struct StaticOrder {
    int nM, nN, nwg, G, c;
    __host__ __device__ void init(int M, int N, int G_, int c_) { nM = M / BM; nN = N / BM; nwg = nM * nN; G = G_; c = c_; }
    __host__ __device__ bool next(int i, Unit& u) const {
        const long L = (long)i * G + c; if (L >= nwg) return false;
        int wgid = (int)L; { const int q = nwg / NXCD, r = nwg % NXCD, xcd = wgid % NXCD, off = wgid / NXCD; wgid = (xcd < r ? xcd * (q + 1) : r * (q + 1) + (xcd - r) * q) + off; }
        const int nig = WGM * nN, gid = wgid / nig, fm = gid * WGM, gsz = (nM - fm) < WGM ? (nM - fm) : WGM;
        u.pm = fm + ((wgid % nig) % gsz); u.pn = (wgid % nig) / gsz; return true;
    }
    __device__ __forceinline__ void a_ready(const Unit&) const {}
    __device__ __forceinline__ void done(const Unit&) const {}
};


__device__ __forceinline__ unsigned cvt_pk_bf16(float lo, float hi) { unsigned r; asm volatile("v_cvt_pk_bf16_f32 %0, %1, %2" : "=v"(r) : "v"(lo), "v"(hi)); return r; }
typedef unsigned u32x2 __attribute__((ext_vector_type(2)));
__device__ __forceinline__ void st4(bf16_t* p, f32x4 v) { u32x2 w; w.x = cvt_pk_bf16(v[0], v[1]); w.y = cvt_pk_bf16(v[2], v[3]); *(u32x2*)p = w; }
__device__ __forceinline__ float sq4(f32x4 v) { return (v[0] * v[0] + v[1] * v[1]) + (v[2] * v[2] + v[3] * v[3]); }
__device__ __forceinline__ void row_ss_add(float* ss, int row, float s, int fq) { s += __shfl_xor(s, 16); s += __shfl_xor(s, 32); if (fq == 0) atomicAdd(ss + row, s); }
__device__ __forceinline__ int seq_pos(int row) { return row < T_P ? (row & (SEQ_P - 1)) : (row - T_P); }
#define PG8_ROWS_BEGIN _Pragma("unroll") for (int ai = 0; ai < 2; ++ai) _Pragma("unroll") for (int m = 0; m < 4; ++m) { const int row = u.pm * BM + ai * HALF + wr * 64 + m * 16 + fr + zo_;
#define PG8_ROWS_END asm volatile("" ::: "memory"); }

struct EpiZ {
    static constexpr bool PERM = false, AFTER_DRAIN = false;
    bf16_t *U, *CQ, *CKV, *KR; float *ssq, *sskv; const float* rope;
    __device__ __forceinline__ void operator()(const f32x4 (&acc)[2][2][4][2], const Unit& u, int wr, int wc, int fr_in, int fq_in) const {
        int zo_ = 0, fr = fr_in, fq = fq_in; asm volatile("" : "+v"(zo_), "+v"(fr), "+v"(fq));
#pragma unroll
        for (int bj = 0; bj < 2; ++bj) {
            const int cc = u.pn * 8 + bj * 4 + wc;
            if (cc < 8) {
                PG8_ROWS_BEGIN
                    bf16_t* p = U + (size_t)row * POOLW + cc * 32 + 4 * fq; st4(p, acc[ai][bj][m][0]); st4(p + 16, acc[ai][bj][m][1]);
                PG8_ROWS_END
            } else if (cc < 20) {
                PG8_ROWS_BEGIN
                    bf16_t* p = CQ + (size_t)row * QLR + (cc - 8) * 32 + 4 * fq; st4(p, acc[ai][bj][m][0]); st4(p + 16, acc[ai][bj][m][1]);
                    row_ss_add(ssq, row, sq4(acc[ai][bj][m][0]) + sq4(acc[ai][bj][m][1]), fq);
                PG8_ROWS_END
            } else if (cc < 28) {
                PG8_ROWS_BEGIN
                    bf16_t* p = CKV + (size_t)row * KVLR + (cc - 20) * 32 + 4 * fq; st4(p, acc[ai][bj][m][0]); st4(p + 16, acc[ai][bj][m][1]);
                    row_ss_add(sskv, row, sq4(acc[ai][bj][m][0]) + sq4(acc[ai][bj][m][1]), fq);
                PG8_ROWS_END
            } else if (cc < 30) {
                const int i0 = 16 * (cc - 28) + 4 * fq;
                PG8_ROWS_BEGIN
                    const float* rp = rope + ((size_t)seq_pos(row) * 32 + i0) * 2;
                    const f32x4 cs0 = *(const f32x4*)rp, cs1 = *(const f32x4*)(rp + 4);
                    const f32x4 x1 = acc[ai][bj][m][0], x2 = acc[ai][bj][m][1];
                    const f32x4 c = {cs0[0], cs0[2], cs1[0], cs1[2]}, s = {cs0[1], cs0[3], cs1[1], cs1[3]};
                    bf16_t* p = KR + (size_t)row * DROPE + i0; st4(p, x1 * c - x2 * s); st4(p + 32, x2 * c + x1 * s);
                PG8_ROWS_END
            }
        }
    }
};
struct EpiQ {
    static constexpr bool PERM = false, AFTER_DRAIN = false;
    bf16_t* Q; const float* ssq; const float* rope;
    __device__ __forceinline__ void operator()(const f32x4 (&acc)[2][2][4][2], const Unit& u, int wr, int wc, int fr_in, int fq_in) const {
        int zo_ = 0, fr = fr_in, fq = fq_in; asm volatile("" : "+v"(zo_), "+v"(fr), "+v"(fq));
#pragma unroll
        for (int bj = 0; bj < 2; ++bj) {
            const int cc = u.pn * 8 + bj * 4 + wc;
            if (cc >= 36) continue;
            const int h = cc / 6, j6 = cc - 6 * h;
            if (j6 < 4) {
                PG8_ROWS_BEGIN
                    const float rq = QSCALE / sqrtf(ssq[row] * (1.0f / QLR) + EPS);
                    bf16_t* p = Q + (size_t)row * LDQ_ + h * DQK + j6 * 32 + 4 * fq; st4(p, acc[ai][bj][m][0] * rq); st4(p + 16, acc[ai][bj][m][1] * rq);
                PG8_ROWS_END
            } else {
                const int i0 = 16 * (j6 - 4) + 4 * fq;
                PG8_ROWS_BEGIN
                    const float rq = QSCALE / sqrtf(ssq[row] * (1.0f / QLR) + EPS);
                    const float* rp = rope + ((size_t)seq_pos(row) * 32 + i0) * 2;
                    const f32x4 cs0 = *(const f32x4*)rp, cs1 = *(const f32x4*)(rp + 4);
                    const f32x4 x1 = acc[ai][bj][m][0] * rq, x2 = acc[ai][bj][m][1] * rq;
                    const f32x4 c = {cs0[0], cs0[2], cs1[0], cs1[2]}, s = {cs0[1], cs0[3], cs1[1], cs1[3]};
                    bf16_t* p = Q + (size_t)row * LDQ_ + h * DQK + DNOPE + i0; st4(p, x1 * c - x2 * s); st4(p + 32, x2 * c + x1 * s);
                PG8_ROWS_END
            }
        }
    }
};
struct EpiKV {
    static constexpr bool PERM = false, AFTER_DRAIN = false;
    bf16_t *KN, *V; const float* sskv;
    __device__ __forceinline__ void operator()(const f32x4 (&acc)[2][2][4][2], const Unit& u, int wr, int wc, int fr_in, int fq_in) const {
        int zo_ = 0, fr = fr_in, fq = fq_in; asm volatile("" : "+v"(zo_), "+v"(fr), "+v"(fq));
        PG8_ROWS_BEGIN
            const float rk = 1.0f / sqrtf(sskv[row] * (1.0f / KVLR) + EPS);
            const size_t o = (size_t)row * LDKV_ + u.pn * DNOPE + wc * 32 + 4 * fq;
            st4(KN + o, acc[ai][0][m][0] * rk); st4(KN + o + 16, acc[ai][0][m][1] * rk);
            st4(V + o, acc[ai][1][m][0] * rk); st4(V + o + 16, acc[ai][1][m][1] * rk);
        PG8_ROWS_END
    }
};
struct EpiRowScaleSS {
    static constexpr bool PERM = false, AFTER_DRAIN = false;
    bf16_t* O; const float* rs; float rs_div; float* ss;
    __device__ __forceinline__ void operator()(const f32x4 (&acc)[2][2][4][2], const Unit& u, int wr, int wc, int fr_in, int fq_in) const {
        int zo_ = 0, fr = fr_in, fq = fq_in; asm volatile("" : "+v"(zo_), "+v"(fr), "+v"(fq));
        PG8_ROWS_BEGIN
            const float r = rs ? 1.0f / sqrtf(rs[row] * rs_div + EPS) : 1.0f;
            float s = 0.f;
#pragma unroll
            for (int bj = 0; bj < 2; ++bj) {
                const f32x4 v0 = acc[ai][bj][m][0] * r, v1 = acc[ai][bj][m][1] * r;
                bf16_t* p = O + (size_t)row * DM + u.pn * BM + bj * HALF + wc * 32 + 4 * fq; st4(p, v0); st4(p + 16, v1);
                s += sq4(v0) + sq4(v1);
            }
            row_ss_add(ss, row, s, fq);
        PG8_ROWS_END
    }
};
struct EpiGU {
    static constexpr bool PERM = false, AFTER_DRAIN = false;
    bf16_t* ACT;
    __device__ __forceinline__ void operator()(const f32x4 (&acc)[2][2][4][2], const Unit& u, int wr, int wc, int fr_in, int fq_in) const {
        int zo_ = 0, fr = fr_in, fq = fq_in; asm volatile("" : "+v"(zo_), "+v"(fr), "+v"(fq));
        PG8_ROWS_BEGIN
#pragma unroll
            for (int bj = 0; bj < 2; ++bj) {
                const int cc = u.pn * 8 + bj * 4 + wc;
                const f32x4 g = acc[ai][bj][m][0], up = acc[ai][bj][m][1]; f32x4 o;
#pragma unroll
                for (int j = 0; j < 4; ++j) o[j] = g[j] * __builtin_amdgcn_rcpf(1.0f + __builtin_amdgcn_exp2f(-1.4426950408889634f * g[j])) * up[j];
                st4(ACT + (size_t)row * DFF + cc * 16 + 4 * fq, o);
            }
        PG8_ROWS_END
    }
};
#undef PG8_ROWS_BEGIN
#undef PG8_ROWS_END

template <class Epi, class Sched, bool ALIGN_EPI = false, bool SP2 = false>
__device__ __forceinline__ void gemm_phase(PG8_LAS unsigned char* lds, const Gemm g, const Sched& S, const Epi& E) {
    const int tid = threadIdx.x, wid = __builtin_amdgcn_readfirstlane(tid >> 6), lane = tid & 63, wr = wid >> 2, wc = wid & 3, fr = lane & 15, fq = lane >> 4;
    const int K = g.K, nt = K / BK;
    unsigned voffA[2], voffB[2];
#pragma unroll
    for (int i = 0; i < 2; ++i) { int R, C; stage_rc(tid * 16 + i * 8192, R, C); const int Rb = Epi::PERM ? ((R & ~31) + perm32(R & 31)) : R;
        voffA[i] = (unsigned)(R * K + C) * 2u; voffB[i] = (unsigned)(Rb * K + C) * 2u; }
    const size_t kstep = (size_t)(BK * 2);
    const size_t hstep = (size_t)HALF * K * 2;
    const size_t tstep = 2 * hstep;
    const unsigned ldsw = (unsigned)wid * 1024u;
    const int aoff = lds_byte(wr * 64 + fr, fq * 8), boff = lds_byte(wc * 32 + fr, fq * 8);
#define PG8_SA(b, h) (((b) * 2 + (h)) * HTB)
#define PG8_SB(b, h) ((4 + (b) * 2 + (h)) * HTB)
#define PG8_STAGE(bufoff, gbase, voff) do { _Pragma("unroll") for (int _i = 0; _i < 2; ++_i) \
        __builtin_amdgcn_global_load_lds((const unsigned*)((const char*)(gbase) + (voff)[_i]), (PG8_LAS unsigned*)(lds + (bufoff) + ldsw + _i * 8192), 16, 0, 0); } while (0)
#define PG8_LDA(dst, b, h) do { _Pragma("unroll") for (int m = 0; m < 4; ++m) _Pragma("unroll") for (int k = 0; k < 2; ++k) dst[m][k] = *(const PG8_LAS bf16x8*)(lds + PG8_SA(b, h) + aoff + m * 2048 + k * 1024); } while (0)
#define PG8_LDB(dst, b, h) do { _Pragma("unroll") for (int n = 0; n < 2; ++n) _Pragma("unroll") for (int k = 0; k < 2; ++k) dst[n][k] = *(const PG8_LAS bf16x8*)(lds + PG8_SB(b, h) + boff + n * 2048 + k * 1024); } while (0)
#define PG8_MMA(ai, bj, At, Bt) do { __builtin_amdgcn_s_setprio(1); _Pragma("unroll") for (int m = 0; m < 4; ++m) _Pragma("unroll") for (int n = 0; n < 2; ++n) _Pragma("unroll") for (int k = 0; k < 2; ++k) \
        acc[ai][bj][m][n] = __builtin_amdgcn_mfma_f32_16x16x32_bf16(Bt[n][k], At[m][k], acc[ai][bj][m][n], 0, 0, 0); __builtin_amdgcn_s_setprio(0); } while (0)
#define PG8_WAIT_V(n) asm volatile("s_waitcnt vmcnt(" #n ")" ::: "memory")
#define PG8_WAIT_L(n) asm volatile("s_waitcnt lgkmcnt(" #n ")" ::: "memory")
#define PG8_BAR __builtin_amdgcn_s_barrier()
#define PG8_SCHED __builtin_amdgcn_sched_barrier(0)
    Unit cur, nxt; int ui = 0;
    if (!S.next(0, cur)) return;
    f32x4 acc[2][2][4][2];
#pragma unroll
    for (int a = 0; a < 2; ++a)
#pragma unroll
        for (int b = 0; b < 2; ++b)
#pragma unroll
            for (int m = 0; m < 4; ++m)
#pragma unroll
                for (int n = 0; n < 2; ++n) acc[a][b][m][n] = (f32x4){0.f, 0.f, 0.f, 0.f};
    bf16x8 At[4][2], B0[2][2], B1[2][2];
    const char* cA = (const char*)g.A + (size_t)cur.pm * tstep; const char* cB = (const char*)g.Bt + (size_t)cur.pn * tstep;
    S.a_ready(cur);
    if constexpr (SP2) {
        PG8_STAGE(PG8_SB(0, 0), cB, voffB); PG8_STAGE(PG8_SB(0, 1), cB + hstep, voffB); PG8_STAGE(PG8_SA(0, 0), cA, voffA); PG8_STAGE(PG8_SA(0, 1), cA + hstep, voffA);
        if (wr == 1) PG8_BAR;
        PG8_WAIT_V(2); PG8_BAR;
        PG8_STAGE(PG8_SB(1, 0), cB + kstep, voffB); PG8_STAGE(PG8_SA(1, 0), cA + kstep, voffA); PG8_STAGE(PG8_SB(1, 1), cB + hstep + kstep, voffB);
        PG8_WAIT_V(6); PG8_BAR;
    } else {
        PG8_STAGE(PG8_SB(0, 0), cB, voffB); PG8_STAGE(PG8_SA(0, 0), cA, voffA); PG8_STAGE(PG8_SB(0, 1), cB + hstep, voffB); PG8_STAGE(PG8_SA(0, 1), cA + hstep, voffA);
        if (wr == 1) PG8_BAR;
        PG8_WAIT_V(4); PG8_BAR;
        PG8_STAGE(PG8_SB(1, 0), cB + kstep, voffB); PG8_STAGE(PG8_SA(1, 0), cA + kstep, voffA); PG8_STAGE(PG8_SB(1, 1), cB + hstep + kstep, voffB);
        PG8_WAIT_V(6); PG8_BAR;
    }
    for (;;) {
        const bool has_next = S.next(ui + 1, nxt);
        const char* nA = has_next ? (const char*)g.A + (size_t)nxt.pm * tstep : cA; const char* nB = has_next ? (const char*)g.Bt + (size_t)nxt.pn * tstep : cB;
#pragma unroll 1
        for (int t = 0; t < nt; t += 2) {
            const bool last = (t == nt - 2);
            const char* a1 = cA + (size_t)(t + 1) * kstep;
            const char* a2 = last ? nA : cA + (size_t)(t + 2) * kstep; const char* b2 = last ? nB : cB + (size_t)(t + 2) * kstep;
            const char* a3 = a2 + kstep; const char* b3 = b2 + kstep;
            if (last && has_next) S.a_ready(nxt);
            if constexpr (SP2) {
            PG8_LDB(B0, 0, 0); PG8_LDB(B1, 0, 1); PG8_SCHED; PG8_LDA(At, 0, 0); PG8_STAGE(PG8_SA(1, 1), a1 + hstep, voffA);
            PG8_WAIT_V(8); PG8_WAIT_L(0); PG8_BAR; PG8_MMA(0, 0, At, B0); PG8_MMA(0, 1, At, B1); PG8_BAR; PG8_SCHED;
            PG8_LDA(At, 0, 1); PG8_STAGE(PG8_SB(0, 0), b2, voffB); PG8_STAGE(PG8_SB(0, 1), b2 + hstep, voffB); PG8_STAGE(PG8_SA(0, 0), a2, voffA);
            PG8_WAIT_V(8); PG8_WAIT_L(0); PG8_BAR; PG8_MMA(1, 0, At, B0); PG8_MMA(1, 1, At, B1); PG8_BAR; PG8_SCHED;
            PG8_LDB(B0, 1, 0); PG8_LDB(B1, 1, 1); PG8_SCHED; PG8_LDA(At, 1, 0); PG8_STAGE(PG8_SA(0, 1), a2 + hstep, voffA);
            PG8_WAIT_V(8); PG8_WAIT_L(0); PG8_BAR; PG8_MMA(0, 0, At, B0); PG8_MMA(0, 1, At, B1); PG8_BAR; PG8_SCHED;
            PG8_LDA(At, 1, 1); PG8_STAGE(PG8_SB(1, 0), b3, voffB); PG8_STAGE(PG8_SB(1, 1), b3 + hstep, voffB); PG8_STAGE(PG8_SA(1, 0), a3, voffA);
            PG8_WAIT_V(8); PG8_WAIT_L(0); PG8_BAR; PG8_MMA(1, 0, At, B0); PG8_MMA(1, 1, At, B1); PG8_BAR; PG8_SCHED;
            } else {
            PG8_LDB(B0, 0, 0); PG8_SCHED; PG8_LDA(At, 0, 0); PG8_STAGE(PG8_SA(1, 1), a1 + hstep, voffA);
            PG8_WAIT_L(8); PG8_BAR; PG8_WAIT_L(0); PG8_MMA(0, 0, At, B0); PG8_BAR; PG8_SCHED;
            PG8_LDB(B1, 0, 1); PG8_STAGE(PG8_SB(0, 0), b2, voffB);
            PG8_BAR; PG8_WAIT_L(0); PG8_MMA(0, 1, At, B1); PG8_BAR;
            PG8_LDA(At, 0, 1); PG8_STAGE(PG8_SA(0, 0), a2, voffA);
            PG8_BAR; PG8_WAIT_L(0); PG8_MMA(1, 0, At, B0); PG8_BAR; PG8_SCHED;
            PG8_STAGE(PG8_SB(0, 1), b2 + hstep, voffB);
            PG8_WAIT_V(6); PG8_BAR; PG8_MMA(1, 1, At, B1); PG8_BAR;
            PG8_LDB(B0, 1, 0); PG8_SCHED; PG8_LDA(At, 1, 0); PG8_STAGE(PG8_SA(0, 1), a2 + hstep, voffA);
            PG8_WAIT_L(8); PG8_BAR; PG8_WAIT_L(0); PG8_MMA(0, 0, At, B0); PG8_BAR; PG8_SCHED;
            PG8_LDB(B1, 1, 1); PG8_STAGE(PG8_SB(1, 0), b3, voffB);
            PG8_BAR; PG8_WAIT_L(0); PG8_MMA(0, 1, At, B1); PG8_BAR;
            PG8_LDA(At, 1, 1); PG8_STAGE(PG8_SA(1, 0), a3, voffA);
            PG8_BAR; PG8_WAIT_L(0); PG8_MMA(1, 0, At, B0); PG8_BAR; PG8_SCHED;
            PG8_STAGE(PG8_SB(1, 1), b3 + hstep, voffB);
            PG8_WAIT_V(6); PG8_BAR; PG8_MMA(1, 1, At, B1); PG8_BAR;
            }
        }
        if constexpr (ALIGN_EPI) { if (wr == 0) PG8_BAR; }
        if constexpr (!Epi::AFTER_DRAIN) { E(acc, cur, wr, wc, fr, fq); S.done(cur); }
        if (!has_next) break;
#pragma unroll
        for (int a = 0; a < 2; ++a)
#pragma unroll
            for (int b = 0; b < 2; ++b)
#pragma unroll
                for (int m = 0; m < 4; ++m)
#pragma unroll
                    for (int n = 0; n < 2; ++n) acc[a][b][m][n] = (f32x4){0.f, 0.f, 0.f, 0.f};
        cur = nxt; cA = nA; cB = nB; ++ui;
        if constexpr (ALIGN_EPI) { if (wr == 1) PG8_BAR; }
    }
    PG8_WAIT_V(0);
    if constexpr (!ALIGN_EPI) { if (wr == 0) PG8_BAR; }
    PG8_BAR;
    if constexpr (Epi::AFTER_DRAIN) { E.fused(acc, cur, wr, wc, fr, fq, lds, wid, lane); S.done(cur); }
#undef PG8_SA
#undef PG8_SB
#undef PG8_STAGE
#undef PG8_LDA
#undef PG8_LDB
#undef PG8_MMA
#undef PG8_WAIT_V
#undef PG8_WAIT_L
#undef PG8_BAR
#undef PG8_SCHED
}
}

namespace att {
using bf16x8 = __attribute__((ext_vector_type(8))) short;
using s16x4  = __attribute__((ext_vector_type(4))) short;
using f32x16 = __attribute__((ext_vector_type(16))) float;
using u32x4  = __attribute__((ext_vector_type(4))) unsigned;
typedef unsigned short bf16_t;
constexpr int NW = 8, QBLK = 32, KVBLK = 64;
constexpr int LDQ = LDQ_, LDKN = LDKV_, LDKR = DROPE, LDV = LDKV_, LDO = DM;
constexpr int SHM_V = 16384, SHM_KN = 16384, SHM_KR = 8192;
constexpr int OFF_V = 0, OFF_KN = 2 * SHM_V, OFF_KR = OFF_KN + 2 * SHM_KN, OFF_WS = OFF_KR + 2 * SHM_KR, ATTN_LDS = OFF_WS + NW * 64 * 4;
constexpr float THRL = 11.5f;
#define KSWZ(row, colB) ((row) * 256 + ((colB) ^ (((row) & 15) << 4)))
#define KRSWZ(row, colB) ((row) * 128 + ((colB) ^ ((((row) >> 1) & 7) << 4)))
#define SBAR() __builtin_amdgcn_sched_barrier(0)
__device__ __forceinline__ int crow(int r, int hi) { return (r & 3) + 8 * (r >> 2) + 4 * hi; }
__device__ __forceinline__ unsigned cvtpk(float lo, float hi) { unsigned r; asm volatile("v_cvt_pk_bf16_f32 %0, %1, %2" : "=v"(r) : "v"(lo), "v"(hi)); return r; }

__device__ __forceinline__ void partialSM(f32x16& p0, f32x16& p1, float& m_reg, float& mn, float& alpha) {
  float pmax = p0[0];
#pragma unroll
  for (int r = 1; r < 16; ++r) pmax = fmaxf(pmax, p0[r]);
#pragma unroll
  for (int r = 0; r < 16; ++r) pmax = fmaxf(pmax, p1[r]);
  { auto rr = __builtin_amdgcn_permlane32_swap(__float_as_uint(pmax), __float_as_uint(pmax), false, false);
    pmax = fmaxf(__uint_as_float(rr[0]), __uint_as_float(rr[1])); }
  if (__builtin_expect(__all(pmax - m_reg <= THRL), 1)) { mn = m_reg; alpha = 1.f; }
  else { mn = fmaxf(m_reg, pmax); alpha = __builtin_amdgcn_exp2f(m_reg - mn); m_reg = mn; }
#pragma unroll
  for (int r = 0; r < 16; ++r) p0[r] = p0[r] - mn;
#pragma unroll
  for (int r = 0; r < 16; ++r) p1[r] = p1[r] - mn;
#pragma unroll
  for (int r = 0; r < 16; ++r) p0[r] = __builtin_amdgcn_exp2f(p0[r]);
}
__device__ __forceinline__ void finishSM(f32x16& p0, f32x16& p1, float alpha, float& l_reg, bf16x8& pa0, bf16x8& pa1, bf16x8& pa2, bf16x8& pa3) {
#pragma unroll
  for (int r = 0; r < 16; ++r) p1[r] = __builtin_amdgcn_exp2f(p1[r]);
  float ps = 0;
#pragma unroll
  for (int r = 0; r < 16; ++r) ps += p0[r];
#pragma unroll
  for (int r = 0; r < 16; ++r) ps += p1[r];
  { auto rr = __builtin_amdgcn_permlane32_swap(__float_as_uint(ps), __float_as_uint(ps), false, false);
    ps = __uint_as_float(rr[0]) + __uint_as_float(rr[1]); }
  l_reg = l_reg * alpha + ps;
#define PK4(P, BASE, OUT) do { unsigned a0 = cvtpk(P[BASE + 0], P[BASE + 1]), a1 = cvtpk(P[BASE + 2], P[BASE + 3]);   \
    unsigned b0 = cvtpk(P[BASE + 4], P[BASE + 5]), b1 = cvtpk(P[BASE + 6], P[BASE + 7]);                              \
    auto r0 = __builtin_amdgcn_permlane32_swap(a0, b0, false, false); auto r1 = __builtin_amdgcn_permlane32_swap(a1, b1, false, false); \
    u32x4 w = {r0[0], r1[0], r0[1], r1[1]}; OUT = *reinterpret_cast<bf16x8*>(&w); } while (0)
  PK4(p0, 0, pa0); PK4(p0, 8, pa1); PK4(p1, 0, pa2); PK4(p1, 8, pa3);
#undef PK4
}
__device__ __forceinline__ void qkt(f32x16& p0, f32x16& p1, const char* Kn, const char* Kr, const bf16x8* qr, int r32, int hi) {
  p0 = f32x16{}; p1 = f32x16{};
#define KFRAG(dst, d0) do { const int cb_ = (((d0) & 7) * 16 + hi * 8) * 2; \
    if ((d0) < 8) { dst[0] = *reinterpret_cast<const bf16x8*>(Kn + KSWZ(r32, cb_)); dst[1] = *reinterpret_cast<const bf16x8*>(Kn + KSWZ(32 + r32, cb_)); } \
    else { dst[0] = *reinterpret_cast<const bf16x8*>(Kr + KRSWZ(r32, cb_)); dst[1] = *reinterpret_cast<const bf16x8*>(Kr + KRSWZ(32 + r32, cb_)); } } while (0)
#define KMMA(src, d0) do { p0 = __builtin_amdgcn_mfma_f32_32x32x16_bf16(src[0], qr[d0], p0, 0, 0, 0); p1 = __builtin_amdgcn_mfma_f32_32x32x16_bf16(src[1], qr[d0], p1, 0, 0, 0); } while (0)
  bf16x8 fa[2], fb[2], fc[2];
  KFRAG(fa, 0); KFRAG(fb, 1); SBAR();
  KFRAG(fc, 2); SBAR(); KMMA(fa, 0); SBAR();
  KFRAG(fa, 3); SBAR(); KMMA(fb, 1); SBAR();
  KFRAG(fb, 4); SBAR(); KMMA(fc, 2); SBAR();
  KFRAG(fc, 5); SBAR(); KMMA(fa, 3); SBAR();
  KFRAG(fa, 6); SBAR(); KMMA(fb, 4); SBAR();
  KFRAG(fb, 7); SBAR(); KMMA(fc, 5); SBAR();
  KFRAG(fc, 8); SBAR(); KMMA(fa, 6); SBAR();
  KFRAG(fa, 9); SBAR(); KMMA(fb, 7); SBAR();
  KFRAG(fb, 10); SBAR(); KMMA(fc, 8); SBAR();
  KFRAG(fc, 11); SBAR(); KMMA(fa, 9); SBAR();
  KMMA(fb, 10); KMMA(fc, 11);
#undef KFRAG
#undef KMMA
}
__device__ __forceinline__ int v_st(int k, int c) { const int kk = (k & ~0xC) | ((k & 4) << 1) | ((k & 8) >> 1); return ((kk >> 3) * 4 + (c >> 5)) * 512 + ((kk & 7) * 32 + (c & 31)) * 2; }
__device__ __forceinline__ int v_rd_base(int lane) { return ((lane & 3) << 3) | (((lane >> 2) & 3) << 6) | (((lane >> 4) & 1) << 5) | (((lane >> 5) & 1) << 8); }
constexpr int v_rd_off(int d0, int ks, int half) { return d0 * 512 + ks * 4096 + half * 2048; }
template <int OFF> __device__ __forceinline__ s16x4 tr_read(int vb) {
  s16x4 r; asm volatile("ds_read_b64_tr_b16 %0, %1 offset:%2" : "=&v"(r) : "v"(vb), "i"(OFF) : "memory"); return r;
}
template <int D0> __device__ __forceinline__ void pv_one(f32x16& od, int vb, bf16x8 pa0, bf16x8 pa1, bf16x8 pa2, bf16x8 pa3) {
  const s16x4 l0 = tr_read<v_rd_off(D0, 0, 0)>(vb), h0 = tr_read<v_rd_off(D0, 0, 1)>(vb), l1 = tr_read<v_rd_off(D0, 1, 0)>(vb), h1 = tr_read<v_rd_off(D0, 1, 1)>(vb);
  const s16x4 l2 = tr_read<v_rd_off(D0, 2, 0)>(vb), h2 = tr_read<v_rd_off(D0, 2, 1)>(vb), l3 = tr_read<v_rd_off(D0, 3, 0)>(vb), h3 = tr_read<v_rd_off(D0, 3, 1)>(vb);
  asm volatile("s_waitcnt lgkmcnt(0)" ::: "memory"); SBAR();
#define PK(L, H) (bf16x8){L[0], L[1], L[2], L[3], H[0], H[1], H[2], H[3]}
  od = __builtin_amdgcn_mfma_f32_32x32x16_bf16(pa0, PK(l0, h0), od, 0, 0, 0);
  od = __builtin_amdgcn_mfma_f32_32x32x16_bf16(pa1, PK(l1, h1), od, 0, 0, 0);
  od = __builtin_amdgcn_mfma_f32_32x32x16_bf16(pa2, PK(l2, h2), od, 0, 0, 0);
  od = __builtin_amdgcn_mfma_f32_32x32x16_bf16(pa3, PK(l3, h3), od, 0, 0, 0);
#undef PK
}
__device__ __forceinline__ void pv_d0(f32x16* o, int vb, bf16x8 pa0, bf16x8 pa1, bf16x8 pa2, bf16x8 pa3) {
  pv_one<0>(o[0], vb, pa0, pa1, pa2, pa3); pv_one<1>(o[1], vb, pa0, pa1, pa2, pa3); pv_one<2>(o[2], vb, pa0, pa1, pa2, pa3); pv_one<3>(o[3], vb, pa0, pa1, pa2, pa3);
}

__device__ __forceinline__ void sm_half(f32x16& p, float& m_reg, float& l_reg, float& alpha, bf16x8& paL, bf16x8& paH) {
  float a = fmaxf(fmaxf(p[0], p[1]), p[2]), b = fmaxf(fmaxf(p[3], p[4]), p[5]);
  a = fmaxf(fmaxf(a, p[6]), p[7]); b = fmaxf(fmaxf(b, p[8]), p[9]); a = fmaxf(fmaxf(a, p[10]), p[11]); b = fmaxf(fmaxf(b, p[12]), p[13]); a = fmaxf(fmaxf(a, p[14]), p[15]);
  float pmax = fmaxf(a, b);
  { auto rr = __builtin_amdgcn_permlane32_swap(__float_as_uint(pmax), __float_as_uint(pmax), false, false);
    pmax = fmaxf(__uint_as_float(rr[0]), __uint_as_float(rr[1])); }
  const bool keep = __all(pmax - m_reg <= THRL);
  const float mn = keep ? m_reg : fmaxf(m_reg, pmax);
  alpha = __builtin_amdgcn_exp2f(m_reg - mn); m_reg = mn;
#pragma unroll
  for (int r = 0; r < 16; ++r) p[r] = __builtin_amdgcn_exp2f(p[r] - mn);
  float ps = 0;
#pragma unroll
  for (int r = 0; r < 16; ++r) ps += p[r];
  { auto rr = __builtin_amdgcn_permlane32_swap(__float_as_uint(ps), __float_as_uint(ps), false, false);
    ps = __uint_as_float(rr[0]) + __uint_as_float(rr[1]); }
  l_reg = l_reg * alpha + ps;
#define PK4(P, BASE, OUT) do { unsigned a0 = cvtpk(P[BASE + 0], P[BASE + 1]), a1 = cvtpk(P[BASE + 2], P[BASE + 3]);   \
    unsigned b0 = cvtpk(P[BASE + 4], P[BASE + 5]), b1 = cvtpk(P[BASE + 6], P[BASE + 7]);                              \
    auto r0 = __builtin_amdgcn_permlane32_swap(a0, b0, false, false); auto r1 = __builtin_amdgcn_permlane32_swap(a1, b1, false, false); \
    u32x4 w = {r0[0], r1[0], r0[1], r1[1]}; OUT = *reinterpret_cast<bf16x8*>(&w); } while (0)
  PK4(p, 0, paL); PK4(p, 8, paH);
#undef PK4
}
template <int H> __device__ __forceinline__ void qkt_half(f32x16& p, const char* Kn, const char* Kr, const bf16x8* qr, int r32, int hi) {
  p = f32x16{};
#pragma unroll
  for (int d0 = 0; d0 < 8; ++d0) { const int cb = (d0 * 16 + hi * 8) * 2;
    const bf16x8 f = *reinterpret_cast<const bf16x8*>(Kn + KSWZ(32 * H + r32, cb)); p = __builtin_amdgcn_mfma_f32_32x32x16_bf16(f, qr[d0], p, 0, 0, 0); }
#pragma unroll
  for (int d0 = 0; d0 < 4; ++d0) { const int cb = (d0 * 16 + hi * 8) * 2;
    const bf16x8 f = *reinterpret_cast<const bf16x8*>(Kr + KRSWZ(32 * H + r32, cb)); p = __builtin_amdgcn_mfma_f32_32x32x16_bf16(f, qr[8 + d0], p, 0, 0, 0); }
}
struct VFrag { s16x4 l0, h0, l1, h1; };
template <int H, int D0> __device__ __forceinline__ VFrag pv_rd(int vb) {
  VFrag f; f.l0 = tr_read<v_rd_off(D0, 2 * H, 0)>(vb); f.h0 = tr_read<v_rd_off(D0, 2 * H, 1)>(vb); f.l1 = tr_read<v_rd_off(D0, 2 * H + 1, 0)>(vb); f.h1 = tr_read<v_rd_off(D0, 2 * H + 1, 1)>(vb); return f;
}
__device__ __forceinline__ void pv_mma(f32x16& od, VFrag& f, bf16x8 paL, bf16x8 paH) {
#define PK(L, Hh) (bf16x8){L[0], L[1], L[2], L[3], Hh[0], Hh[1], Hh[2], Hh[3]}
  od = __builtin_amdgcn_mfma_f32_32x32x16_bf16(paL, PK(f.l0, f.h0), od, 0, 0, 0);
  od = __builtin_amdgcn_mfma_f32_32x32x16_bf16(paH, PK(f.l1, f.h1), od, 0, 0, 0);
#undef PK
}
#define VWAIT(N, f) asm volatile("s_waitcnt lgkmcnt(" #N ")" : "+v"(f.l0), "+v"(f.h0), "+v"(f.l1), "+v"(f.h1) :: "memory")
template <int H> __device__ __forceinline__ void pv_half(f32x16* o, int vb, bf16x8 paL, bf16x8 paH) {
  VFrag fa = pv_rd<H, 0>(vb), fb = pv_rd<H, 1>(vb);
  VWAIT(4, fa); pv_mma(o[0], fa, paL, paH);
  fa = pv_rd<H, 2>(vb);
  VWAIT(4, fb); pv_mma(o[1], fb, paL, paH);
  fb = pv_rd<H, 3>(vb);
  VWAIT(4, fa); pv_mma(o[2], fa, paL, paH);
  VWAIT(0, fb); pv_mma(o[3], fb, paL, paH);
}
#undef VWAIT

__device__ __forceinline__ void attn_unit(const bf16_t* __restrict__ Qb, const bf16_t* __restrict__ KNh, const bf16_t* __restrict__ KRs, const bf16_t* __restrict__ Vh,
                                          bf16_t* __restrict__ Ob, float* __restrict__ ssa, int seq, char* lds) {
  const int tid = threadIdx.x, wid = __builtin_amdgcn_readfirstlane(tid >> 6), lane = tid & 63, r32 = lane & 31, hi = lane >> 5;
  char* V_lds = lds + OFF_V; char* KN_lds = lds + OFF_KN; char* KR_lds = lds + OFF_KR;
  float* ws = (float*)(lds + OFF_WS) + wid * 64; float* li_l = ws; float* al_l = ws + 32;
  float m_reg = -1e30f, l_reg = 0; f32x16 o[4] = {}; bf16x8 qr[12];
  const bf16_t* Qw = Qb + (long)(wid * QBLK + r32) * LDQ + hi * 8;
#pragma unroll
  for (int d0 = 0; d0 < 12; ++d0) qr[d0] = *reinterpret_cast<const bf16x8*>(Qw + d0 * 16);
  const int vb0 = (int)(uintptr_t)V_lds + v_rd_base(lane);
  unsigned kn_off[2], v_off[2], kr_off;
#pragma unroll
  for (int i = 0; i < 2; ++i) {
    const int q = (wid * 2 + i) * 64 + lane;
    { const int row = q >> 4, c = (q & 15) ^ (row & 15); kn_off[i] = (unsigned)(row * LDKN * 2 + c * 16); }
    { const int sub = q >> 5, kk = (sub >> 2) * 8 + ((q & 31) >> 2), cc = (sub & 3) * 32 + (q & 3) * 8, k = (kk & ~0xC) | ((kk & 4) << 1) | ((kk & 8) >> 1);
      v_off[i] = (unsigned)(k * LDV * 2 + cc * 2); }
  }
  { const int q = wid * 64 + lane, row = q >> 3, c = (q & 7) ^ ((row >> 1) & 7); kr_off = (unsigned)(row * LDKR * 2 + c * 16); }
  typedef __attribute__((address_space(3))) unsigned lds_u32;
#define GLDS(gp, lp) __builtin_amdgcn_global_load_lds((const unsigned*)(gp), (lds_u32*)(lp), 16, 0, 0)
#define DMA_K(k0, s) do { const char* kb_ = (const char*)KNh + (size_t)(k0) * (LDKN * 2); const char* rb_ = (const char*)KRs + (size_t)(k0) * (LDKR * 2); \
    GLDS(kb_ + kn_off[0], KN_lds + (s) * SHM_KN + (wid * 2) * 1024); GLDS(kb_ + kn_off[1], KN_lds + (s) * SHM_KN + (wid * 2 + 1) * 1024); \
    GLDS(rb_ + kr_off, KR_lds + (s) * SHM_KR + wid * 1024); } while (0)
#define DMA_V(k0, off) do { const char* vb_ = (const char*)Vh + (size_t)(k0) * (LDV * 2); \
    GLDS(vb_ + v_off[0], V_lds + (off) + (wid * 2) * 1024); GLDS(vb_ + v_off[1], V_lds + (off) + (wid * 2 + 1) * 1024); } while (0)
#define RESC(a) do { if (__any((a) < 1.f)) { if (hi == 0) al_l[r32] = (a); asm volatile("s_waitcnt lgkmcnt(0)" ::: "memory"); \
    _Pragma("unroll") for (int d = 0; d < 4; ++d) _Pragma("unroll") for (int r = 0; r < 16; ++r) o[d][r] *= al_l[crow(r, hi)]; } } while (0)
  f32x16 p0, p1; float al0, al1; bf16x8 pa0, pa1, pa2, pa3; const int NT = seq / KVBLK;
#define STEP(b, j) do { \
    if ((j) + 1 < NT) { DMA_K(((j) + 1) * KVBLK, (b) ^ 1); DMA_V(((j) + 1) * KVBLK, ((b) ^ 1) * SHM_V); } SBAR(); \
    qkt_half<0>(p0, KN_lds + (b) * SHM_KN, KR_lds + (b) * SHM_KR, qr, r32, hi); SBAR(); \
    qkt_half<1>(p1, KN_lds + (b) * SHM_KN, KR_lds + (b) * SHM_KR, qr, r32, hi); sm_half(p0, m_reg, l_reg, al0, pa0, pa1); SBAR(); \
    RESC(al0); SBAR(); \
    pv_half<0>(o, vb0 + (b) * SHM_V, pa0, pa1); sm_half(p1, m_reg, l_reg, al1, pa2, pa3); SBAR(); \
    RESC(al1); SBAR(); \
    pv_half<1>(o, vb0 + (b) * SHM_V, pa2, pa3); \
    asm volatile("s_waitcnt vmcnt(0)" ::: "memory"); __syncthreads(); } while (0)
  DMA_K(0, 0); DMA_V(0, 0);
  asm volatile("s_waitcnt vmcnt(0)" ::: "memory"); __syncthreads();
#pragma unroll 1
  for (int j = 0; j < NT; j += 2) { STEP(0, j); STEP(1, j + 1); }
#undef STEP
  if (hi == 0) li_l[r32] = l_reg; asm volatile("s_waitcnt lgkmcnt(0)" ::: "memory");
  int zo = 0; asm volatile("" : "+v"(zo));
  bf16_t* Ow = Ob + (long)(wid * QBLK) * LDO; float* ssw = ssa + wid * QBLK;
#pragma unroll
  for (int r = 0; r < 16; ++r) { const int orow = crow(r, hi) + zo; const float rl = __builtin_amdgcn_rcpf(li_l[orow]); float s = 0.f;
#pragma unroll
    for (int d0 = 0; d0 < 4; ++d0) { const float v = o[d0][r] * rl; s += v * v; Ow[(long)orow * LDO + d0 * 32 + r32] = (bf16_t)(cvtpk(v, v) & 0xffffu); }
    s += __shfl_xor(s, 1); s += __shfl_xor(s, 2); s += __shfl_xor(s, 4); s += __shfl_xor(s, 8); s += __shfl_xor(s, 16);
    if (r32 == 0) atomicAdd(ssw + orow, s); }
  __syncthreads();
#undef GLDS
#undef DMA_K
#undef DMA_V
#undef RESC
}
#undef KSWZ
#undef KRSWZ
#undef SBAR
}

constexpr int NWAVES = 8, NTHREADS = 512;
constexpr size_t MiB = 1u << 20;
constexpr size_t WS_SS = 0;
constexpr size_t WS_MOD = 2 * MiB;
constexpr size_t WS_ROPE = 3 * MiB;
constexpr size_t WS_WIN = 7 * MiB, WS_WUQ = 9 * MiB, WS_WUKV = 10 * MiB, WS_WOUT = 11 * MiB, WS_WGU = 13 * MiB, WS_WD = 24 * MiB;
constexpr size_t WS_HB = 32 * MiB;
constexpr size_t WS_U = 192 * MiB, WS_CQ = 232 * MiB, WS_CKV = 292 * MiB, WS_KR = 332 * MiB;
constexpr size_t WS_Q = 342 * MiB, WS_KN = 522 * MiB, WS_V = 642 * MiB, WS_MX = 762 * MiB, WS_END = 922 * MiB;
constexpr size_t WS_MG = WS_Q;
constexpr size_t WS_ACT = WS_U;
constexpr size_t WS_F = WS_V;
static_assert(WS_ACT + (size_t)TT * DFF * 2 <= WS_F && WS_F + (size_t)TT * DM * 2 <= WS_END && WS_WD + (size_t)DM * DFF * 2 <= WS_HB, "d_ws map");
constexpr int LDS_BYTES = 147456;
constexpr int MISC_OFF = 131072 + 320;
constexpr size_t WS_BAR = 1835008;

#define LAS __attribute__((address_space(3)))
typedef unsigned short bf16;
typedef float f32x4 __attribute__((ext_vector_type(4)));
typedef unsigned v4u __attribute__((ext_vector_type(4)));
typedef unsigned v2u __attribute__((ext_vector_type(2)));
__device__ __forceinline__ unsigned pkbf(float lo, float hi) { unsigned r; asm volatile("v_cvt_pk_bf16_f32 %0, %1, %2" : "=v"(r) : "v"(lo), "v"(hi)); return r; }
__device__ __forceinline__ float bf2f(unsigned short b) { return __uint_as_float((unsigned)b << 16); }
__device__ __forceinline__ float wave_sum(float v) {
#pragma unroll
    for (int o = 1; o < 64; o <<= 1) v += __shfl_xor(v, o);
    return v;
}

struct Params { const float* in[23]; float* out; unsigned char* ws; int ph_lo, ph_hi; };
enum { I_XP = 0, I_XS, I_CP, I_CS, I_WADA, I_BADA, I_GMIXPRE, I_GMIXPOST, I_WIN, I_POOLW, I_POOLSCALE, I_GQA, I_WUQ, I_GKVA, I_WUKV, I_GPOOLOUT, I_GATTNOUT, I_WOUT, I_GFFNPRE, I_GFFNPOST, I_WGATE, I_WUP, I_WDOWN };

struct WSrc { const float* p; int col; };
__device__ __forceinline__ WSrc wmap(const Params& a, int mat, int n) {
    if (mat == 0) {
        if (n >= 960) return {nullptr, 0};
        if (n < 896) return {a.in[I_WIN], n};
        const int pp = n - 896, ch = pp >> 5, w = pp & 31, nn = w >> 4, i = 16 * ch + (w & 15); return {a.in[I_WIN], 896 + i + 32 * nn};
    } else if (mat == 1) {
        const int cc = n >> 5, w = n & 31; if (cc >= 36) return {nullptr, 0};
        const int h = cc / 6, j6 = cc - 6 * h;
        if (j6 < 4) return {a.in[I_WUQ], h * DQK + 32 * j6 + w};
        const int nn = w >> 4, i = 16 * (j6 - 4) + (w & 15); return {a.in[I_WUQ], h * DQK + DNOPE + i + 32 * nn};
    } else if (mat == 2) return {a.in[I_WUKV], n};
    else if (mat == 3) return {a.in[I_WOUT], n};
    else if (mat == 4) { const int cc = n >> 5, w = n & 31, nn = w >> 4; return {nn ? a.in[I_WUP] : a.in[I_WGATE], 16 * cc + (w & 15)}; }
    return {a.in[I_WDOWN], n};
}
__device__ __forceinline__ float wgain(const Params& a, int mat, int k) {
    if (mat == 1) return a.in[I_GQA][k];
    if (mat == 2) return a.in[I_GKVA][k];
    if (mat == 3) return k < POOLW ? a.in[I_GPOOLOUT][k] : a.in[I_GATTNOUT][k - POOLW];
    return 1.0f;
}
__device__ __forceinline__ void p0_transpose_item(const Params& a, int mat, int K, int Nsrc, int Ndst, bf16* WT, LAS float* scr, int item, int lane) {
    const int nblk = Ndst / 32, kb = item / nblk, nb = item % nblk, k0 = 64 * kb, n0 = 32 * nb;
    const WSrc s = wmap(a, mat, n0 + (lane & 31));
#pragma unroll 8
    for (int i = 0; i < 32; ++i) { const int kk = 2 * i + (lane >> 5); scr[kk * 33 + (lane & 31)] = s.p ? s.p[(size_t)(k0 + kk) * Nsrc + s.col] * wgain(a, mat, k0 + kk) : 0.f; }
    asm volatile("s_waitcnt lgkmcnt(0)" ::: "memory");
    const int c = lane & 7;
#pragma unroll
    for (int j = 0; j < 4; ++j) { const int n = (lane >> 3) + 8 * j; const LAS float* sp = scr + (8 * c) * 33 + n;
        v4u o; o.x = pkbf(sp[0 * 33], sp[1 * 33]); o.y = pkbf(sp[2 * 33], sp[3 * 33]); o.z = pkbf(sp[4 * 33], sp[5 * 33]); o.w = pkbf(sp[6 * 33], sp[7 * 33]);
        *(v4u*)(WT + (size_t)(n0 + n) * K + k0 + 8 * c) = o; }
    asm volatile("s_waitcnt lgkmcnt(0)" ::: "memory");
}
__constant__ double INV_FREQ[32] = {1.0, 0.7498942093324559, 0.5623413251903491, 0.4216965034285822, 0.31622776601683794, 0.23713737056616552, 0.1778279410038923, 0.1333521432163324,
    0.1, 0.07498942093324558, 0.05623413251903491, 0.042169650342858224, 0.03162277660168379, 0.023713737056616554, 0.01778279410038923, 0.01333521432163324,
    0.01, 0.007498942093324558, 0.005623413251903491, 0.004216965034285823, 0.0031622776601683794, 0.0023713737056616554, 0.0017782794100389228, 0.001333521432163324,
    0.001, 0.0007498942093324559, 0.0005623413251903491, 0.00042169650342858224, 0.00031622776601683794, 0.00023713737056616554, 0.00017782794100389227, 0.0001333521432163324};
__device__ __forceinline__ void rope_entry(float* dst, int s, int i) {
    const double ang = (double)s * INV_FREQ[i];
    const double q = __builtin_rint(ang * 0.6366197723675814);
    double r = __builtin_fma(-q, 1.5707963267948966, ang); r = __builtin_fma(-q, 6.123233995736766e-17, r);
    const double r2 = r * r;
    const double sn = r * (1.0 + r2 * (-1.0 / 6 + r2 * (1.0 / 120 + r2 * (-1.0 / 5040 + r2 * (1.0 / 362880 + r2 * (-1.0 / 39916800 + r2 * (1.0 / 6227020800.0)))))));
    const double cn = 1.0 + r2 * (-0.5 + r2 * (1.0 / 24 + r2 * (-1.0 / 720 + r2 * (1.0 / 40320 + r2 * (-1.0 / 3628800 + r2 * (1.0 / 479001600 + r2 * (-1.0 / 87178291200.0)))))));
    const int qi = (int)((long long)q & 3);
    const double c = (qi == 0) ? cn : (qi == 1) ? -sn : (qi == 2) ? -cn : sn;
    const double sv = (qi == 0) ? sn : (qi == 1) ? cn : (qi == 2) ? -sn : -cn;
    dst[0] = (float)c; dst[1] = (float)sv;
}
__device__ __forceinline__ void p0a_prologue(const Params& a, LAS unsigned char* lds) {
    const int tid = threadIdx.x, lane = tid & 63, wave = __builtin_amdgcn_readfirstlane(tid >> 6);
    unsigned char* ws = a.ws;
    const int G = gridDim.x, gw = blockIdx.x * NWAVES + wave, NGW = G * NWAVES, gt = blockIdx.x * NTHREADS + tid, NGT = G * NTHREADS;
    { f32x4* z = (f32x4*)(ws + WS_SS); for (int i = gt; i < 5 * TT / 4; i += NGT) z[i] = (f32x4){0.f, 0.f, 0.f, 0.f}; }
    { float* rt = (float*)(ws + WS_ROPE); for (int i = gt; i < SEQ_S * 32; i += NGT) rope_entry(rt + 2 * (size_t)i, i >> 5, i & 31); }
    {
        LAS float* scr = (LAS float*)(lds + wave * 16384);
        constexpr int I0 = 16 * 32, I1 = 6 * 40, I2 = 4 * 48, I3 = 16 * 32, I4 = 16 * 176, I5 = 44 * 32;
        constexpr int NITEMS = I0 + I1 + I2 + I3 + I4 + I5;
        for (int it = gw; it < NITEMS; it += NGW) {
            int r = it;
            if (r < I0) { p0_transpose_item(a, 0, DM, 960, 1024, (bf16*)(ws + WS_WIN), scr, r, lane); continue; } r -= I0;
            if (r < I1) { p0_transpose_item(a, 1, QLR, LDQ_, 1280, (bf16*)(ws + WS_WUQ), scr, r, lane); continue; } r -= I1;
            if (r < I2) { p0_transpose_item(a, 2, KVLR, 1536, 1536, (bf16*)(ws + WS_WUKV), scr, r, lane); continue; } r -= I2;
            if (r < I3) { p0_transpose_item(a, 3, DM, DM, DM, (bf16*)(ws + WS_WOUT), scr, r, lane); continue; } r -= I3;
            if (r < I4) { p0_transpose_item(a, 4, DM, DFF, 2 * DFF, (bf16*)(ws + WS_WGU), scr, r, lane); continue; } r -= I4;
            p0_transpose_item(a, 5, DFF, DM, DM, (bf16*)(ws + WS_WD), scr, r, lane);
        }
    }
    __syncthreads();
    for (int bb = blockIdx.x; bb < 96; bb += G) {
        float accb[NBATCH];
#pragma unroll
        for (int b = 0; b < NBATCH; ++b) accb[b] = 0.f;
        const float* wa = a.in[I_WADA] + bb * 64 + lane;
        for (int k0 = wave * 128; k0 < wave * 128 + 128; k0 += 16) {
            float w[16];
#pragma unroll
            for (int kk = 0; kk < 16; ++kk) w[kk] = wa[(size_t)(k0 + kk) * 6144];
#pragma unroll
            for (int kk = 0; kk < 16; ++kk) {
#pragma unroll
                for (int b = 0; b < NBATCH; ++b) { const float c = (b < 8) ? a.in[I_CP][b * DM + k0 + kk] : a.in[I_CS][k0 + kk]; accb[b] += (c / (1.0f + __expf(-c))) * w[kk]; } }
        }
        LAS float* red = (LAS float*)lds;
#pragma unroll
        for (int b = 0; b < NBATCH; ++b) red[(wave * NBATCH + b) * 64 + lane] = accb[b];
        __syncthreads();
        for (int idx = tid; idx < NBATCH * 64; idx += NTHREADS) { const int b = idx >> 6, l = idx & 63; float s = a.in[I_BADA][bb * 64 + l];
#pragma unroll
            for (int w = 0; w < 8; ++w) s += red[(w * NBATCH + b) * 64 + l];
            ((float*)(ws + WS_MOD))[b * 6144 + bb * 64 + l] = s; }
        __syncthreads();
    }
}

__device__ __forceinline__ const float* xrow_ptr(const Params& a, int t) { return t < T_P ? a.in[I_XP] + (size_t)t * DM : a.in[I_XS] + (size_t)(t - T_P) * DM; }
__device__ __forceinline__ int batch_of(int t) { return t < T_P ? (t >> 13) : 8; }
__device__ __forceinline__ void st4bf(bf16* p, f32x4 v) { v2u w; w.x = pkbf(v[0], v[1]); w.y = pkbf(v[2], v[3]); *(v2u*)p = w; }
__device__ __forceinline__ f32x4 ld4bf(const bf16* p) { const v2u w = *(const v2u*)p; return (f32x4){__uint_as_float(w.x << 16), __uint_as_float(w.x & 0xffff0000u), __uint_as_float(w.y << 16), __uint_as_float(w.y & 0xffff0000u)}; }

__device__ __forceinline__ void wave_sum2(float& a, float& b) {
#pragma unroll
    for (int o = 1; o < 64; o <<= 1) { const float ta = __shfl_xor(a, o), tb = __shfl_xor(b, o); a += ta; b += tb; }
}
__device__ __forceinline__ float ssq4(f32x4 v) { return (v[0] * v[0] + v[1] * v[1]) + (v[2] * v[2] + v[3] * v[3]); }
#define ROWS_SETUP const int tid = threadIdx.x, lane = tid & 63, wave = __builtin_amdgcn_readfirstlane(tid >> 6); \
    const int NGW = gridDim.x * NWAVES, gw = blockIdx.x * NWAVES + wave, per = (((TT + NGW - 1) / NGW) + 1) & ~1, t_lo = gw * per, t_hi = min(TT, t_lo + per); (void)tid;
__device__ __forceinline__ void p0b_rows(const Params& a) {
    ROWS_SETUP
    const float* mod = (const float*)(a.ws + WS_MOD); bf16* HB = (bf16*)(a.ws + WS_HB);
    int bcur = -1; f32x4 A0[4], S1[4];
    for (int t = t_lo; t < t_hi; t += 2) {
        const int b = batch_of(t);
        if (b != bcur) { bcur = b;
#pragma unroll
            for (int j = 0; j < 4; ++j) { const int c = 4 * lane + 256 * j; const f32x4 g = *(const f32x4*)(a.in[I_GMIXPRE] + c), sc = *(const f32x4*)(mod + b * 6144 + 1024 + c);
                A0[j] = g * (sc + 1.0f); S1[j] = *(const f32x4*)(mod + b * 6144 + c); } }
        const f32x4* xr = (const f32x4*)xrow_ptr(a, t) + lane; f32x4 v[2][4]; float s0 = 0.f, s1 = 0.f;
#pragma unroll
        for (int j = 0; j < 4; ++j) { v[0][j] = xr[64 * j]; v[1][j] = xr[256 + 64 * j]; }
#pragma unroll
        for (int j = 0; j < 4; ++j) { s0 += ssq4(v[0][j]); s1 += ssq4(v[1][j]); }
        wave_sum2(s0, s1);
        const float r0 = 1.0f / sqrtf(s0 * (1.0f / DM) + EPS), r1 = 1.0f / sqrtf(s1 * (1.0f / DM) + EPS);
#pragma unroll
        for (int j = 0; j < 4; ++j) { st4bf(HB + (size_t)t * DM + 4 * lane + 256 * j, v[0][j] * r0 * A0[j] + S1[j]); st4bf(HB + (size_t)(t + 1) * DM + 4 * lane + 256 * j, v[1][j] * r1 * A0[j] + S1[j]); }
    }
}
__device__ __forceinline__ void p6_rows(const Params& a) {
    ROWS_SETUP
    const float* mod = (const float*)(a.ws + WS_MOD); bf16* HB = (bf16*)(a.ws + WS_HB); const bf16* MG = (const bf16*)(a.ws + WS_MG);
    const float* ssm = (const float*)(a.ws + WS_SS) + 3 * (size_t)TT;
    int bcur = -1; f32x4 A1[4], B2[4], S2[4];
    for (int t = t_lo; t < t_hi; t += 2) {
        const int b = batch_of(t);
        if (b != bcur) { bcur = b;
#pragma unroll
            for (int j = 0; j < 4; ++j) { const int c = 4 * lane + 256 * j;
                A1[j] = *(const f32x4*)(mod + b * 6144 + 2048 + c) * *(const f32x4*)(a.in[I_GMIXPOST] + c);
                B2[j] = *(const f32x4*)(a.in[I_GFFNPRE] + c) * (*(const f32x4*)(mod + b * 6144 + 4096 + c) + 1.0f);
                S2[j] = *(const f32x4*)(mod + b * 6144 + 3072 + c); } }
        const float rm0 = 1.0f / sqrtf(ssm[t] * (1.0f / DM) + EPS), rm1 = 1.0f / sqrtf(ssm[t + 1] * (1.0f / DM) + EPS);
        const f32x4* xr = (const f32x4*)xrow_ptr(a, t) + lane; f32x4 v[2][4], mg[2][4]; float s0 = 0.f, s1 = 0.f;
#pragma unroll
        for (int j = 0; j < 4; ++j) { v[0][j] = xr[64 * j]; v[1][j] = xr[256 + 64 * j];
            mg[0][j] = ld4bf(MG + (size_t)t * DM + 4 * lane + 256 * j); mg[1][j] = ld4bf(MG + (size_t)(t + 1) * DM + 4 * lane + 256 * j); }
#pragma unroll
        for (int j = 0; j < 4; ++j) { v[0][j] = v[0][j] + A1[j] * (mg[0][j] * rm0); v[1][j] = v[1][j] + A1[j] * (mg[1][j] * rm1); s0 += ssq4(v[0][j]); s1 += ssq4(v[1][j]); }
        wave_sum2(s0, s1);
        const float r0 = 1.0f / sqrtf(s0 * (1.0f / DM) + EPS), r1 = 1.0f / sqrtf(s1 * (1.0f / DM) + EPS);
        f32x4* orow = (f32x4*)(a.out + (size_t)t * DM) + lane;
#pragma unroll
        for (int j = 0; j < 4; ++j) { orow[64 * j] = v[0][j]; orow[256 + 64 * j] = v[1][j];
            st4bf(HB + (size_t)t * DM + 4 * lane + 256 * j, v[0][j] * r0 * B2[j] + S2[j]); st4bf(HB + (size_t)(t + 1) * DM + 4 * lane + 256 * j, v[1][j] * r1 * B2[j] + S2[j]); }
    }
}
__device__ __forceinline__ void p9_rows(const Params& a) {
    ROWS_SETUP
    const float* mod = (const float*)(a.ws + WS_MOD); const bf16* FB = (const bf16*)(a.ws + WS_F);
    const float* ssf = (const float*)(a.ws + WS_SS) + 4 * (size_t)TT;
    int bcur = -1; f32x4 A2[4];
    for (int t = t_lo; t < t_hi; t += 2) {
        const int b = batch_of(t);
        if (b != bcur) { bcur = b;
#pragma unroll
            for (int j = 0; j < 4; ++j) { const int c = 4 * lane + 256 * j; A2[j] = *(const f32x4*)(mod + b * 6144 + 5120 + c) * *(const f32x4*)(a.in[I_GFFNPOST] + c); } }
        const float rf0 = 1.0f / sqrtf(ssf[t] * (1.0f / DM) + EPS), rf1 = 1.0f / sqrtf(ssf[t + 1] * (1.0f / DM) + EPS);
        f32x4* orow = (f32x4*)(a.out + (size_t)t * DM) + lane; f32x4 x1[2][4], f[2][4];
#pragma unroll
        for (int j = 0; j < 4; ++j) { x1[0][j] = orow[64 * j]; x1[1][j] = orow[256 + 64 * j];
            f[0][j] = ld4bf(FB + (size_t)t * DM + 4 * lane + 256 * j); f[1][j] = ld4bf(FB + (size_t)(t + 1) * DM + 4 * lane + 256 * j); }
#pragma unroll
        for (int j = 0; j < 4; ++j) { orow[64 * j] = x1[0][j] + A2[j] * (f[0][j] * rf0); orow[256 + 64 * j] = x1[1][j] + A2[j] * (f[1][j] * rf1); }
    }
}
#undef ROWS_SETUP

__device__ __forceinline__ void pool_phase(const Params& a, LAS unsigned char* lds) {
    const int tid = threadIdx.x, lane = tid & 63, wave = __builtin_amdgcn_readfirstlane(tid >> 6);
    const bf16* U = (const bf16*)(a.ws + WS_U); bf16* MX = (bf16*)(a.ws + WS_MX); const float* ssa = (const float*)(a.ws + WS_SS) + 2 * (size_t)TT;
    LAS float* ps = (LAS float*)lds;
    LAS float* ssl = (LAS float*)(lds + 65536);
    LAS unsigned char* us = lds + 65536 + 1024;
    const int g = wave & 3, half = wave >> 2, d = lane;
    float wreg[64];
#pragma unroll
    for (int c = 0; c < 64; ++c) wreg[c] = a.in[I_POOLW][g * 4096 + c * 64 + d];
    const float pscale = a.in[I_POOLSCALE][64 * g + d];
    for (int tile = blockIdx.x; tile < TT / 64; tile += gridDim.x) {
        const int t0 = tile * 64, sb = t0 < T_P ? (t0 & ~(SEQ_P - 1)) : T_P, se = t0 < T_P ? sb + SEQ_P : TT;
#pragma unroll
        for (int it = 0; it < 5; ++it) { const int idx = tid + NTHREADS * it, rl = idx >> 5, ch8 = idx & 31, tr = t0 - 8 + rl;
            if (tr >= sb && tr < se) *(LAS v4u*)(us + rl * 512 + ch8 * 16) = *(const v4u*)(U + (size_t)tr * POOLW + ch8 * 8); }
        __syncthreads();
#pragma unroll 1
        for (int it = 0; it < 4; ++it) {
            const int idx = tid + NTHREADS * it, tl = idx >> 5, ch8 = idx & 31, t = t0 + tl, w = 2 << (ch8 >> 3);
            const int lo = max(t - (w >> 1), sb), hi = min(t + w - (w >> 1), se);
            float sum[8];
#pragma unroll
            for (int e = 0; e < 8; ++e) sum[e] = 0.f;
            for (int j = lo; j < hi; ++j) { const v4u q = *(const LAS v4u*)(us + (j - t0 + 8) * 512 + ch8 * 16);
#pragma unroll
                for (int e = 0; e < 4; ++e) { sum[2 * e] += __uint_as_float(q[e] << 16); sum[2 * e + 1] += __uint_as_float(q[e] & 0xffff0000u); } }
            const v4u q = *(const LAS v4u*)(us + (tl + 8) * 512 + ch8 * 16); const float inv = 1.0f / (float)(hi - lo);
            f32x4 o0, o1;
#pragma unroll
            for (int e = 0; e < 2; ++e) { o0[2 * e] = sum[2 * e] * inv - __uint_as_float(q[e] << 16); o0[2 * e + 1] = sum[2 * e + 1] * inv - __uint_as_float(q[e] & 0xffff0000u);
                o1[2 * e] = sum[4 + 2 * e] * inv - __uint_as_float(q[2 + e] << 16); o1[2 * e + 1] = sum[5 + 2 * e] * inv - __uint_as_float(q[2 + e] & 0xffff0000u); }
            *(LAS f32x4*)(ps + tl * 256 + ch8 * 8) = o0; *(LAS f32x4*)(ps + tl * 256 + ch8 * 8 + 4) = o1;
        }
        __syncthreads();
        float o[32];
#pragma unroll
        for (int tt = 0; tt < 32; ++tt) { const int tl = half * 32 + tt; float acc = 0.f;
#pragma unroll
            for (int c4 = 0; c4 < 16; ++c4) { const f32x4 pv = *(const LAS f32x4*)(ps + tl * 256 + g * 64 + c4 * 4);
                acc += pv[0] * wreg[4 * c4] + pv[1] * wreg[4 * c4 + 1] + pv[2] * wreg[4 * c4 + 2] + pv[3] * wreg[4 * c4 + 3]; }
            o[tt] = acc * pscale; const float s = wave_sum(o[tt] * o[tt]);
            if (lane == 0) ssl[g * 64 + tl] = s; }
        __syncthreads();
#pragma unroll
        for (int tt = 0; tt < 32; ++tt) { const int tl = half * 32 + tt, t = t0 + tl;
            const float f = sqrtf(ssa[t] * (1.0f / (NH * DV)) + EPS) / sqrtf(((ssl[tl] + ssl[64 + tl]) + (ssl[128 + tl] + ssl[192 + tl])) * (1.0f / POOLW) + EPS);
            MX[(size_t)t * DM + 64 * g + d] = (bf16)(pkbf(o[tt] * f, 0.f) & 0xffffu); }
        __syncthreads();
    }
}
#define XB_TMO      128
#define XB_XCNT(j)  (256  + 64 * (j))
#define XB_XSUB(j)  (1280 + 64 * (j))
#define XB_XGEN(j)  (2304 + 64 * (j))
#define XB_TOP      3328
#define XB_TOPGEN   3392
#define XCD_BAR_WORDS 3456
#define XB_SPIN_CAP (1u << 18)

__device__ __forceinline__ unsigned xb_ld(unsigned* p)              { return __hip_atomic_load(p, __ATOMIC_RELAXED, __HIP_MEMORY_SCOPE_AGENT); }
__device__ __forceinline__ unsigned xb_add(unsigned* p, unsigned v) { return __hip_atomic_fetch_add(p, v, __ATOMIC_RELAXED, __HIP_MEMORY_SCOPE_AGENT); }
__device__ __forceinline__ unsigned xb_xcc_id() { return (unsigned)__builtin_amdgcn_s_getreg((3 << 11) | 20) & 0xFu; }
#define XB_SPIN(cond, bar) do { unsigned _sp = 0; while (cond) { __builtin_amdgcn_s_sleep(1); \
    if ((++_sp & 255u) == 0u) { if (xb_ld(&(bar)[XB_TMO])) break; if (_sp > XB_SPIN_CAP) { atomicAdd(&(bar)[XB_TMO], 1u); break; } } } } while (0)

struct XcdBarrier {
    unsigned* bar; unsigned x;
    volatile LAS unsigned* st;
};

__device__ __forceinline__ XcdBarrier xcd_barrier_post(unsigned* bar, volatile LAS unsigned* st) {
    XcdBarrier b; b.bar = bar; b.x = xb_xcc_id(); b.st = st;
    if (threadIdx.x == 0) { const unsigned rank_ = xb_add(&bar[XB_XCNT(b.x)], 1u); st[4] = b.x; st[5] = rank_; }
    return b;
}
__device__ __forceinline__ void xcd_barrier_complete(unsigned* bar, unsigned x, unsigned& nloc, unsigned& nx) {
    const unsigned G = gridDim.x * gridDim.y * gridDim.z;
    unsigned sum, cnt, mine, sp = 0u;
    for (;;) {
        sum = 0u; cnt = 0u; mine = 0u;
#pragma unroll
        for (unsigned j = 0; j < 16; ++j) { const unsigned c = xb_ld(&bar[XB_XCNT(j)]); sum += c; cnt += (c > 0u) ? 1u : 0u; mine = (j == x) ? c : mine; }
        if (sum == G) break;
        __builtin_amdgcn_s_sleep(1);
        if ((++sp & 255u) == 0u) { if (xb_ld(&bar[XB_TMO])) break; if (sp > XB_SPIN_CAP) { atomicAdd(&bar[XB_TMO], 1u); break; } }
    }
    nloc = mine > 0u ? mine : 1u; nx = cnt > 0u ? cnt : 1u;
}

__device__ __forceinline__ void xcd_barrier(const XcdBarrier& b) {
    asm volatile("s_waitcnt vmcnt(0)" ::: "memory");
    __syncthreads();
    if (threadIdx.x == 0) {
        unsigned* bar = b.bar;
        __builtin_amdgcn_s_waitcnt(0);
        unsigned nloc = b.st[0], nx = b.st[1];
        if (nloc == 0u) { xcd_barrier_complete(bar, b.x, nloc, nx); b.st[0] = nloc; b.st[1] = nx; }
        const unsigned old = xb_add(&bar[XB_XSUB(b.x)], 1u);
        const unsigned gen = old / nloc;
        if (old + 1u == (gen + 1u) * nloc) {
            __builtin_amdgcn_fence(__ATOMIC_RELEASE, "agent");
            asm volatile("s_waitcnt vmcnt(0)" ::: "memory");
            const unsigned og = xb_add(&bar[XB_TOP], 1u);
            const unsigned tg = og / nx;
            if (og + 1u == (tg + 1u) * nx) xb_add(&bar[XB_TOPGEN], 1u);
            else XB_SPIN(xb_ld(&bar[XB_TOPGEN]) == tg, bar);
            __builtin_amdgcn_fence(__ATOMIC_ACQUIRE, "agent");
            xb_add(&bar[XB_XGEN(b.x)], 1u);
            asm volatile("s_waitcnt vmcnt(0)" ::: "memory");
        } else {
            XB_SPIN(xb_ld(&bar[XB_XGEN(b.x)]) == gen, bar);
            __builtin_amdgcn_fence(__ATOMIC_ACQUIRE, "agent");
            asm volatile("s_waitcnt vmcnt(0)" ::: "memory");
        }
    }
    __syncthreads();
}

constexpr int N_PHASES = 10;
__device__ __forceinline__ void attn_phase(const Params& a, unsigned char* lds, bool placed) {
    const att::bf16_t* Q = (const att::bf16_t*)(a.ws + WS_Q); const att::bf16_t* KN = (const att::bf16_t*)(a.ws + WS_KN); const att::bf16_t* KR = (const att::bf16_t*)(a.ws + WS_KR);
    const att::bf16_t* V = (const att::bf16_t*)(a.ws + WS_V); att::bf16_t* MX = (att::bf16_t*)(a.ws + WS_MX); float* ssa = (float*)(a.ws + WS_SS) + 2 * (size_t)TT;
    const int G = gridDim.x;
    int x = blockIdx.x & 7, cu = blockIdx.x >> 3;
    if (G == 256 && placed) {
        const unsigned* barw = (const unsigned*)(a.ws + WS_BAR); bool ok = true;
        for (int j = 0; j < 8; ++j) ok = ok && (__hip_atomic_load(barw + XB_XCNT(j), __ATOMIC_RELAXED, __HIP_MEMORY_SCOPE_AGENT) == 32u);
        volatile LAS unsigned* M = (volatile LAS unsigned*)((LAS unsigned char*)lds + MISC_OFF);
        if (ok && M[12] < 8u && M[13] < 32u) { x = (int)M[12]; cu = (int)M[13]; }
    }
    const int ns = x < 4 ? 2 : 1, np = x < 4 ? 5 : 7, p0 = x < 4 ? 5 * x : 20 + 7 * (x - 4);
    const int nunits = (G == 256) ? ns + np : ((TT / 256) * NH - (int)blockIdx.x + G - 1) / G;
    for (int i = 0; i < nunits; ++i) {
        int row0, k0, h, seq;
        if (G == 256) {
            if (i < ns) { h = x < 4 ? x : 4 + ((x - 4) >> 1); const int qb = x < 4 ? cu + 32 * i : ((x - 4) & 1) * 32 + cu; row0 = T_P + qb * 256; k0 = T_P; seq = SEQ_S; }
            else { const int p = p0 + (i - ns), sq = p / NH; h = p - sq * NH; row0 = sq * SEQ_P + cu * 256; k0 = sq * SEQ_P; seq = SEQ_P; }
        } else { const int uidx = blockIdx.x + i * G, rb = uidx / NH; h = uidx - rb * NH; row0 = rb * 256; k0 = row0 < T_P ? (row0 & ~(SEQ_P - 1)) : T_P; seq = row0 < T_P ? SEQ_P : SEQ_S; }
        att::attn_unit(Q + (size_t)row0 * LDQ_ + h * DQK, KN + (size_t)k0 * LDKV_ + h * DNOPE, KR + (size_t)k0 * DROPE, V + (size_t)k0 * LDKV_ + h * DV,
                       MX + (size_t)row0 * DM + POOLW + h * DV, ssa + row0, seq, (char*)lds);
    }
}

__global__ void __launch_bounds__(NTHREADS, 2) enc_fwd(Params a) {
    extern __shared__ __attribute__((aligned(16))) unsigned char lds_raw[];
    LAS unsigned char* lds = (LAS unsigned char*)lds_raw;
    const int lo = a.ph_lo, hi = a.ph_hi, G = gridDim.x;
    unsigned char* ws = a.ws;
    float* SS = (float*)(ws + WS_SS);
#define IN(k) (lo <= (k) && (k) < hi)
    unsigned* barw = (unsigned*)(ws + WS_BAR);
    volatile LAS unsigned* MISC = (volatile LAS unsigned*)(lds + MISC_OFF);
    if (threadIdx.x < 16) MISC[threadIdx.x] = 0u;
    if (IN(0) && IN(1) && blockIdx.x == 0) for (int i = threadIdx.x; i < XCD_BAR_WORDS; i += NTHREADS) barw[i] = 0u;
    __syncthreads();
    XcdBarrier xb; xb.bar = barw; xb.x = 0; xb.st = MISC + 8;
#define SEAM(k) do { if (IN(k) && IN((k) + 1)) { if ((k) == 0) { cg::this_grid().sync(); xb = xcd_barrier_post(barw, MISC + 8); } else xcd_barrier(xb); } } while (0)
    if (IN(0)) { p0a_prologue(a, lds); } SEAM(0);
    if (IN(1)) { p0b_rows(a); } SEAM(1);
    if (IN(2)) {
        pg8::Gemm g{(const pg8::bf16_t*)(ws + WS_HB), (const pg8::bf16_t*)(ws + WS_WIN), TT, 1024, DM}; pg8::StaticOrder S; S.init(TT, 1024, G, (int)blockIdx.x);
        pg8::EpiZ E{(pg8::bf16_t*)(ws + WS_U), (pg8::bf16_t*)(ws + WS_CQ), (pg8::bf16_t*)(ws + WS_CKV), (pg8::bf16_t*)(ws + WS_KR), SS, SS + TT, (const float*)(ws + WS_ROPE)};
        pg8::gemm_phase<pg8::EpiZ, pg8::StaticOrder, true, true>(lds, g, S, E);
    } SEAM(2);
    if (IN(3)) {
        { pg8::Gemm g{(const pg8::bf16_t*)(ws + WS_CQ), (const pg8::bf16_t*)(ws + WS_WUQ), TT, 1280, QLR}; pg8::StaticOrder S; S.init(TT, 1280, G, (int)blockIdx.x);
          pg8::EpiQ E{(pg8::bf16_t*)(ws + WS_Q), SS, (const float*)(ws + WS_ROPE)};
          pg8::gemm_phase<pg8::EpiQ, pg8::StaticOrder, true, true>(lds, g, S, E); }
        { pg8::Gemm g{(const pg8::bf16_t*)(ws + WS_CKV), (const pg8::bf16_t*)(ws + WS_WUKV), TT, 1536, KVLR}; pg8::StaticOrder S; S.init(TT, 1536, G, (int)blockIdx.x);
          pg8::EpiKV E{(pg8::bf16_t*)(ws + WS_KN), (pg8::bf16_t*)(ws + WS_V), SS + TT};
          pg8::gemm_phase<pg8::EpiKV, pg8::StaticOrder, true, true>(lds, g, S, E); }
    } SEAM(3);
    if (IN(4)) { attn_phase(a, lds_raw, IN(0) && IN(1)); } SEAM(4);
    if (IN(5)) { pool_phase(a, lds); } SEAM(5);
    if (IN(6)) {
        pg8::Gemm g{(const pg8::bf16_t*)(ws + WS_MX), (const pg8::bf16_t*)(ws + WS_WOUT), TT, DM, DM}; pg8::StaticOrder S; S.init(TT, DM, G, (int)blockIdx.x);
        pg8::EpiRowScaleSS E{(pg8::bf16_t*)(ws + WS_MG), SS + 2 * (size_t)TT, 1.0f / (NH * DV), SS + 3 * (size_t)TT};
        pg8::gemm_phase<pg8::EpiRowScaleSS, pg8::StaticOrder, true, true>(lds, g, S, E);
    } SEAM(6);
    if (IN(7)) { p6_rows(a); } SEAM(7);
    if (IN(8)) {
        pg8::Gemm g{(const pg8::bf16_t*)(ws + WS_HB), (const pg8::bf16_t*)(ws + WS_WGU), TT, 2 * DFF, DM}; pg8::StaticOrder S; S.init(TT, 2 * DFF, G, (int)blockIdx.x);
        pg8::EpiGU E{(pg8::bf16_t*)(ws + WS_ACT)};
        pg8::gemm_phase<pg8::EpiGU, pg8::StaticOrder, true, true>(lds, g, S, E);
    } SEAM(8);
    if (IN(9)) {
        pg8::Gemm g{(const pg8::bf16_t*)(ws + WS_ACT), (const pg8::bf16_t*)(ws + WS_WD), TT, DM, DFF}; pg8::StaticOrder S; S.init(TT, DM, G, (int)blockIdx.x);
        pg8::EpiRowScaleSS E{(pg8::bf16_t*)(ws + WS_F), nullptr, 0.f, SS + 4 * (size_t)TT};
        pg8::gemm_phase<pg8::EpiRowScaleSS, pg8::StaticOrder, true, true>(lds, g, S, E);
    } SEAM(9);
    if (IN(10)) { p9_rows(a); }
#undef IN
#undef SEAM
}

extern "C" void kernel_launch(void* const* d_in, const int* in_sizes, int n_in, void* d_out, int out_size, void* d_ws, size_t ws_size, hipStream_t stream) {
    static int grid = 0;
    if (grid == 0) {
        if (n_in != 23 || out_size != TT * DM || ws_size < WS_END) { fprintf(stderr, "kernel_launch: unexpected shapes: n_in %d out %d ws %zu (need %zu)\n", n_in, out_size, ws_size, (size_t)WS_END); grid = -1; return; }
        int dev = 0, cus = 0, per_cu = 0;
        if (hipGetDevice(&dev) != hipSuccess || hipDeviceGetAttribute(&cus, hipDeviceAttributeMultiprocessorCount, dev) != hipSuccess) { grid = -1; return; }
        if (hipFuncSetAttribute((const void*)enc_fwd, hipFuncAttributeMaxDynamicSharedMemorySize, LDS_BYTES) != hipSuccess) { fprintf(stderr, "kernel_launch: hipFuncSetAttribute failed\n"); grid = -1; return; }
        if (hipOccupancyMaxActiveBlocksPerMultiprocessor(&per_cu, (const void*)enc_fwd, NTHREADS, LDS_BYTES) != hipSuccess || per_cu < 1) per_cu = 1;
        (void)hipGetLastError();
        grid = cus;
    }
    if (grid < 0) return;
    Params p{};
    for (int i = 0; i < 23; ++i) p.in[i] = (const float*)d_in[i];
    p.out = (float*)d_out; p.ws = (unsigned char*)d_ws;
#if MK_PER_PHASE
    for (int ph = 0; ph <= N_PHASES; ++ph) { p.ph_lo = ph; p.ph_hi = ph + 1; hipLaunchKernelGGL(enc_fwd, dim3(grid), dim3(NTHREADS), LDS_BYTES, stream, p); }
#else
    p.ph_lo = 0; p.ph_hi = N_PHASES + 1;
    void* args[] = {&p};
    hipError_t e = hipLaunchCooperativeKernel((const void*)enc_fwd, dim3(grid), dim3(NTHREADS), args, LDS_BYTES, stream);
    if (e != hipSuccess) fprintf(stderr, "kernel_launch: cooperative launch failed: %s (grid %d)\n", hipGetErrorString(e), grid);
#endif
}
```

```cpp
#include <hip/hip_runtime.h>
#include <hip/hip_cooperative_groups.h>
#include <cstdio>
#include <cstdint>
namespace cg = cooperative_groups;

#ifndef MK_PER_PHASE
#define MK_PER_PHASE 0
#endif

constexpr int DM = 1024, T_P = 65536, T_S = 16384, TT = T_P + T_S, SEQ_P = 8192, SEQ_S = 16384, NBATCH = 9;
constexpr int NH = 6, DQK = 192, DNOPE = 128, DROPE = 64, DV = 128, QLR = 384, KVLR = 256, DFF = 2816, POOLW = 256;
constexpr int LDQ_ = NH * DQK  , LDKV_ = NH * DNOPE  ;
constexpr float EPS = 1e-6f;
constexpr float QSCALE = 0.07216878364870322f * 1.4426950408889634f;

namespace pg8 {
#define PG8_LAS __attribute__((address_space(3)))
typedef unsigned short bf16_t;
typedef short bf16x8 __attribute__((ext_vector_type(8)));
typedef float f32x4 __attribute__((ext_vector_type(4)));
typedef unsigned u32x4 __attribute__((ext_vector_type(4)));
constexpr int BM = 256, BK = 64, HALF = 128, HTB = HALF * BK * 2  , STAGE_BYTES = 8 * HTB, NXCD = 8, WGM = 8;

__host__ __device__ __forceinline__ int lds_byte(int r, int c) { const int st = (r >> 4) * 2 + (c >> 5), rr = r & 15, cc = c & 31, ob = rr * 64 + cc * 2; return st * 1024 + (ob ^ (((ob >> 9) & 1) << 5)); }
__host__ __device__ __forceinline__ void stage_rc(int b, int& R, int& C) { const int st = b / 1024, sb = b % 1024, swz = sb ^ (((sb >> 9) & 1) << 5); R = (st >> 1) * 16 + swz / 64; C = (st & 1) * 32 + (swz % 64) / 2; }
__host__ __device__ __forceinline__ int perm32(int rho) { const int n = rho >> 4, i = rho & 15; return 8 * (i >> 2) + 4 * n + (i & 3); }

struct Unit { int pm, pn; };
struct Gemm { const bf16_t* A; const bf16_t* Bt; int M, N, K; };

struct StaticOrder {
    int nM, nN, nwg, G, c;
    __host__ __device__ void init(int M, int N, int G_, int c_) { nM = M / BM; nN = N / BM; nwg = nM * nN; G = G_; c = c_; }
    __host__ __device__ bool next(int i, Unit& u) const {
        const long L = (long)i * G + c; if (L >= nwg) return false;
        int wgid = (int)L; { const int q = nwg / NXCD, r = nwg % NXCD, xcd = wgid % NXCD, off = wgid / NXCD; wgid = (xcd < r ? xcd * (q + 1) : r * (q + 1) + (xcd - r) * q) + off; }
        const int nig = WGM * nN, gid = wgid / nig, fm = gid * WGM, gsz = (nM - fm) < WGM ? (nM - fm) : WGM;
        u.pm = fm + ((wgid % nig) % gsz); u.pn = (wgid % nig) / gsz; return true;
    }
    __device__ __forceinline__ void a_ready(const Unit&) const {}
    __device__ __forceinline__ void done(const Unit&) const {}
};


__device__ __forceinline__ unsigned cvt_pk_bf16(float lo, float hi) { unsigned r; asm volatile("v_cvt_pk_bf16_f32 %0, %1, %2" : "=v"(r) : "v"(lo), "v"(hi)); return r; }
typedef unsigned u32x2 __attribute__((ext_vector_type(2)));
__device__ __forceinline__ void st4(bf16_t* p, f32x4 v) { u32x2 w; w.x = cvt_pk_bf16(v[0], v[1]); w.y = cvt_pk_bf16(v[2], v[3]); *(u32x2*)p = w; }
__device__ __forceinline__ float sq4(f32x4 v) { return (v[0] * v[0] + v[1] * v[1]) + (v[2] * v[2] + v[3] * v[3]); }
__device__ __forceinline__ void row_ss_add(float* ss, int row, float s, int fq) { s += __shfl_xor(s, 16); s += __shfl_xor(s, 32); if (fq == 0) atomicAdd(ss + row, s); }
__device__ __forceinline__ int seq_pos(int row) { return row < T_P ? (row & (SEQ_P - 1)) : (row - T_P); }
#define PG8_ROWS_BEGIN _Pragma("unroll") for (int ai = 0; ai < 2; ++ai) _Pragma("unroll") for (int m = 0; m < 4; ++m) { const int row = u.pm * BM + ai * HALF + wr * 64 + m * 16 + fr + zo_;
#define PG8_ROWS_END asm volatile("" ::: "memory"); }

struct EpiZ {
    static constexpr bool PERM = false, AFTER_DRAIN = false;
    bf16_t *U, *CQ, *CKV, *KR; float *ssq, *sskv; const float* rope;
    __device__ __forceinline__ void operator()(const f32x4 (&acc)[2][2][4][2], const Unit& u, int wr, int wc, int fr_in, int fq_in) const {
        int zo_ = 0, fr = fr_in, fq = fq_in; asm volatile("" : "+v"(zo_), "+v"(fr), "+v"(fq));
#pragma unroll
        for (int bj = 0; bj < 2; ++bj) {
            const int cc = u.pn * 8 + bj * 4 + wc;
            if (cc < 8) {
                PG8_ROWS_BEGIN
                    bf16_t* p = U + (size_t)row * POOLW + cc * 32 + 4 * fq; st4(p, acc[ai][bj][m][0]); st4(p + 16, acc[ai][bj][m][1]);
                PG8_ROWS_END
            } else if (cc < 20) {
                PG8_ROWS_BEGIN
                    bf16_t* p = CQ + (size_t)row * QLR + (cc - 8) * 32 + 4 * fq; st4(p, acc[ai][bj][m][0]); st4(p + 16, acc[ai][bj][m][1]);
                    row_ss_add(ssq, row, sq4(acc[ai][bj][m][0]) + sq4(acc[ai][bj][m][1]), fq);
                PG8_ROWS_END
            } else if (cc < 28) {
                PG8_ROWS_BEGIN
                    bf16_t* p = CKV + (size_t)row * KVLR + (cc - 20) * 32 + 4 * fq; st4(p, acc[ai][bj][m][0]); st4(p + 16, acc[ai][bj][m][1]);
                    row_ss_add(sskv, row, sq4(acc[ai][bj][m][0]) + sq4(acc[ai][bj][m][1]), fq);
                PG8_ROWS_END
            } else if (cc < 30) {
                const int i0 = 16 * (cc - 28) + 4 * fq;
                PG8_ROWS_BEGIN
                    const float* rp = rope + ((size_t)seq_pos(row) * 32 + i0) * 2;
                    const f32x4 cs0 = *(const f32x4*)rp, cs1 = *(const f32x4*)(rp + 4);
                    const f32x4 x1 = acc[ai][bj][m][0], x2 = acc[ai][bj][m][1];
                    const f32x4 c = {cs0[0], cs0[2], cs1[0], cs1[2]}, s = {cs0[1], cs0[3], cs1[1], cs1[3]};
                    bf16_t* p = KR + (size_t)row * DROPE + i0; st4(p, x1 * c - x2 * s); st4(p + 32, x2 * c + x1 * s);
                PG8_ROWS_END
            }
        }
    }
};
struct EpiQ {
    static constexpr bool PERM = false, AFTER_DRAIN = false;
    bf16_t* Q; const float* ssq; const float* rope;
    __device__ __forceinline__ void operator()(const f32x4 (&acc)[2][2][4][2], const Unit& u, int wr, int wc, int fr_in, int fq_in) const {
        int zo_ = 0, fr = fr_in, fq = fq_in; asm volatile("" : "+v"(zo_), "+v"(fr), "+v"(fq));
#pragma unroll
        for (int bj = 0; bj < 2; ++bj) {
            const int cc = u.pn * 8 + bj * 4 + wc;
            if (cc >= 36) continue;
            const int h = cc / 6, j6 = cc - 6 * h;
            if (j6 < 4) {
                PG8_ROWS_BEGIN
                    const float rq = QSCALE / sqrtf(ssq[row] * (1.0f / QLR) + EPS);
                    bf16_t* p = Q + (size_t)row * LDQ_ + h * DQK + j6 * 32 + 4 * fq; st4(p, acc[ai][bj][m][0] * rq); st4(p + 16, acc[ai][bj][m][1] * rq);
                PG8_ROWS_END
            } else {
                const int i0 = 16 * (j6 - 4) + 4 * fq;
                PG8_ROWS_BEGIN
                    const float rq = QSCALE / sqrtf(ssq[row] * (1.0f / QLR) + EPS);
                    const float* rp = rope + ((size_t)seq_pos(row) * 32 + i0) * 2;
                    const f32x4 cs0 = *(const f32x4*)rp, cs1 = *(const f32x4*)(rp + 4);
                    const f32x4 x1 = acc[ai][bj][m][0] * rq, x2 = acc[ai][bj][m][1] * rq;
                    const f32x4 c = {cs0[0], cs0[2], cs1[0], cs1[2]}, s = {cs0[1], cs0[3], cs1[1], cs1[3]};
                    bf16_t* p = Q + (size_t)row * LDQ_ + h * DQK + DNOPE + i0; st4(p, x1 * c - x2 * s); st4(p + 32, x2 * c + x1 * s);
                PG8_ROWS_END
            }
        }
    }
};
struct EpiKV {
    static constexpr bool PERM = false, AFTER_DRAIN = false;
    bf16_t *KN, *V; const float* sskv;
    __device__ __forceinline__ void operator()(const f32x4 (&acc)[2][2][4][2], const Unit& u, int wr, int wc, int fr_in, int fq_in) const {
        int zo_ = 0, fr = fr_in, fq = fq_in; asm volatile("" : "+v"(zo_), "+v"(fr), "+v"(fq));
        PG8_ROWS_BEGIN
            const float rk = 1.0f / sqrtf(sskv[row] * (1.0f / KVLR) + EPS);
            const size_t o = (size_t)row * LDKV_ + u.pn * DNOPE + wc * 32 + 4 * fq;
            st4(KN + o, acc[ai][0][m][0] * rk); st4(KN + o + 16, acc[ai][0][m][1] * rk);
            st4(V + o, acc[ai][1][m][0] * rk); st4(V + o + 16, acc[ai][1][m][1] * rk);
        PG8_ROWS_END
    }
};
struct EpiRowScaleSS {
    static constexpr bool PERM = false, AFTER_DRAIN = false;
    bf16_t* O; const float* rs; float rs_div; float* ss;
    __device__ __forceinline__ void operator()(const f32x4 (&acc)[2][2][4][2], const Unit& u, int wr, int wc, int fr_in, int fq_in) const {
        int zo_ = 0, fr = fr_in, fq = fq_in; asm volatile("" : "+v"(zo_), "+v"(fr), "+v"(fq));
        PG8_ROWS_BEGIN
            const float r = rs ? 1.0f / sqrtf(rs[row] * rs_div + EPS) : 1.0f;
            float s = 0.f;
#pragma unroll
            for (int bj = 0; bj < 2; ++bj) {
                const f32x4 v0 = acc[ai][bj][m][0] * r, v1 = acc[ai][bj][m][1] * r;
                bf16_t* p = O + (size_t)row * DM + u.pn * BM + bj * HALF + wc * 32 + 4 * fq; st4(p, v0); st4(p + 16, v1);
                s += sq4(v0) + sq4(v1);
            }
            row_ss_add(ss, row, s, fq);
        PG8_ROWS_END
    }
};
struct EpiGU {
    static constexpr bool PERM = false, AFTER_DRAIN = false;
    bf16_t* ACT;
    __device__ __forceinline__ void operator()(const f32x4 (&acc)[2][2][4][2], const Unit& u, int wr, int wc, int fr_in, int fq_in) const {
        int zo_ = 0, fr = fr_in, fq = fq_in; asm volatile("" : "+v"(zo_), "+v"(fr), "+v"(fq));
        PG8_ROWS_BEGIN
#pragma unroll
            for (int bj = 0; bj < 2; ++bj) {
                const int cc = u.pn * 8 + bj * 4 + wc;
                const f32x4 g = acc[ai][bj][m][0], up = acc[ai][bj][m][1]; f32x4 o;
#pragma unroll
                for (int j = 0; j < 4; ++j) o[j] = g[j] * __builtin_amdgcn_rcpf(1.0f + __builtin_amdgcn_exp2f(-1.4426950408889634f * g[j])) * up[j];
                st4(ACT + (size_t)row * DFF + cc * 16 + 4 * fq, o);
            }
        PG8_ROWS_END
    }
};
#undef PG8_ROWS_BEGIN
#undef PG8_ROWS_END

template <class Epi, class Sched, bool ALIGN_EPI = false, bool SP2 = false>
__device__ __forceinline__ void gemm_phase(PG8_LAS unsigned char* lds, const Gemm g, const Sched& S, const Epi& E) {
    const int tid = threadIdx.x, wid = __builtin_amdgcn_readfirstlane(tid >> 6), lane = tid & 63, wr = wid >> 2, wc = wid & 3, fr = lane & 15, fq = lane >> 4;
    const int K = g.K, nt = K / BK;
    unsigned voffA[2], voffB[2];
#pragma unroll
    for (int i = 0; i < 2; ++i) { int R, C; stage_rc(tid * 16 + i * 8192, R, C); const int Rb = Epi::PERM ? ((R & ~31) + perm32(R & 31)) : R;
        voffA[i] = (unsigned)(R * K + C) * 2u; voffB[i] = (unsigned)(Rb * K + C) * 2u; }
    const size_t kstep = (size_t)(BK * 2);
    const size_t hstep = (size_t)HALF * K * 2;
    const size_t tstep = 2 * hstep;
    const unsigned ldsw = (unsigned)wid * 1024u;
    const int aoff = lds_byte(wr * 64 + fr, fq * 8), boff = lds_byte(wc * 32 + fr, fq * 8);
#define PG8_SA(b, h) (((b) * 2 + (h)) * HTB)
#define PG8_SB(b, h) ((4 + (b) * 2 + (h)) * HTB)
#define PG8_STAGE(bufoff, gbase, voff) do { _Pragma("unroll") for (int _i = 0; _i < 2; ++_i) \
        __builtin_amdgcn_global_load_lds((const unsigned*)((const char*)(gbase) + (voff)[_i]), (PG8_LAS unsigned*)(lds + (bufoff) + ldsw + _i * 8192), 16, 0, 0); } while (0)
#define PG8_LDA(dst, b, h) do { _Pragma("unroll") for (int m = 0; m < 4; ++m) _Pragma("unroll") for (int k = 0; k < 2; ++k) dst[m][k] = *(const PG8_LAS bf16x8*)(lds + PG8_SA(b, h) + aoff + m * 2048 + k * 1024); } while (0)
#define PG8_LDB(dst, b, h) do { _Pragma("unroll") for (int n = 0; n < 2; ++n) _Pragma("unroll") for (int k = 0; k < 2; ++k) dst[n][k] = *(const PG8_LAS bf16x8*)(lds + PG8_SB(b, h) + boff + n * 2048 + k * 1024); } while (0)
#define PG8_MMA(ai, bj, At, Bt) do { __builtin_amdgcn_s_setprio(1); _Pragma("unroll") for (int m = 0; m < 4; ++m) _Pragma("unroll") for (int n = 0; n < 2; ++n) _Pragma("unroll") for (int k = 0; k < 2; ++k) \
        acc[ai][bj][m][n] = __builtin_amdgcn_mfma_f32_16x16x32_bf16(Bt[n][k], At[m][k], acc[ai][bj][m][n], 0, 0, 0); __builtin_amdgcn_s_setprio(0); } while (0)
#define PG8_WAIT_V(n) asm volatile("s_waitcnt vmcnt(" #n ")" ::: "memory")
#define PG8_WAIT_L(n) asm volatile("s_waitcnt lgkmcnt(" #n ")" ::: "memory")
#define PG8_BAR __builtin_amdgcn_s_barrier()
#define PG8_SCHED __builtin_amdgcn_sched_barrier(0)
    Unit cur, nxt; int ui = 0;
    if (!S.next(0, cur)) return;
    f32x4 acc[2][2][4][2];
#pragma unroll
    for (int a = 0; a < 2; ++a)
#pragma unroll
        for (int b = 0; b < 2; ++b)
#pragma unroll
            for (int m = 0; m < 4; ++m)
#pragma unroll
                for (int n = 0; n < 2; ++n) acc[a][b][m][n] = (f32x4){0.f, 0.f, 0.f, 0.f};
    bf16x8 At[4][2], B0[2][2], B1[2][2];
    const char* cA = (const char*)g.A + (size_t)cur.pm * tstep; const char* cB = (const char*)g.Bt + (size_t)cur.pn * tstep;
    S.a_ready(cur);
    if constexpr (SP2) {
        PG8_STAGE(PG8_SB(0, 0), cB, voffB); PG8_STAGE(PG8_SB(0, 1), cB + hstep, voffB); PG8_STAGE(PG8_SA(0, 0), cA, voffA); PG8_STAGE(PG8_SA(0, 1), cA + hstep, voffA);
        if (wr == 1) PG8_BAR;
        PG8_WAIT_V(2); PG8_BAR;
        PG8_STAGE(PG8_SB(1, 0), cB + kstep, voffB); PG8_STAGE(PG8_SA(1, 0), cA + kstep, voffA); PG8_STAGE(PG8_SB(1, 1), cB + hstep + kstep, voffB);
        PG8_WAIT_V(6); PG8_BAR;
    } else {
        PG8_STAGE(PG8_SB(0, 0), cB, voffB); PG8_STAGE(PG8_SA(0, 0), cA, voffA); PG8_STAGE(PG8_SB(0, 1), cB + hstep, voffB); PG8_STAGE(PG8_SA(0, 1), cA + hstep, voffA);
        if (wr == 1) PG8_BAR;
        PG8_WAIT_V(4); PG8_BAR;
        PG8_STAGE(PG8_SB(1, 0), cB + kstep, voffB); PG8_STAGE(PG8_SA(1, 0), cA + kstep, voffA); PG8_STAGE(PG8_SB(1, 1), cB + hstep + kstep, voffB);
        PG8_WAIT_V(6); PG8_BAR;
    }
    for (;;) {
        const bool has_next = S.next(ui + 1, nxt);
        const char* nA = has_next ? (const char*)g.A + (size_t)nxt.pm * tstep : cA; const char* nB = has_next ? (const char*)g.Bt + (size_t)nxt.pn * tstep : cB;
#pragma unroll 1
        for (int t = 0; t < nt; t += 2) {
            const bool last = (t == nt - 2);
            const char* a1 = cA + (size_t)(t + 1) * kstep;
            const char* a2 = last ? nA : cA + (size_t)(t + 2) * kstep; const char* b2 = last ? nB : cB + (size_t)(t + 2) * kstep;
            const char* a3 = a2 + kstep; const char* b3 = b2 + kstep;
            if (last && has_next) S.a_ready(nxt);
            if constexpr (SP2) {
            PG8_LDB(B0, 0, 0); PG8_LDB(B1, 0, 1); PG8_SCHED; PG8_LDA(At, 0, 0); PG8_STAGE(PG8_SA(1, 1), a1 + hstep, voffA);
            PG8_WAIT_V(8); PG8_WAIT_L(0); PG8_BAR; PG8_MMA(0, 0, At, B0); PG8_MMA(0, 1, At, B1); PG8_BAR; PG8_SCHED;
            PG8_LDA(At, 0, 1); PG8_STAGE(PG8_SB(0, 0), b2, voffB); PG8_STAGE(PG8_SB(0, 1), b2 + hstep, voffB); PG8_STAGE(PG8_SA(0, 0), a2, voffA);
            PG8_WAIT_V(8); PG8_WAIT_L(0); PG8_BAR; PG8_MMA(1, 0, At, B0); PG8_MMA(1, 1, At, B1); PG8_BAR; PG8_SCHED;
            PG8_LDB(B0, 1, 0); PG8_LDB(B1, 1, 1); PG8_SCHED; PG8_LDA(At, 1, 0); PG8_STAGE(PG8_SA(0, 1), a2 + hstep, voffA);
            PG8_WAIT_V(8); PG8_WAIT_L(0); PG8_BAR; PG8_MMA(0, 0, At, B0); PG8_MMA(0, 1, At, B1); PG8_BAR; PG8_SCHED;
            PG8_LDA(At, 1, 1); PG8_STAGE(PG8_SB(1, 0), b3, voffB); PG8_STAGE(PG8_SB(1, 1), b3 + hstep, voffB); PG8_STAGE(PG8_SA(1, 0), a3, voffA);
            PG8_WAIT_V(8); PG8_WAIT_L(0); PG8_BAR; PG8_MMA(1, 0, At, B0); PG8_MMA(1, 1, At, B1); PG8_BAR; PG8_SCHED;
            } else {
            PG8_LDB(B0, 0, 0); PG8_SCHED; PG8_LDA(At, 0, 0); PG8_STAGE(PG8_SA(1, 1), a1 + hstep, voffA);
            PG8_WAIT_L(8); PG8_BAR; PG8_WAIT_L(0); PG8_MMA(0, 0, At, B0); PG8_BAR; PG8_SCHED;
            PG8_LDB(B1, 0, 1); PG8_STAGE(PG8_SB(0, 0), b2, voffB);
            PG8_BAR; PG8_WAIT_L(0); PG8_MMA(0, 1, At, B1); PG8_BAR;
            PG8_LDA(At, 0, 1); PG8_STAGE(PG8_SA(0, 0), a2, voffA);
            PG8_BAR; PG8_WAIT_L(0); PG8_MMA(1, 0, At, B0); PG8_BAR; PG8_SCHED;
            PG8_STAGE(PG8_SB(0, 1), b2 + hstep, voffB);
            PG8_WAIT_V(6); PG8_BAR; PG8_MMA(1, 1, At, B1); PG8_BAR;
            PG8_LDB(B0, 1, 0); PG8_SCHED; PG8_LDA(At, 1, 0); PG8_STAGE(PG8_SA(0, 1), a2 + hstep, voffA);
            PG8_WAIT_L(8); PG8_BAR; PG8_WAIT_L(0); PG8_MMA(0, 0, At, B0); PG8_BAR; PG8_SCHED;
            PG8_LDB(B1, 1, 1); PG8_STAGE(PG8_SB(1, 0), b3, voffB);
            PG8_BAR; PG8_WAIT_L(0); PG8_MMA(0, 1, At, B1); PG8_BAR;
            PG8_LDA(At, 1, 1); PG8_STAGE(PG8_SA(1, 0), a3, voffA);
            PG8_BAR; PG8_WAIT_L(0); PG8_MMA(1, 0, At, B0); PG8_BAR; PG8_SCHED;
            PG8_STAGE(PG8_SB(1, 1), b3 + hstep, voffB);
            PG8_WAIT_V(6); PG8_BAR; PG8_MMA(1, 1, At, B1); PG8_BAR;
            }
        }
        if constexpr (ALIGN_EPI) { if (wr == 0) PG8_BAR; }
        if constexpr (!Epi::AFTER_DRAIN) { E(acc, cur, wr, wc, fr, fq); S.done(cur); }
        if (!has_next) break;
#pragma unroll
        for (int a = 0; a < 2; ++a)
#pragma unroll
            for (int b = 0; b < 2; ++b)
#pragma unroll
                for (int m = 0; m < 4; ++m)
#pragma unroll
                    for (int n = 0; n < 2; ++n) acc[a][b][m][n] = (f32x4){0.f, 0.f, 0.f, 0.f};
        cur = nxt; cA = nA; cB = nB; ++ui;
        if constexpr (ALIGN_EPI) { if (wr == 1) PG8_BAR; }
    }
    PG8_WAIT_V(0);
    if constexpr (!ALIGN_EPI) { if (wr == 0) PG8_BAR; }
    PG8_BAR;
    if constexpr (Epi::AFTER_DRAIN) { E.fused(acc, cur, wr, wc, fr, fq, lds, wid, lane); S.done(cur); }
#undef PG8_SA
#undef PG8_SB
#undef PG8_STAGE
#undef PG8_LDA
#undef PG8_LDB
#undef PG8_MMA
#undef PG8_WAIT_V
#undef PG8_WAIT_L
#undef PG8_BAR
#undef PG8_SCHED
}
}

namespace att {
using bf16x8 = __attribute__((ext_vector_type(8))) short;
using s16x4  = __attribute__((ext_vector_type(4))) short;
using f32x16 = __attribute__((ext_vector_type(16))) float;
using u32x4  = __attribute__((ext_vector_type(4))) unsigned;
typedef unsigned short bf16_t;
constexpr int NW = 8, QBLK = 32, KVBLK = 64;
constexpr int LDQ = LDQ_, LDKN = LDKV_, LDKR = DROPE, LDV = LDKV_, LDO = DM;
constexpr int SHM_V = 16384, SHM_KN = 16384, SHM_KR = 8192;
constexpr int OFF_V = 0, OFF_KN = 2 * SHM_V, OFF_KR = OFF_KN + 2 * SHM_KN, OFF_WS = OFF_KR + 2 * SHM_KR, ATTN_LDS = OFF_WS + NW * 64 * 4;
constexpr float THRL = 11.5f;
#define KSWZ(row, colB) ((row) * 256 + ((colB) ^ (((row) & 15) << 4)))
#define KRSWZ(row, colB) ((row) * 128 + ((colB) ^ ((((row) >> 1) & 7) << 4)))
#define SBAR() __builtin_amdgcn_sched_barrier(0)
__device__ __forceinline__ int crow(int r, int hi) { return (r & 3) + 8 * (r >> 2) + 4 * hi; }
__device__ __forceinline__ unsigned cvtpk(float lo, float hi) { unsigned r; asm volatile("v_cvt_pk_bf16_f32 %0, %1, %2" : "=v"(r) : "v"(lo), "v"(hi)); return r; }

__device__ __forceinline__ void partialSM(f32x16& p0, f32x16& p1, float& m_reg, float& mn, float& alpha) {
  float pmax = p0[0];
#pragma unroll
  for (int r = 1; r < 16; ++r) pmax = fmaxf(pmax, p0[r]);
#pragma unroll
  for (int r = 0; r < 16; ++r) pmax = fmaxf(pmax, p1[r]);
  { auto rr = __builtin_amdgcn_permlane32_swap(__float_as_uint(pmax), __float_as_uint(pmax), false, false);
    pmax = fmaxf(__uint_as_float(rr[0]), __uint_as_float(rr[1])); }
  if (__builtin_expect(__all(pmax - m_reg <= THRL), 1)) { mn = m_reg; alpha = 1.f; }
  else { mn = fmaxf(m_reg, pmax); alpha = __builtin_amdgcn_exp2f(m_reg - mn); m_reg = mn; }
#pragma unroll
  for (int r = 0; r < 16; ++r) p0[r] = p0[r] - mn;
#pragma unroll
  for (int r = 0; r < 16; ++r) p1[r] = p1[r] - mn;
#pragma unroll
  for (int r = 0; r < 16; ++r) p0[r] = __builtin_amdgcn_exp2f(p0[r]);
}
__device__ __forceinline__ void finishSM(f32x16& p0, f32x16& p1, float alpha, float& l_reg, bf16x8& pa0, bf16x8& pa1, bf16x8& pa2, bf16x8& pa3) {
#pragma unroll
  for (int r = 0; r < 16; ++r) p1[r] = __builtin_amdgcn_exp2f(p1[r]);
  float ps = 0;
#pragma unroll
  for (int r = 0; r < 16; ++r) ps += p0[r];
#pragma unroll
  for (int r = 0; r < 16; ++r) ps += p1[r];
  { auto rr = __builtin_amdgcn_permlane32_swap(__float_as_uint(ps), __float_as_uint(ps), false, false);
    ps = __uint_as_float(rr[0]) + __uint_as_float(rr[1]); }
  l_reg = l_reg * alpha + ps;
#define PK4(P, BASE, OUT) do { unsigned a0 = cvtpk(P[BASE + 0], P[BASE + 1]), a1 = cvtpk(P[BASE + 2], P[BASE + 3]);   \
    unsigned b0 = cvtpk(P[BASE + 4], P[BASE + 5]), b1 = cvtpk(P[BASE + 6], P[BASE + 7]);                              \
    auto r0 = __builtin_amdgcn_permlane32_swap(a0, b0, false, false); auto r1 = __builtin_amdgcn_permlane32_swap(a1, b1, false, false); \
    u32x4 w = {r0[0], r1[0], r0[1], r1[1]}; OUT = *reinterpret_cast<bf16x8*>(&w); } while (0)
  PK4(p0, 0, pa0); PK4(p0, 8, pa1); PK4(p1, 0, pa2); PK4(p1, 8, pa3);
#undef PK4
}
__device__ __forceinline__ void qkt(f32x16& p0, f32x16& p1, const char* Kn, const char* Kr, const bf16x8* qr, int r32, int hi) {
  p0 = f32x16{}; p1 = f32x16{};
#define KFRAG(dst, d0) do { const int cb_ = (((d0) & 7) * 16 + hi * 8) * 2; \
    if ((d0) < 8) { dst[0] = *reinterpret_cast<const bf16x8*>(Kn + KSWZ(r32, cb_)); dst[1] = *reinterpret_cast<const bf16x8*>(Kn + KSWZ(32 + r32, cb_)); } \
    else { dst[0] = *reinterpret_cast<const bf16x8*>(Kr + KRSWZ(r32, cb_)); dst[1] = *reinterpret_cast<const bf16x8*>(Kr + KRSWZ(32 + r32, cb_)); } } while (0)
#define KMMA(src, d0) do { p0 = __builtin_amdgcn_mfma_f32_32x32x16_bf16(src[0], qr[d0], p0, 0, 0, 0); p1 = __builtin_amdgcn_mfma_f32_32x32x16_bf16(src[1], qr[d0], p1, 0, 0, 0); } while (0)
  bf16x8 fa[2], fb[2], fc[2];
  KFRAG(fa, 0); KFRAG(fb, 1); SBAR();
  KFRAG(fc, 2); SBAR(); KMMA(fa, 0); SBAR();
  KFRAG(fa, 3); SBAR(); KMMA(fb, 1); SBAR();
  KFRAG(fb, 4); SBAR(); KMMA(fc, 2); SBAR();
  KFRAG(fc, 5); SBAR(); KMMA(fa, 3); SBAR();
  KFRAG(fa, 6); SBAR(); KMMA(fb, 4); SBAR();
  KFRAG(fb, 7); SBAR(); KMMA(fc, 5); SBAR();
  KFRAG(fc, 8); SBAR(); KMMA(fa, 6); SBAR();
  KFRAG(fa, 9); SBAR(); KMMA(fb, 7); SBAR();
  KFRAG(fb, 10); SBAR(); KMMA(fc, 8); SBAR();
  KFRAG(fc, 11); SBAR(); KMMA(fa, 9); SBAR();
  KMMA(fb, 10); KMMA(fc, 11);
#undef KFRAG
#undef KMMA
}
__device__ __forceinline__ int v_st(int k, int c) { const int kk = (k & ~0xC) | ((k & 4) << 1) | ((k & 8) >> 1); return ((kk >> 3) * 4 + (c >> 5)) * 512 + ((kk & 7) * 32 + (c & 31)) * 2; }
__device__ __forceinline__ int v_rd_base(int lane) { return ((lane & 3) << 3) | (((lane >> 2) & 3) << 6) | (((lane >> 4) & 1) << 5) | (((lane >> 5) & 1) << 8); }
constexpr int v_rd_off(int d0, int ks, int half) { return d0 * 512 + ks * 4096 + half * 2048; }
template <int OFF> __device__ __forceinline__ s16x4 tr_read(int vb) {
  s16x4 r; asm volatile("ds_read_b64_tr_b16 %0, %1 offset:%2" : "=&v"(r) : "v"(vb), "i"(OFF) : "memory"); return r;
}
template <int D0> __device__ __forceinline__ void pv_one(f32x16& od, int vb, bf16x8 pa0, bf16x8 pa1, bf16x8 pa2, bf16x8 pa3) {
  const s16x4 l0 = tr_read<v_rd_off(D0, 0, 0)>(vb), h0 = tr_read<v_rd_off(D0, 0, 1)>(vb), l1 = tr_read<v_rd_off(D0, 1, 0)>(vb), h1 = tr_read<v_rd_off(D0, 1, 1)>(vb);
  const s16x4 l2 = tr_read<v_rd_off(D0, 2, 0)>(vb), h2 = tr_read<v_rd_off(D0, 2, 1)>(vb), l3 = tr_read<v_rd_off(D0, 3, 0)>(vb), h3 = tr_read<v_rd_off(D0, 3, 1)>(vb);
  asm volatile("s_waitcnt lgkmcnt(0)" ::: "memory"); SBAR();
#define PK(L, H) (bf16x8){L[0], L[1], L[2], L[3], H[0], H[1], H[2], H[3]}
  od = __builtin_amdgcn_mfma_f32_32x32x16_bf16(pa0, PK(l0, h0), od, 0, 0, 0);
  od = __builtin_amdgcn_mfma_f32_32x32x16_bf16(pa1, PK(l1, h1), od, 0, 0, 0);
  od = __builtin_amdgcn_mfma_f32_32x32x16_bf16(pa2, PK(l2, h2), od, 0, 0, 0);
  od = __builtin_amdgcn_mfma_f32_32x32x16_bf16(pa3, PK(l3, h3), od, 0, 0, 0);
#undef PK
}
__device__ __forceinline__ void pv_d0(f32x16* o, int vb, bf16x8 pa0, bf16x8 pa1, bf16x8 pa2, bf16x8 pa3) {
  pv_one<0>(o[0], vb, pa0, pa1, pa2, pa3); pv_one<1>(o[1], vb, pa0, pa1, pa2, pa3); pv_one<2>(o[2], vb, pa0, pa1, pa2, pa3); pv_one<3>(o[3], vb, pa0, pa1, pa2, pa3);
}

__device__ __forceinline__ void sm_half(f32x16& p, float& m_reg, float& l_reg, float& alpha, bf16x8& paL, bf16x8& paH) {
  float a = fmaxf(fmaxf(p[0], p[1]), p[2]), b = fmaxf(fmaxf(p[3], p[4]), p[5]);
  a = fmaxf(fmaxf(a, p[6]), p[7]); b = fmaxf(fmaxf(b, p[8]), p[9]); a = fmaxf(fmaxf(a, p[10]), p[11]); b = fmaxf(fmaxf(b, p[12]), p[13]); a = fmaxf(fmaxf(a, p[14]), p[15]);
  float pmax = fmaxf(a, b);
  { auto rr = __builtin_amdgcn_permlane32_swap(__float_as_uint(pmax), __float_as_uint(pmax), false, false);
    pmax = fmaxf(__uint_as_float(rr[0]), __uint_as_float(rr[1])); }
  const bool keep = __all(pmax - m_reg <= THRL);
  const float mn = keep ? m_reg : fmaxf(m_reg, pmax);
  alpha = __builtin_amdgcn_exp2f(m_reg - mn); m_reg = mn;
#pragma unroll
  for (int r = 0; r < 16; ++r) p[r] = __builtin_amdgcn_exp2f(p[r] - mn);
  float ps = 0;
#pragma unroll
  for (int r = 0; r < 16; ++r) ps += p[r];
  { auto rr = __builtin_amdgcn_permlane32_swap(__float_as_uint(ps), __float_as_uint(ps), false, false);
    ps = __uint_as_float(rr[0]) + __uint_as_float(rr[1]); }
  l_reg = l_reg * alpha + ps;
#define PK4(P, BASE, OUT) do { unsigned a0 = cvtpk(P[BASE + 0], P[BASE + 1]), a1 = cvtpk(P[BASE + 2], P[BASE + 3]);   \
    unsigned b0 = cvtpk(P[BASE + 4], P[BASE + 5]), b1 = cvtpk(P[BASE + 6], P[BASE + 7]);                              \
    auto r0 = __builtin_amdgcn_permlane32_swap(a0, b0, false, false); auto r1 = __builtin_amdgcn_permlane32_swap(a1, b1, false, false); \
    u32x4 w = {r0[0], r1[0], r0[1], r1[1]}; OUT = *reinterpret_cast<bf16x8*>(&w); } while (0)
  PK4(p, 0, paL); PK4(p, 8, paH);
#undef PK4
}
template <int H> __device__ __forceinline__ void qkt_half(f32x16& p, const char* Kn, const char* Kr, const bf16x8* qr, int r32, int hi) {
  p = f32x16{};
#pragma unroll
  for (int d0 = 0; d0 < 8; ++d0) { const int cb = (d0 * 16 + hi * 8) * 2;
    const bf16x8 f = *reinterpret_cast<const bf16x8*>(Kn + KSWZ(32 * H + r32, cb)); p = __builtin_amdgcn_mfma_f32_32x32x16_bf16(f, qr[d0], p, 0, 0, 0); }
#pragma unroll
  for (int d0 = 0; d0 < 4; ++d0) { const int cb = (d0 * 16 + hi * 8) * 2;
    const bf16x8 f = *reinterpret_cast<const bf16x8*>(Kr + KRSWZ(32 * H + r32, cb)); p = __builtin_amdgcn_mfma_f32_32x32x16_bf16(f, qr[8 + d0], p, 0, 0, 0); }
}
struct VFrag { s16x4 l0, h0, l1, h1; };
template <int H, int D0> __device__ __forceinline__ VFrag pv_rd(int vb) {
  VFrag f; f.l0 = tr_read<v_rd_off(D0, 2 * H, 0)>(vb); f.h0 = tr_read<v_rd_off(D0, 2 * H, 1)>(vb); f.l1 = tr_read<v_rd_off(D0, 2 * H + 1, 0)>(vb); f.h1 = tr_read<v_rd_off(D0, 2 * H + 1, 1)>(vb); return f;
}
__device__ __forceinline__ void pv_mma(f32x16& od, VFrag& f, bf16x8 paL, bf16x8 paH) {
#define PK(L, Hh) (bf16x8){L[0], L[1], L[2], L[3], Hh[0], Hh[1], Hh[2], Hh[3]}
  od = __builtin_amdgcn_mfma_f32_32x32x16_bf16(paL, PK(f.l0, f.h0), od, 0, 0, 0);
  od = __builtin_amdgcn_mfma_f32_32x32x16_bf16(paH, PK(f.l1, f.h1), od, 0, 0, 0);
#undef PK
}
#define VWAIT(N, f) asm volatile("s_waitcnt lgkmcnt(" #N ")" : "+v"(f.l0), "+v"(f.h0), "+v"(f.l1), "+v"(f.h1) :: "memory")
template <int H> __device__ __forceinline__ void pv_half(f32x16* o, int vb, bf16x8 paL, bf16x8 paH) {
  VFrag fa = pv_rd<H, 0>(vb), fb = pv_rd<H, 1>(vb);
  VWAIT(4, fa); pv_mma(o[0], fa, paL, paH);
  fa = pv_rd<H, 2>(vb);
  VWAIT(4, fb); pv_mma(o[1], fb, paL, paH);
  fb = pv_rd<H, 3>(vb);
  VWAIT(4, fa); pv_mma(o[2], fa, paL, paH);
  VWAIT(0, fb); pv_mma(o[3], fb, paL, paH);
}
#undef VWAIT

__device__ __forceinline__ void attn_unit(const bf16_t* __restrict__ Qb, const bf16_t* __restrict__ KNh, const bf16_t* __restrict__ KRs, const bf16_t* __restrict__ Vh,
                                          bf16_t* __restrict__ Ob, float* __restrict__ ssa, int seq, char* lds) {
  const int tid = threadIdx.x, wid = __builtin_amdgcn_readfirstlane(tid >> 6), lane = tid & 63, r32 = lane & 31, hi = lane >> 5;
  char* V_lds = lds + OFF_V; char* KN_lds = lds + OFF_KN; char* KR_lds = lds + OFF_KR;
  float* ws = (float*)(lds + OFF_WS) + wid * 64; float* li_l = ws; float* al_l = ws + 32;
  float m_reg = -1e30f, l_reg = 0; f32x16 o[4] = {}; bf16x8 qr[12];
  const bf16_t* Qw = Qb + (long)(wid * QBLK + r32) * LDQ + hi * 8;
#pragma unroll
  for (int d0 = 0; d0 < 12; ++d0) qr[d0] = *reinterpret_cast<const bf16x8*>(Qw + d0 * 16);
  const int vb0 = (int)(uintptr_t)V_lds + v_rd_base(lane);
  unsigned kn_off[2], v_off[2], kr_off;
#pragma unroll
  for (int i = 0; i < 2; ++i) {
    const int q = (wid * 2 + i) * 64 + lane;
    { const int row = q >> 4, c = (q & 15) ^ (row & 15); kn_off[i] = (unsigned)(row * LDKN * 2 + c * 16); }
    { const int sub = q >> 5, kk = (sub >> 2) * 8 + ((q & 31) >> 2), cc = (sub & 3) * 32 + (q & 3) * 8, k = (kk & ~0xC) | ((kk & 4) << 1) | ((kk & 8) >> 1);
      v_off[i] = (unsigned)(k * LDV * 2 + cc * 2); }
  }
  { const int q = wid * 64 + lane, row = q >> 3, c = (q & 7) ^ ((row >> 1) & 7); kr_off = (unsigned)(row * LDKR * 2 + c * 16); }
  typedef __attribute__((address_space(3))) unsigned lds_u32;
#define GLDS(gp, lp) __builtin_amdgcn_global_load_lds((const unsigned*)(gp), (lds_u32*)(lp), 16, 0, 0)
#define DMA_K(k0, s) do { const char* kb_ = (const char*)KNh + (size_t)(k0) * (LDKN * 2); const char* rb_ = (const char*)KRs + (size_t)(k0) * (LDKR * 2); \
    GLDS(kb_ + kn_off[0], KN_lds + (s) * SHM_KN + (wid * 2) * 1024); GLDS(kb_ + kn_off[1], KN_lds + (s) * SHM_KN + (wid * 2 + 1) * 1024); \
    GLDS(rb_ + kr_off, KR_lds + (s) * SHM_KR + wid * 1024); } while (0)
#define DMA_V(k0, off) do { const char* vb_ = (const char*)Vh + (size_t)(k0) * (LDV * 2); \
    GLDS(vb_ + v_off[0], V_lds + (off) + (wid * 2) * 1024); GLDS(vb_ + v_off[1], V_lds + (off) + (wid * 2 + 1) * 1024); } while (0)
#define RESC(a) do { if (__any((a) < 1.f)) { if (hi == 0) al_l[r32] = (a); asm volatile("s_waitcnt lgkmcnt(0)" ::: "memory"); \
    _Pragma("unroll") for (int d = 0; d < 4; ++d) _Pragma("unroll") for (int r = 0; r < 16; ++r) o[d][r] *= al_l[crow(r, hi)]; } } while (0)
  f32x16 p0, p1; float al0, al1; bf16x8 pa0, pa1, pa2, pa3; const int NT = seq / KVBLK;
#define STEP(b, j) do { \
    if ((j) + 1 < NT) { DMA_K(((j) + 1) * KVBLK, (b) ^ 1); DMA_V(((j) + 1) * KVBLK, ((b) ^ 1) * SHM_V); } SBAR(); \
    qkt_half<0>(p0, KN_lds + (b) * SHM_KN, KR_lds + (b) * SHM_KR, qr, r32, hi); SBAR(); \
    qkt_half<1>(p1, KN_lds + (b) * SHM_KN, KR_lds + (b) * SHM_KR, qr, r32, hi); sm_half(p0, m_reg, l_reg, al0, pa0, pa1); SBAR(); \
    RESC(al0); SBAR(); \
    pv_half<0>(o, vb0 + (b) * SHM_V, pa0, pa1); sm_half(p1, m_reg, l_reg, al1, pa2, pa3); SBAR(); \
    RESC(al1); SBAR(); \
    pv_half<1>(o, vb0 + (b) * SHM_V, pa2, pa3); \
    asm volatile("s_waitcnt vmcnt(0)" ::: "memory"); __syncthreads(); } while (0)
  DMA_K(0, 0); DMA_V(0, 0);
  asm volatile("s_waitcnt vmcnt(0)" ::: "memory"); __syncthreads();
#pragma unroll 1
  for (int j = 0; j < NT; j += 2) { STEP(0, j); STEP(1, j + 1); }
#undef STEP
  if (hi == 0) li_l[r32] = l_reg; asm volatile("s_waitcnt lgkmcnt(0)" ::: "memory");
  int zo = 0; asm volatile("" : "+v"(zo));
  bf16_t* Ow = Ob + (long)(wid * QBLK) * LDO; float* ssw = ssa + wid * QBLK;
#pragma unroll
  for (int r = 0; r < 16; ++r) { const int orow = crow(r, hi) + zo; const float rl = __builtin_amdgcn_rcpf(li_l[orow]); float s = 0.f;
#pragma unroll
    for (int d0 = 0; d0 < 4; ++d0) { const float v = o[d0][r] * rl; s += v * v; Ow[(long)orow * LDO + d0 * 32 + r32] = (bf16_t)(cvtpk(v, v) & 0xffffu); }
    s += __shfl_xor(s, 1); s += __shfl_xor(s, 2); s += __shfl_xor(s, 4); s += __shfl_xor(s, 8); s += __shfl_xor(s, 16);
    if (r32 == 0) atomicAdd(ssw + orow, s); }
  __syncthreads();
#undef GLDS
#undef DMA_K
#undef DMA_V
#undef RESC
}
#undef KSWZ
#undef KRSWZ
#undef SBAR
}

constexpr int NWAVES = 8, NTHREADS = 512;
constexpr size_t MiB = 1u << 20;
constexpr size_t WS_SS = 0;
constexpr size_t WS_MOD = 2 * MiB;
constexpr size_t WS_ROPE = 3 * MiB;
constexpr size_t WS_WIN = 7 * MiB, WS_WUQ = 9 * MiB, WS_WUKV = 10 * MiB, WS_WOUT = 11 * MiB, WS_WGU = 13 * MiB, WS_WD = 24 * MiB;
constexpr size_t WS_HB = 32 * MiB;
constexpr size_t WS_U = 192 * MiB, WS_CQ = 232 * MiB, WS_CKV = 292 * MiB, WS_KR = 332 * MiB;
constexpr size_t WS_Q = 342 * MiB, WS_KN = 522 * MiB, WS_V = 642 * MiB, WS_END = 922 * MiB;
constexpr size_t WS_MX = WS_HB;
constexpr size_t WS_MG = 762 * MiB;
constexpr size_t WS_ACT = WS_U;
constexpr size_t WS_F = WS_HB;
static_assert(WS_ACT + (size_t)TT * DFF * 2 <= WS_MG && WS_MG + (size_t)TT * DM * 2 <= WS_END && WS_HB + (size_t)TT * DM * 2 <= WS_ACT && WS_WD + (size_t)DM * DFF * 2 <= WS_HB, "d_ws map");
constexpr int LDS_BYTES = 147456;
constexpr int MISC_OFF = 131072 + 320;
constexpr size_t WS_BAR = 1835008;

#define LAS __attribute__((address_space(3)))
typedef unsigned short bf16;
typedef float f32x4 __attribute__((ext_vector_type(4)));
typedef unsigned v4u __attribute__((ext_vector_type(4)));
typedef unsigned v2u __attribute__((ext_vector_type(2)));
__device__ __forceinline__ unsigned pkbf(float lo, float hi) { unsigned r; asm volatile("v_cvt_pk_bf16_f32 %0, %1, %2" : "=v"(r) : "v"(lo), "v"(hi)); return r; }
__device__ __forceinline__ float bf2f(unsigned short b) { return __uint_as_float((unsigned)b << 16); }
__device__ __forceinline__ float wave_sum(float v) {
#pragma unroll
    for (int o = 1; o < 64; o <<= 1) v += __shfl_xor(v, o);
    return v;
}

struct Params { const float* in[23]; float* out; unsigned char* ws; int ph_lo, ph_hi; };
enum { I_XP = 0, I_XS, I_CP, I_CS, I_WADA, I_BADA, I_GMIXPRE, I_GMIXPOST, I_WIN, I_POOLW, I_POOLSCALE, I_GQA, I_WUQ, I_GKVA, I_WUKV, I_GPOOLOUT, I_GATTNOUT, I_WOUT, I_GFFNPRE, I_GFFNPOST, I_WGATE, I_WUP, I_WDOWN };

struct WSrc { const float* p; int col; };
__device__ __forceinline__ WSrc wmap(const Params& a, int mat, int n) {
    if (mat == 0) {
        if (n >= 960) return {nullptr, 0};
        if (n < 896) return {a.in[I_WIN], n};
        const int pp = n - 896, ch = pp >> 5, w = pp & 31, nn = w >> 4, i = 16 * ch + (w & 15); return {a.in[I_WIN], 896 + i + 32 * nn};
    } else if (mat == 1) {
        const int cc = n >> 5, w = n & 31; if (cc >= 36) return {nullptr, 0};
        const int h = cc / 6, j6 = cc - 6 * h;
        if (j6 < 4) return {a.in[I_WUQ], h * DQK + 32 * j6 + w};
        const int nn = w >> 4, i = 16 * (j6 - 4) + (w & 15); return {a.in[I_WUQ], h * DQK + DNOPE + i + 32 * nn};
    } else if (mat == 2) return {a.in[I_WUKV], n};
    else if (mat == 3) return {a.in[I_WOUT], n};
    else if (mat == 4) { const int cc = n >> 5, w = n & 31, nn = w >> 4; return {nn ? a.in[I_WUP] : a.in[I_WGATE], 16 * cc + (w & 15)}; }
    return {a.in[I_WDOWN], n};
}
__device__ __forceinline__ float wgain(const Params& a, int mat, int k) {
    if (mat == 1) return a.in[I_GQA][k];
    if (mat == 2) return a.in[I_GKVA][k];
    if (mat == 3) return k < POOLW ? a.in[I_GPOOLOUT][k] : a.in[I_GATTNOUT][k - POOLW];
    return 1.0f;
}
__device__ __forceinline__ void p0_transpose_item(const Params& a, int mat, int K, int Nsrc, int Ndst, bf16* WT, LAS float* scr, int item, int lane) {
    const int nblk = Ndst / 32, kb = item / nblk, nb = item % nblk, k0 = 64 * kb, n0 = 32 * nb;
    const WSrc s = wmap(a, mat, n0 + (lane & 31));
#pragma unroll 8
    for (int i = 0; i < 32; ++i) { const int kk = 2 * i + (lane >> 5); scr[kk * 33 + (lane & 31)] = s.p ? s.p[(size_t)(k0 + kk) * Nsrc + s.col] * wgain(a, mat, k0 + kk) : 0.f; }
    asm volatile("s_waitcnt lgkmcnt(0)" ::: "memory");
    const int c = lane & 7;
#pragma unroll
    for (int j = 0; j < 4; ++j) { const int n = (lane >> 3) + 8 * j; const LAS float* sp = scr + (8 * c) * 33 + n;
        v4u o; o.x = pkbf(sp[0 * 33], sp[1 * 33]); o.y = pkbf(sp[2 * 33], sp[3 * 33]); o.z = pkbf(sp[4 * 33], sp[5 * 33]); o.w = pkbf(sp[6 * 33], sp[7 * 33]);
        *(v4u*)(WT + (size_t)(n0 + n) * K + k0 + 8 * c) = o; }
    asm volatile("s_waitcnt lgkmcnt(0)" ::: "memory");
}
__constant__ double INV_FREQ[32] = {1.0, 0.7498942093324559, 0.5623413251903491, 0.4216965034285822, 0.31622776601683794, 0.23713737056616552, 0.1778279410038923, 0.1333521432163324,
    0.1, 0.07498942093324558, 0.05623413251903491, 0.042169650342858224, 0.03162277660168379, 0.023713737056616554, 0.01778279410038923, 0.01333521432163324,
    0.01, 0.007498942093324558, 0.005623413251903491, 0.004216965034285823, 0.0031622776601683794, 0.0023713737056616554, 0.0017782794100389228, 0.001333521432163324,
    0.001, 0.0007498942093324559, 0.0005623413251903491, 0.00042169650342858224, 0.00031622776601683794, 0.00023713737056616554, 0.00017782794100389227, 0.0001333521432163324};
__device__ __forceinline__ void rope_entry(float* dst, int s, int i) {
    const double ang = (double)s * INV_FREQ[i];
    const double q = __builtin_rint(ang * 0.6366197723675814);
    double r = __builtin_fma(-q, 1.5707963267948966, ang); r = __builtin_fma(-q, 6.123233995736766e-17, r);
    const double r2 = r * r;
    const double sn = r * (1.0 + r2 * (-1.0 / 6 + r2 * (1.0 / 120 + r2 * (-1.0 / 5040 + r2 * (1.0 / 362880 + r2 * (-1.0 / 39916800 + r2 * (1.0 / 6227020800.0)))))));
    const double cn = 1.0 + r2 * (-0.5 + r2 * (1.0 / 24 + r2 * (-1.0 / 720 + r2 * (1.0 / 40320 + r2 * (-1.0 / 3628800 + r2 * (1.0 / 479001600 + r2 * (-1.0 / 87178291200.0)))))));
    const int qi = (int)((long long)q & 3);
    const double c = (qi == 0) ? cn : (qi == 1) ? -sn : (qi == 2) ? -cn : sn;
    const double sv = (qi == 0) ? sn : (qi == 1) ? cn : (qi == 2) ? -sn : -cn;
    dst[0] = (float)c; dst[1] = (float)sv;
}
__device__ __forceinline__ void p0a_prologue(const Params& a, LAS unsigned char* lds) {
    const int tid = threadIdx.x, lane = tid & 63, wave = __builtin_amdgcn_readfirstlane(tid >> 6);
    unsigned char* ws = a.ws;
    const int G = gridDim.x, gw = blockIdx.x * NWAVES + wave, NGW = G * NWAVES, gt = blockIdx.x * NTHREADS + tid, NGT = G * NTHREADS;
    { f32x4* z = (f32x4*)(ws + WS_SS); for (int i = gt; i < 5 * TT / 4; i += NGT) z[i] = (f32x4){0.f, 0.f, 0.f, 0.f}; }
    { float* rt = (float*)(ws + WS_ROPE); for (int i = gt; i < SEQ_S * 32; i += NGT) rope_entry(rt + 2 * (size_t)i, i >> 5, i & 31); }
    {
        LAS float* scr = (LAS float*)(lds + wave * 16384);
        constexpr int I0 = 16 * 32, I1 = 6 * 40, I2 = 4 * 48, I3 = 16 * 32, I4 = 16 * 176, I5 = 44 * 32;
        constexpr int NITEMS = I0 + I1 + I2 + I3 + I4 + I5;
        for (int it = gw; it < NITEMS; it += NGW) {
            int r = it;
            if (r < I0) { p0_transpose_item(a, 0, DM, 960, 1024, (bf16*)(ws + WS_WIN), scr, r, lane); continue; } r -= I0;
            if (r < I1) { p0_transpose_item(a, 1, QLR, LDQ_, 1280, (bf16*)(ws + WS_WUQ), scr, r, lane); continue; } r -= I1;
            if (r < I2) { p0_transpose_item(a, 2, KVLR, 1536, 1536, (bf16*)(ws + WS_WUKV), scr, r, lane); continue; } r -= I2;
            if (r < I3) { p0_transpose_item(a, 3, DM, DM, DM, (bf16*)(ws + WS_WOUT), scr, r, lane); continue; } r -= I3;
            if (r < I4) { p0_transpose_item(a, 4, DM, DFF, 2 * DFF, (bf16*)(ws + WS_WGU), scr, r, lane); continue; } r -= I4;
            p0_transpose_item(a, 5, DFF, DM, DM, (bf16*)(ws + WS_WD), scr, r, lane);
        }
    }
    __syncthreads();
    for (int bb = blockIdx.x; bb < 96; bb += G) {
        float accb[NBATCH];
#pragma unroll
        for (int b = 0; b < NBATCH; ++b) accb[b] = 0.f;
        const float* wa = a.in[I_WADA] + bb * 64 + lane;
        for (int k0 = wave * 128; k0 < wave * 128 + 128; k0 += 16) {
            float w[16];
#pragma unroll
            for (int kk = 0; kk < 16; ++kk) w[kk] = wa[(size_t)(k0 + kk) * 6144];
#pragma unroll
            for (int kk = 0; kk < 16; ++kk) {
#pragma unroll
                for (int b = 0; b < NBATCH; ++b) { const float c = (b < 8) ? a.in[I_CP][b * DM + k0 + kk] : a.in[I_CS][k0 + kk]; accb[b] += (c / (1.0f + __expf(-c))) * w[kk]; } }
        }
        LAS float* red = (LAS float*)lds;
#pragma unroll
        for (int b = 0; b < NBATCH; ++b) red[(wave * NBATCH + b) * 64 + lane] = accb[b];
        __syncthreads();
        for (int idx = tid; idx < NBATCH * 64; idx += NTHREADS) { const int b = idx >> 6, l = idx & 63; float s = a.in[I_BADA][bb * 64 + l];
#pragma unroll
            for (int w = 0; w < 8; ++w) s += red[(w * NBATCH + b) * 64 + l];
            ((float*)(ws + WS_MOD))[b * 6144 + bb * 64 + l] = s; }
        __syncthreads();
    }
}

__device__ __forceinline__ const float* xrow_ptr(const Params& a, int t) { return t < T_P ? a.in[I_XP] + (size_t)t * DM : a.in[I_XS] + (size_t)(t - T_P) * DM; }
__device__ __forceinline__ int batch_of(int t) { return t < T_P ? (t >> 13) : 8; }
__device__ __forceinline__ void st4bf(bf16* p, f32x4 v) { v2u w; w.x = pkbf(v[0], v[1]); w.y = pkbf(v[2], v[3]); *(v2u*)p = w; }
__device__ __forceinline__ f32x4 ld4bf(const bf16* p) { const v2u w = *(const v2u*)p; return (f32x4){__uint_as_float(w.x << 16), __uint_as_float(w.x & 0xffff0000u), __uint_as_float(w.y << 16), __uint_as_float(w.y & 0xffff0000u)}; }

__device__ __forceinline__ void wave_sum2(float& a, float& b) {
#pragma unroll
    for (int o = 1; o < 64; o <<= 1) { const float ta = __shfl_xor(a, o), tb = __shfl_xor(b, o); a += ta; b += tb; }
}
__device__ __forceinline__ float ssq4(f32x4 v) { return (v[0] * v[0] + v[1] * v[1]) + (v[2] * v[2] + v[3] * v[3]); }
#define ROWS_SETUP const int tid = threadIdx.x, lane = tid & 63, wave = __builtin_amdgcn_readfirstlane(tid >> 6); \
    const int NGW = gridDim.x * NWAVES, gw = blockIdx.x * NWAVES + wave, per = (((TT + NGW - 1) / NGW) + 1) & ~1, t_lo = gw * per, t_hi = min(TT, t_lo + per); (void)tid;
__device__ __forceinline__ void p0b_rows(const Params& a) {
    ROWS_SETUP
    const float* mod = (const float*)(a.ws + WS_MOD); bf16* HB = (bf16*)(a.ws + WS_HB);
    int bcur = -1; f32x4 A0[4], S1[4];
    for (int t = t_lo; t < t_hi; t += 2) {
        const int b = batch_of(t);
        if (b != bcur) { bcur = b;
#pragma unroll
            for (int j = 0; j < 4; ++j) { const int c = 4 * lane + 256 * j; const f32x4 g = *(const f32x4*)(a.in[I_GMIXPRE] + c), sc = *(const f32x4*)(mod + b * 6144 + 1024 + c);
                A0[j] = g * (sc + 1.0f); S1[j] = *(const f32x4*)(mod + b * 6144 + c); } }
        const f32x4* xr = (const f32x4*)xrow_ptr(a, t) + lane; f32x4 v[2][4]; float s0 = 0.f, s1 = 0.f;
#pragma unroll
        for (int j = 0; j < 4; ++j) { v[0][j] = xr[64 * j]; v[1][j] = xr[256 + 64 * j]; }
#pragma unroll
        for (int j = 0; j < 4; ++j) { s0 += ssq4(v[0][j]); s1 += ssq4(v[1][j]); }
        wave_sum2(s0, s1);
        const float r0 = 1.0f / sqrtf(s0 * (1.0f / DM) + EPS), r1 = 1.0f / sqrtf(s1 * (1.0f / DM) + EPS);
#pragma unroll
        for (int j = 0; j < 4; ++j) { st4bf(HB + (size_t)t * DM + 4 * lane + 256 * j, v[0][j] * r0 * A0[j] + S1[j]); st4bf(HB + (size_t)(t + 1) * DM + 4 * lane + 256 * j, v[1][j] * r1 * A0[j] + S1[j]); }
    }
}
__device__ __forceinline__ void p6_rows(const Params& a) {
    ROWS_SETUP
    const float* mod = (const float*)(a.ws + WS_MOD); bf16* HB = (bf16*)(a.ws + WS_HB); const bf16* MG = (const bf16*)(a.ws + WS_MG);
    const float* ssm = (const float*)(a.ws + WS_SS) + 3 * (size_t)TT;
    int bcur = -1; f32x4 A1[4], B2[4], S2[4];
    for (int t = t_lo; t < t_hi; t += 2) {
        const int b = batch_of(t);
        if (b != bcur) { bcur = b;
#pragma unroll
            for (int j = 0; j < 4; ++j) { const int c = 4 * lane + 256 * j;
                A1[j] = *(const f32x4*)(mod + b * 6144 + 2048 + c) * *(const f32x4*)(a.in[I_GMIXPOST] + c);
                B2[j] = *(const f32x4*)(a.in[I_GFFNPRE] + c) * (*(const f32x4*)(mod + b * 6144 + 4096 + c) + 1.0f);
                S2[j] = *(const f32x4*)(mod + b * 6144 + 3072 + c); } }
        const float rm0 = 1.0f / sqrtf(ssm[t] * (1.0f / DM) + EPS), rm1 = 1.0f / sqrtf(ssm[t + 1] * (1.0f / DM) + EPS);
        const f32x4* xr = (const f32x4*)xrow_ptr(a, t) + lane; f32x4 v[2][4], mg[2][4]; float s0 = 0.f, s1 = 0.f;
#pragma unroll
        for (int j = 0; j < 4; ++j) { v[0][j] = xr[64 * j]; v[1][j] = xr[256 + 64 * j];
            mg[0][j] = ld4bf(MG + (size_t)t * DM + 4 * lane + 256 * j); mg[1][j] = ld4bf(MG + (size_t)(t + 1) * DM + 4 * lane + 256 * j); }
#pragma unroll
        for (int j = 0; j < 4; ++j) { v[0][j] = v[0][j] + A1[j] * (mg[0][j] * rm0); v[1][j] = v[1][j] + A1[j] * (mg[1][j] * rm1); s0 += ssq4(v[0][j]); s1 += ssq4(v[1][j]); }
        wave_sum2(s0, s1);
        const float r0 = 1.0f / sqrtf(s0 * (1.0f / DM) + EPS), r1 = 1.0f / sqrtf(s1 * (1.0f / DM) + EPS);
#pragma unroll
        for (int j = 0; j < 4; ++j) {
            st4bf(HB + (size_t)t * DM + 4 * lane + 256 * j, v[0][j] * r0 * B2[j] + S2[j]); st4bf(HB + (size_t)(t + 1) * DM + 4 * lane + 256 * j, v[1][j] * r1 * B2[j] + S2[j]); }
    }
}
__device__ __forceinline__ void p9_rows(const Params& a) {
    ROWS_SETUP
    const float* mod = (const float*)(a.ws + WS_MOD); const bf16* FB = (const bf16*)(a.ws + WS_F); const bf16* MG = (const bf16*)(a.ws + WS_MG);
    const float* ssm = (const float*)(a.ws + WS_SS) + 3 * (size_t)TT; const float* ssf = (const float*)(a.ws + WS_SS) + 4 * (size_t)TT;
    int bcur = -1; f32x4 A1[4], A2[4];
    for (int t = t_lo; t < t_hi; t += 2) {
        const int b = batch_of(t);
        if (b != bcur) { bcur = b;
#pragma unroll
            for (int j = 0; j < 4; ++j) { const int c = 4 * lane + 256 * j;
                A1[j] = *(const f32x4*)(mod + b * 6144 + 2048 + c) * *(const f32x4*)(a.in[I_GMIXPOST] + c);
                A2[j] = *(const f32x4*)(mod + b * 6144 + 5120 + c) * *(const f32x4*)(a.in[I_GFFNPOST] + c); } }
        const float rm0 = 1.0f / sqrtf(ssm[t] * (1.0f / DM) + EPS), rm1 = 1.0f / sqrtf(ssm[t + 1] * (1.0f / DM) + EPS);
        const float rf0 = 1.0f / sqrtf(ssf[t] * (1.0f / DM) + EPS), rf1 = 1.0f / sqrtf(ssf[t + 1] * (1.0f / DM) + EPS);
        const f32x4* xr = (const f32x4*)xrow_ptr(a, t) + lane; f32x4* orow = (f32x4*)(a.out + (size_t)t * DM) + lane; f32x4 v[2][4], mg[2][4], f[2][4];
#pragma unroll
        for (int j = 0; j < 4; ++j) { v[0][j] = xr[64 * j]; v[1][j] = xr[256 + 64 * j];
            mg[0][j] = ld4bf(MG + (size_t)t * DM + 4 * lane + 256 * j); mg[1][j] = ld4bf(MG + (size_t)(t + 1) * DM + 4 * lane + 256 * j);
            f[0][j] = ld4bf(FB + (size_t)t * DM + 4 * lane + 256 * j); f[1][j] = ld4bf(FB + (size_t)(t + 1) * DM + 4 * lane + 256 * j); }
#pragma unroll
        for (int j = 0; j < 4; ++j) { const f32x4 x10 = v[0][j] + A1[j] * (mg[0][j] * rm0), x11 = v[1][j] + A1[j] * (mg[1][j] * rm1);
            orow[64 * j] = x10 + A2[j] * (f[0][j] * rf0); orow[256 + 64 * j] = x11 + A2[j] * (f[1][j] * rf1); }
    }
}
#undef ROWS_SETUP

__device__ __forceinline__ void pool_phase(const Params& a, LAS unsigned char* lds) {
    const int tid = threadIdx.x, lane = tid & 63, wave = __builtin_amdgcn_readfirstlane(tid >> 6);
    const bf16* U = (const bf16*)(a.ws + WS_U); bf16* MX = (bf16*)(a.ws + WS_MX); const float* ssa = (const float*)(a.ws + WS_SS) + 2 * (size_t)TT;
    LAS float* ps = (LAS float*)lds;
    LAS float* ssl = (LAS float*)(lds + 65536);
    LAS unsigned char* us = lds + 65536 + 1024;
    const int g = wave & 3, half = wave >> 2, d = lane;
    float wreg[64];
#pragma unroll
    for (int c = 0; c < 64; ++c) wreg[c] = a.in[I_POOLW][g * 4096 + c * 64 + d];
    const float pscale = a.in[I_POOLSCALE][64 * g + d];
    for (int tile = blockIdx.x; tile < TT / 64; tile += gridDim.x) {
        const int t0 = tile * 64, sb = t0 < T_P ? (t0 & ~(SEQ_P - 1)) : T_P, se = t0 < T_P ? sb + SEQ_P : TT;
#pragma unroll
        for (int it = 0; it < 5; ++it) { const int idx = tid + NTHREADS * it, rl = idx >> 5, ch8 = idx & 31, tr = t0 - 8 + rl;
            if (tr >= sb && tr < se) *(LAS v4u*)(us + rl * 512 + ch8 * 16) = *(const v4u*)(U + (size_t)tr * POOLW + ch8 * 8); }
        __syncthreads();
#pragma unroll 1
        for (int it = 0; it < 4; ++it) {
            const int idx = tid + NTHREADS * it, tl = idx >> 5, ch8 = idx & 31, t = t0 + tl, w = 2 << (ch8 >> 3);
            const int lo = max(t - (w >> 1), sb), hi = min(t + w - (w >> 1), se);
            float sum[8];
#pragma unroll
            for (int e = 0; e < 8; ++e) sum[e] = 0.f;
            for (int j = lo; j < hi; ++j) { const v4u q = *(const LAS v4u*)(us + (j - t0 + 8) * 512 + ch8 * 16);
#pragma unroll
                for (int e = 0; e < 4; ++e) { sum[2 * e] += __uint_as_float(q[e] << 16); sum[2 * e + 1] += __uint_as_float(q[e] & 0xffff0000u); } }
            const v4u q = *(const LAS v4u*)(us + (tl + 8) * 512 + ch8 * 16); const float inv = 1.0f / (float)(hi - lo);
            f32x4 o0, o1;
#pragma unroll
            for (int e = 0; e < 2; ++e) { o0[2 * e] = sum[2 * e] * inv - __uint_as_float(q[e] << 16); o0[2 * e + 1] = sum[2 * e + 1] * inv - __uint_as_float(q[e] & 0xffff0000u);
                o1[2 * e] = sum[4 + 2 * e] * inv - __uint_as_float(q[2 + e] << 16); o1[2 * e + 1] = sum[5 + 2 * e] * inv - __uint_as_float(q[2 + e] & 0xffff0000u); }
            *(LAS f32x4*)(ps + tl * 256 + ch8 * 8) = o0; *(LAS f32x4*)(ps + tl * 256 + ch8 * 8 + 4) = o1;
        }
        __syncthreads();
        float o[32];
#pragma unroll
        for (int tt = 0; tt < 32; ++tt) { const int tl = half * 32 + tt; float acc = 0.f;
#pragma unroll
            for (int c4 = 0; c4 < 16; ++c4) { const f32x4 pv = *(const LAS f32x4*)(ps + tl * 256 + g * 64 + c4 * 4);
                acc += pv[0] * wreg[4 * c4] + pv[1] * wreg[4 * c4 + 1] + pv[2] * wreg[4 * c4 + 2] + pv[3] * wreg[4 * c4 + 3]; }
            o[tt] = acc * pscale; const float s = wave_sum(o[tt] * o[tt]);
            if (lane == 0) ssl[g * 64 + tl] = s; }
        __syncthreads();
#pragma unroll
        for (int tt = 0; tt < 32; ++tt) { const int tl = half * 32 + tt, t = t0 + tl;
            const float f = sqrtf(ssa[t] * (1.0f / (NH * DV)) + EPS) / sqrtf(((ssl[tl] + ssl[64 + tl]) + (ssl[128 + tl] + ssl[192 + tl])) * (1.0f / POOLW) + EPS);
            MX[(size_t)t * DM + 64 * g + d] = (bf16)(pkbf(o[tt] * f, 0.f) & 0xffffu); }
        __syncthreads();
    }
}
#define XB_TMO      128
#define XB_XCNT(j)  (256  + 64 * (j))
#define XB_XSUB(j)  (1280 + 64 * (j))
#define XB_XGEN(j)  (2304 + 64 * (j))
#define XB_TOP      3328
#define XB_TOPGEN   3392
#define XCD_BAR_WORDS 3456
#define XB_SPIN_CAP (1u << 18)

__device__ __forceinline__ unsigned xb_ld(unsigned* p)              { return __hip_atomic_load(p, __ATOMIC_RELAXED, __HIP_MEMORY_SCOPE_AGENT); }
__device__ __forceinline__ unsigned xb_add(unsigned* p, unsigned v) { return __hip_atomic_fetch_add(p, v, __ATOMIC_RELAXED, __HIP_MEMORY_SCOPE_AGENT); }
__device__ __forceinline__ unsigned xb_xcc_id() { return (unsigned)__builtin_amdgcn_s_getreg((3 << 11) | 20) & 0xFu; }
#define XB_SPIN(cond, bar) do { unsigned _sp = 0; while (cond) { __builtin_amdgcn_s_sleep(1); \
    if ((++_sp & 255u) == 0u) { if (xb_ld(&(bar)[XB_TMO])) break; if (_sp > XB_SPIN_CAP) { atomicAdd(&(bar)[XB_TMO], 1u); break; } } } } while (0)

struct XcdBarrier {
    unsigned* bar; unsigned x;
    volatile LAS unsigned* st;
};

__device__ __forceinline__ XcdBarrier xcd_barrier_post(unsigned* bar, volatile LAS unsigned* st) {
    XcdBarrier b; b.bar = bar; b.x = xb_xcc_id(); b.st = st;
    if (threadIdx.x == 0) (void)xb_add(&bar[XB_XCNT(b.x)], 1u);
    return b;
}
__device__ __forceinline__ void xcd_barrier_complete(unsigned* bar, unsigned x, unsigned& nloc, unsigned& nx) {
    const unsigned G = gridDim.x * gridDim.y * gridDim.z;
    unsigned sum, cnt, mine, sp = 0u;
    for (;;) {
        sum = 0u; cnt = 0u; mine = 0u;
#pragma unroll
        for (unsigned j = 0; j < 16; ++j) { const unsigned c = xb_ld(&bar[XB_XCNT(j)]); sum += c; cnt += (c > 0u) ? 1u : 0u; mine = (j == x) ? c : mine; }
        if (sum == G) break;
        __builtin_amdgcn_s_sleep(1);
        if ((++sp & 255u) == 0u) { if (xb_ld(&bar[XB_TMO])) break; if (sp > XB_SPIN_CAP) { atomicAdd(&bar[XB_TMO], 1u); break; } }
    }
    nloc = mine > 0u ? mine : 1u; nx = cnt > 0u ? cnt : 1u;
}

__device__ __forceinline__ void xcd_barrier(const XcdBarrier& b) {
    asm volatile("s_waitcnt vmcnt(0)" ::: "memory");
    __syncthreads();
    if (threadIdx.x == 0) {
        unsigned* bar = b.bar;
        __builtin_amdgcn_s_waitcnt(0);
        unsigned nloc = b.st[0], nx = b.st[1];
        if (nloc == 0u) { xcd_barrier_complete(bar, b.x, nloc, nx); b.st[0] = nloc; b.st[1] = nx; }
        const unsigned old = xb_add(&bar[XB_XSUB(b.x)], 1u);
        const unsigned gen = old / nloc;
        if (old + 1u == (gen + 1u) * nloc) {
            __builtin_amdgcn_fence(__ATOMIC_RELEASE, "agent");
            asm volatile("s_waitcnt vmcnt(0)" ::: "memory");
            const unsigned og = xb_add(&bar[XB_TOP], 1u);
            const unsigned tg = og / nx;
            if (og + 1u == (tg + 1u) * nx) xb_add(&bar[XB_TOPGEN], 1u);
            else XB_SPIN(xb_ld(&bar[XB_TOPGEN]) == tg, bar);
            __builtin_amdgcn_fence(__ATOMIC_ACQUIRE, "agent");
            xb_add(&bar[XB_XGEN(b.x)], 1u);
            asm volatile("s_waitcnt vmcnt(0)" ::: "memory");
        } else {
            XB_SPIN(xb_ld(&bar[XB_XGEN(b.x)]) == gen, bar);
            __builtin_amdgcn_fence(__ATOMIC_ACQUIRE, "agent");
            asm volatile("s_waitcnt vmcnt(0)" ::: "memory");
        }
    }
    __syncthreads();
}

constexpr int N_PHASES = 10;
__device__ __forceinline__ void attn_phase(const Params& a, unsigned char* lds) {
    const att::bf16_t* Q = (const att::bf16_t*)(a.ws + WS_Q); const att::bf16_t* KN = (const att::bf16_t*)(a.ws + WS_KN); const att::bf16_t* KR = (const att::bf16_t*)(a.ws + WS_KR);
    const att::bf16_t* V = (const att::bf16_t*)(a.ws + WS_V); att::bf16_t* MX = (att::bf16_t*)(a.ws + WS_MX); float* ssa = (float*)(a.ws + WS_SS) + 2 * (size_t)TT;
    const int G = gridDim.x;
    const int x = blockIdx.x & 7, cu = blockIdx.x >> 3;
    const int ns = x < 4 ? 2 : 1, np = x < 4 ? 5 : 7, p0 = x < 4 ? 5 * x : 20 + 7 * (x - 4);
    const int nunits = (G == 256) ? ns + np : ((TT / 256) * NH - (int)blockIdx.x + G - 1) / G;
    for (int i = 0; i < nunits; ++i) {
        int row0, k0, h, seq;
        if (G == 256) {
            if (i < ns) { h = x < 4 ? x : 4 + ((x - 4) >> 1); const int qb = x < 4 ? cu + 32 * i : ((x - 4) & 1) * 32 + cu; row0 = T_P + qb * 256; k0 = T_P; seq = SEQ_S; }
            else { const int p = p0 + (i - ns), sq = p / NH; h = p - sq * NH; row0 = sq * SEQ_P + cu * 256; k0 = sq * SEQ_P; seq = SEQ_P; }
        } else { const int uidx = blockIdx.x + i * G, rb = uidx / NH; h = uidx - rb * NH; row0 = rb * 256; k0 = row0 < T_P ? (row0 & ~(SEQ_P - 1)) : T_P; seq = row0 < T_P ? SEQ_P : SEQ_S; }
        att::attn_unit(Q + (size_t)row0 * LDQ_ + h * DQK, KN + (size_t)k0 * LDKV_ + h * DNOPE, KR + (size_t)k0 * DROPE, V + (size_t)k0 * LDKV_ + h * DV,
                       MX + (size_t)row0 * DM + POOLW + h * DV, ssa + row0, seq, (char*)lds);
    }
}

__global__ void __launch_bounds__(NTHREADS, 2) enc_fwd(Params a) {
    extern __shared__ __attribute__((aligned(16))) unsigned char lds_raw[];
    LAS unsigned char* lds = (LAS unsigned char*)lds_raw;
    const int lo = a.ph_lo, hi = a.ph_hi, G = gridDim.x;
    unsigned char* ws = a.ws;
    float* SS = (float*)(ws + WS_SS);
#define IN(k) (lo <= (k) && (k) < hi)
    unsigned* barw = (unsigned*)(ws + WS_BAR);
    volatile LAS unsigned* MISC = (volatile LAS unsigned*)(lds + MISC_OFF);
    if (threadIdx.x < 16) MISC[threadIdx.x] = 0u;
    if (IN(0) && IN(1) && blockIdx.x == 0) for (int i = threadIdx.x; i < XCD_BAR_WORDS; i += NTHREADS) barw[i] = 0u;
    __syncthreads();
    XcdBarrier xb; xb.bar = barw; xb.x = 0; xb.st = MISC + 8;
#define SEAM(k) do { if (IN(k) && IN((k) + 1)) { if ((k) == 0) { cg::this_grid().sync(); xb = xcd_barrier_post(barw, MISC + 8); } else xcd_barrier(xb); } } while (0)
    if (IN(0)) { p0a_prologue(a, lds); } SEAM(0);
    if (IN(1)) { p0b_rows(a); } SEAM(1);
    if (IN(2)) {
        pg8::Gemm g{(const pg8::bf16_t*)(ws + WS_HB), (const pg8::bf16_t*)(ws + WS_WIN), TT, 1024, DM}; pg8::StaticOrder S; S.init(TT, 1024, G, (int)blockIdx.x);
        pg8::EpiZ E{(pg8::bf16_t*)(ws + WS_U), (pg8::bf16_t*)(ws + WS_CQ), (pg8::bf16_t*)(ws + WS_CKV), (pg8::bf16_t*)(ws + WS_KR), SS, SS + TT, (const float*)(ws + WS_ROPE)};
        pg8::gemm_phase<pg8::EpiZ, pg8::StaticOrder, true, true>(lds, g, S, E);
    } SEAM(2);
    if (IN(3)) {
        { pg8::Gemm g{(const pg8::bf16_t*)(ws + WS_CQ), (const pg8::bf16_t*)(ws + WS_WUQ), TT, 1280, QLR}; pg8::StaticOrder S; S.init(TT, 1280, G, (int)blockIdx.x);
          pg8::EpiQ E{(pg8::bf16_t*)(ws + WS_Q), SS, (const float*)(ws + WS_ROPE)};
          pg8::gemm_phase<pg8::EpiQ, pg8::StaticOrder, true, true>(lds, g, S, E); }
        { pg8::Gemm g{(const pg8::bf16_t*)(ws + WS_CKV), (const pg8::bf16_t*)(ws + WS_WUKV), TT, 1536, KVLR}; pg8::StaticOrder S; S.init(TT, 1536, G, (int)blockIdx.x);
          pg8::EpiKV E{(pg8::bf16_t*)(ws + WS_KN), (pg8::bf16_t*)(ws + WS_V), SS + TT};
          pg8::gemm_phase<pg8::EpiKV, pg8::StaticOrder, true, true>(lds, g, S, E); }
    } SEAM(3);
    if (IN(4)) { attn_phase(a, lds_raw); } SEAM(4);
    if (IN(5)) { pool_phase(a, lds); } SEAM(5);
    if (IN(6)) {
        pg8::Gemm g{(const pg8::bf16_t*)(ws + WS_MX), (const pg8::bf16_t*)(ws + WS_WOUT), TT, DM, DM}; pg8::StaticOrder S; S.init(TT, DM, G, (int)blockIdx.x);
        pg8::EpiRowScaleSS E{(pg8::bf16_t*)(ws + WS_MG), SS + 2 * (size_t)TT, 1.0f / (NH * DV), SS + 3 * (size_t)TT};
        pg8::gemm_phase<pg8::EpiRowScaleSS, pg8::StaticOrder, true, true>(lds, g, S, E);
    } SEAM(6);
    if (IN(7)) { p6_rows(a); } SEAM(7);
    if (IN(8)) {
        pg8::Gemm g{(const pg8::bf16_t*)(ws + WS_HB), (const pg8::bf16_t*)(ws + WS_WGU), TT, 2 * DFF, DM}; pg8::StaticOrder S; S.init(TT, 2 * DFF, G, (int)blockIdx.x);
        pg8::EpiGU E{(pg8::bf16_t*)(ws + WS_ACT)};
        pg8::gemm_phase<pg8::EpiGU, pg8::StaticOrder, true, true>(lds, g, S, E);
    } SEAM(8);
    if (IN(9)) {
        pg8::Gemm g{(const pg8::bf16_t*)(ws + WS_ACT), (const pg8::bf16_t*)(ws + WS_WD), TT, DM, DFF}; pg8::StaticOrder S; S.init(TT, DM, G, (int)blockIdx.x);
        pg8::EpiRowScaleSS E{(pg8::bf16_t*)(ws + WS_F), nullptr, 0.f, SS + 4 * (size_t)TT};
        pg8::gemm_phase<pg8::EpiRowScaleSS, pg8::StaticOrder, true, true>(lds, g, S, E);
    } SEAM(9);
    if (IN(10)) { p9_rows(a); }
#undef IN
#undef SEAM
}

extern "C" void kernel_launch(void* const* d_in, const int* in_sizes, int n_in, void* d_out, int out_size, void* d_ws, size_t ws_size, hipStream_t stream) {
    static int grid = 0;
    if (grid == 0) {
        if (n_in != 23 || out_size != TT * DM || ws_size < WS_END) { fprintf(stderr, "kernel_launch: unexpected shapes: n_in %d out %d ws %zu (need %zu)\n", n_in, out_size, ws_size, (size_t)WS_END); grid = -1; return; }
        int dev = 0, cus = 0, per_cu = 0;
        if (hipGetDevice(&dev) != hipSuccess || hipDeviceGetAttribute(&cus, hipDeviceAttributeMultiprocessorCount, dev) != hipSuccess) { grid = -1; return; }
        if (hipFuncSetAttribute((const void*)enc_fwd, hipFuncAttributeMaxDynamicSharedMemorySize, LDS_BYTES) != hipSuccess) { fprintf(stderr, "kernel_launch: hipFuncSetAttribute failed\n"); grid = -1; return; }
        if (hipOccupancyMaxActiveBlocksPerMultiprocessor(&per_cu, (const void*)enc_fwd, NTHREADS, LDS_BYTES) != hipSuccess || per_cu < 1) per_cu = 1;
        (void)hipGetLastError();
        grid = cus;
    }
    if (grid < 0) return;
    Params p{};
    for (int i = 0; i < 23; ++i) p.in[i] = (const float*)d_in[i];
    p.out = (float*)d_out; p.ws = (unsigned char*)d_ws;
#if MK_PER_PHASE
    for (int ph = 0; ph <= N_PHASES; ++ph) { p.ph_lo = ph; p.ph_hi = ph + 1; hipLaunchKernelGGL(enc_fwd, dim3(grid), dim3(NTHREADS), LDS_BYTES, stream, p); }
#else
    p.ph_lo = 0; p.ph_hi = N_PHASES + 1;
    void* args[] = {&p};
    hipError_t e = hipLaunchCooperativeKernel((const void*)enc_fwd, dim3(grid), dim3(NTHREADS), args, LDS_BYTES, stream);
    if (e != hipSuccess) fprintf(stderr, "kernel_launch: cooperative launch failed: %s (grid %d)\n", hipGetErrorString(e), grid);
#endif
}
```

```cpp
#include <hip/hip_runtime.h>
#include <hip/hip_cooperative_groups.h>
#include <cstdio>
#include <cstdint>
namespace cg = cooperative_groups;

#ifndef MK_PER_PHASE
#define MK_PER_PHASE 0
#endif

constexpr int DM = 1024, T_P = 65536, T_S = 16384, TT = T_P + T_S, SEQ_P = 8192, SEQ_S = 16384, NBATCH = 9;
constexpr int NH = 6, DQK = 192, DNOPE = 128, DROPE = 64, DV = 128, QLR = 384, KVLR = 256, DFF = 2816, POOLW = 256;
constexpr int LDQ_ = NH * DQK  , LDKV_ = NH * DNOPE  ;
constexpr float EPS = 1e-6f;
constexpr float QSCALE = 0.07216878364870322f * 1.4426950408889634f;

namespace pg8 {
#define PG8_LAS __attribute__((address_space(3)))
typedef unsigned short bf16_t;
typedef short bf16x8 __attribute__((ext_vector_type(8)));
typedef float f32x4 __attribute__((ext_vector_type(4)));
typedef unsigned u32x4 __attribute__((ext_vector_type(4)));
constexpr int BM = 256, BK = 64, HALF = 128, HTB = HALF * BK * 2  , STAGE_BYTES = 8 * HTB, NXCD = 8, WGM = 8;

__host__ __device__ __forceinline__ int lds_byte(int r, int c) { const int st = (r >> 4) * 2 + (c >> 5), rr = r & 15, cc = c & 31, ob = rr * 64 + cc * 2; return st * 1024 + (ob ^ (((ob >> 9) & 1) << 5)); }
__host__ __device__ __forceinline__ void stage_rc(int b, int& R, int& C) { const int st = b / 1024, sb = b % 1024, swz = sb ^ (((sb >> 9) & 1) << 5); R = (st >> 1) * 16 + swz / 64; C = (st & 1) * 32 + (swz % 64) / 2; }
__host__ __device__ __forceinline__ int perm32(int rho) { const int n = rho >> 4, i = rho & 15; return 8 * (i >> 2) + 4 * n + (i & 3); }

struct Unit { int pm, pn; };
struct Gemm { const bf16_t* A; const bf16_t* Bt; int M, N, K; };

struct StaticOrder {
    int nM, nN, nwg, G, c;
    __host__ __device__ void init(int M, int N, int G_, int c_) { nM = M / BM; nN = N / BM; nwg = nM * nN; G = G_; c = c_; }
    __host__ __device__ bool next(int i, Unit& u) const {
        const long L = (long)i * G + c; if (L >= nwg) return false;
        int wgid = (int)L; { const int q = nwg / NXCD, r = nwg % NXCD, xcd = wgid % NXCD, off = wgid / NXCD; wgid = (xcd < r ? xcd * (q + 1) : r * (q + 1) + (xcd - r) * q) + off; }
        const int nig = WGM * nN, gid = wgid / nig, fm = gid * WGM, gsz = (nM - fm) < WGM ? (nM - fm) : WGM;
        u.pm = fm + ((wgid % nig) % gsz); u.pn = (wgid % nig) / gsz; return true;
    }
    __device__ __forceinline__ void a_ready(const Unit&) const {}
    __device__ __forceinline__ void done(const Unit&) const {}
};


__device__ __forceinline__ unsigned cvt_pk_bf16(float lo, float hi) { unsigned r; asm volatile("v_cvt_pk_bf16_f32 %0, %1, %2" : "=v"(r) : "v"(lo), "v"(hi)); return r; }
typedef unsigned u32x2 __attribute__((ext_vector_type(2)));
__device__ __forceinline__ void st4(bf16_t* p, f32x4 v) { u32x2 w; w.x = cvt_pk_bf16(v[0], v[1]); w.y = cvt_pk_bf16(v[2], v[3]); *(u32x2*)p = w; }
__device__ __forceinline__ float sq4(f32x4 v) { return (v[0] * v[0] + v[1] * v[1]) + (v[2] * v[2] + v[3] * v[3]); }
__device__ __forceinline__ void row_ss_add(float* ss, int row, float s, int fq) { s += __shfl_xor(s, 16); s += __shfl_xor(s, 32); if (fq == 0) atomicAdd(ss + row, s); }
__device__ __forceinline__ int seq_pos(int row) { return row < T_P ? (row & (SEQ_P - 1)) : (row - T_P); }
#define PG8_ROWS_BEGIN _Pragma("unroll") for (int ai = 0; ai < 2; ++ai) _Pragma("unroll") for (int m = 0; m < 4; ++m) { const int row = u.pm * BM + ai * HALF + wr * 64 + m * 16 + fr + zo_;
#define PG8_ROWS_END asm volatile("" ::: "memory"); }

struct EpiZ {
    static constexpr bool PERM = false, AFTER_DRAIN = false;
    bf16_t *U, *CQ, *CKV, *KR; float *ssq, *sskv; const float* rope;
    __device__ __forceinline__ void operator()(const f32x4 (&acc)[2][2][4][2], const Unit& u, int wr, int wc, int fr_in, int fq_in) const {
        int zo_ = 0, fr = fr_in, fq = fq_in; asm volatile("" : "+v"(zo_), "+v"(fr), "+v"(fq));
#pragma unroll
        for (int bj = 0; bj < 2; ++bj) {
            const int cc = u.pn * 8 + bj * 4 + wc;
            if (cc < 8) {
                PG8_ROWS_BEGIN
                    bf16_t* p = U + (size_t)row * POOLW + cc * 32 + 4 * fq; st4(p, acc[ai][bj][m][0]); st4(p + 16, acc[ai][bj][m][1]);
                PG8_ROWS_END
            } else if (cc < 20) {
                PG8_ROWS_BEGIN
                    bf16_t* p = CQ + (size_t)row * QLR + (cc - 8) * 32 + 4 * fq; st4(p, acc[ai][bj][m][0]); st4(p + 16, acc[ai][bj][m][1]);
                    row_ss_add(ssq, row, sq4(acc[ai][bj][m][0]) + sq4(acc[ai][bj][m][1]), fq);
                PG8_ROWS_END
            } else if (cc < 28) {
                PG8_ROWS_BEGIN
                    bf16_t* p = CKV + (size_t)row * KVLR + (cc - 20) * 32 + 4 * fq; st4(p, acc[ai][bj][m][0]); st4(p + 16, acc[ai][bj][m][1]);
                    row_ss_add(sskv, row, sq4(acc[ai][bj][m][0]) + sq4(acc[ai][bj][m][1]), fq);
                PG8_ROWS_END
            } else if (cc < 30) {
                const int i0 = 16 * (cc - 28) + 4 * fq;
                PG8_ROWS_BEGIN
                    const float* rp = rope + ((size_t)seq_pos(row) * 32 + i0) * 2;
                    const f32x4 cs0 = *(const f32x4*)rp, cs1 = *(const f32x4*)(rp + 4);
                    const f32x4 x1 = acc[ai][bj][m][0], x2 = acc[ai][bj][m][1];
                    const f32x4 c = {cs0[0], cs0[2], cs1[0], cs1[2]}, s = {cs0[1], cs0[3], cs1[1], cs1[3]};
                    bf16_t* p = KR + (size_t)row * DROPE + i0; st4(p, x1 * c - x2 * s); st4(p + 32, x2 * c + x1 * s);
                PG8_ROWS_END
            }
        }
    }
};
struct EpiQ {
    static constexpr bool PERM = false, AFTER_DRAIN = false;
    bf16_t* Q; const float* ssq; const float* rope;
    __device__ __forceinline__ void operator()(const f32x4 (&acc)[2][2][4][2], const Unit& u, int wr, int wc, int fr_in, int fq_in) const {
        int zo_ = 0, fr = fr_in, fq = fq_in; asm volatile("" : "+v"(zo_), "+v"(fr), "+v"(fq));
#pragma unroll
        for (int bj = 0; bj < 2; ++bj) {
            const int cc = u.pn * 8 + bj * 4 + wc;
            if (cc >= 36) continue;
            const int h = cc / 6, j6 = cc - 6 * h;
            if (j6 < 4) {
                PG8_ROWS_BEGIN
                    const float rq = QSCALE / sqrtf(ssq[row] * (1.0f / QLR) + EPS);
                    bf16_t* p = Q + (size_t)row * LDQ_ + h * DQK + j6 * 32 + 4 * fq; st4(p, acc[ai][bj][m][0] * rq); st4(p + 16, acc[ai][bj][m][1] * rq);
                PG8_ROWS_END
            } else {
                const int i0 = 16 * (j6 - 4) + 4 * fq;
                PG8_ROWS_BEGIN
                    const float rq = QSCALE / sqrtf(ssq[row] * (1.0f / QLR) + EPS);
                    const float* rp = rope + ((size_t)seq_pos(row) * 32 + i0) * 2;
                    const f32x4 cs0 = *(const f32x4*)rp, cs1 = *(const f32x4*)(rp + 4);
                    const f32x4 x1 = acc[ai][bj][m][0] * rq, x2 = acc[ai][bj][m][1] * rq;
                    const f32x4 c = {cs0[0], cs0[2], cs1[0], cs1[2]}, s = {cs0[1], cs0[3], cs1[1], cs1[3]};
                    bf16_t* p = Q + (size_t)row * LDQ_ + h * DQK + DNOPE + i0; st4(p, x1 * c - x2 * s); st4(p + 32, x2 * c + x1 * s);
                PG8_ROWS_END
            }
        }
    }
};
struct EpiKV {
    static constexpr bool PERM = false, AFTER_DRAIN = false;
    bf16_t *KN, *V; const float* sskv;
    __device__ __forceinline__ void operator()(const f32x4 (&acc)[2][2][4][2], const Unit& u, int wr, int wc, int fr_in, int fq_in) const {
        int zo_ = 0, fr = fr_in, fq = fq_in; asm volatile("" : "+v"(zo_), "+v"(fr), "+v"(fq));
        PG8_ROWS_BEGIN
            const float rk = 1.0f / sqrtf(sskv[row] * (1.0f / KVLR) + EPS);
            const size_t o = (size_t)row * LDKV_ + u.pn * DNOPE + wc * 32 + 4 * fq;
            st4(KN + o, acc[ai][0][m][0] * rk); st4(KN + o + 16, acc[ai][0][m][1] * rk);
            st4(V + o, acc[ai][1][m][0] * rk); st4(V + o + 16, acc[ai][1][m][1] * rk);
        PG8_ROWS_END
    }
};
struct EpiRowScaleSS {
    static constexpr bool PERM = false, AFTER_DRAIN = false;
    bf16_t* O; const float* rs; float rs_div; float* ss;
    __device__ __forceinline__ void operator()(const f32x4 (&acc)[2][2][4][2], const Unit& u, int wr, int wc, int fr_in, int fq_in) const {
        int zo_ = 0, fr = fr_in, fq = fq_in; asm volatile("" : "+v"(zo_), "+v"(fr), "+v"(fq));
        PG8_ROWS_BEGIN
            const float r = rs ? 1.0f / sqrtf(rs[row] * rs_div + EPS) : 1.0f;
            float s = 0.f;
#pragma unroll
            for (int bj = 0; bj < 2; ++bj) {
                const f32x4 v0 = acc[ai][bj][m][0] * r, v1 = acc[ai][bj][m][1] * r;
                bf16_t* p = O + (size_t)row * DM + u.pn * BM + bj * HALF + wc * 32 + 4 * fq; st4(p, v0); st4(p + 16, v1);
                s += sq4(v0) + sq4(v1);
            }
            row_ss_add(ss, row, s, fq);
        PG8_ROWS_END
    }
};
struct EpiGU {
    static constexpr bool PERM = false, AFTER_DRAIN = false;
    bf16_t* ACT;
    __device__ __forceinline__ void operator()(const f32x4 (&acc)[2][2][4][2], const Unit& u, int wr, int wc, int fr_in, int fq_in) const {
        int zo_ = 0, fr = fr_in, fq = fq_in; asm volatile("" : "+v"(zo_), "+v"(fr), "+v"(fq));
        PG8_ROWS_BEGIN
#pragma unroll
            for (int bj = 0; bj < 2; ++bj) {
                const int cc = u.pn * 8 + bj * 4 + wc;
                const f32x4 g = acc[ai][bj][m][0], up = acc[ai][bj][m][1]; f32x4 o;
#pragma unroll
                for (int j = 0; j < 4; ++j) o[j] = g[j] * __builtin_amdgcn_rcpf(1.0f + __builtin_amdgcn_exp2f(-1.4426950408889634f * g[j])) * up[j];
                st4(ACT + (size_t)row * DFF + cc * 16 + 4 * fq, o);
            }
        PG8_ROWS_END
    }
};
#undef PG8_ROWS_BEGIN
#undef PG8_ROWS_END

template <class Epi, class Sched, bool ALIGN_EPI = false, bool SP2 = false>
__device__ __forceinline__ void gemm_phase(PG8_LAS unsigned char* lds, const Gemm g, const Sched& S, const Epi& E) {
    const int tid = threadIdx.x, wid = __builtin_amdgcn_readfirstlane(tid >> 6), lane = tid & 63, wr = wid >> 2, wc = wid & 3, fr = lane & 15, fq = lane >> 4;
    const int K = g.K, nt = K / BK;
    unsigned voffA[2], voffB[2];
#pragma unroll
    for (int i = 0; i < 2; ++i) { int R, C; stage_rc(tid * 16 + i * 8192, R, C); const int Rb = Epi::PERM ? ((R & ~31) + perm32(R & 31)) : R;
        voffA[i] = (unsigned)(R * K + C) * 2u; voffB[i] = (unsigned)(Rb * K + C) * 2u; }
    const size_t kstep = (size_t)(BK * 2);
    const size_t hstep = (size_t)HALF * K * 2;
    const size_t tstep = 2 * hstep;
    const unsigned ldsw = (unsigned)wid * 1024u;
    const int aoff = lds_byte(wr * 64 + fr, fq * 8), boff = lds_byte(wc * 32 + fr, fq * 8);
#define PG8_SA(b, h) (((b) * 2 + (h)) * HTB)
#define PG8_SB(b, h) ((4 + (b) * 2 + (h)) * HTB)
#define PG8_STAGE(bufoff, gbase, voff) do { _Pragma("unroll") for (int _i = 0; _i < 2; ++_i) \
        __builtin_amdgcn_global_load_lds((const unsigned*)((const char*)(gbase) + (voff)[_i]), (PG8_LAS unsigned*)(lds + (bufoff) + ldsw + _i * 8192), 16, 0, 0); } while (0)
#define PG8_LDA(dst, b, h) do { _Pragma("unroll") for (int m = 0; m < 4; ++m) _Pragma("unroll") for (int k = 0; k < 2; ++k) dst[m][k] = *(const PG8_LAS bf16x8*)(lds + PG8_SA(b, h) + aoff + m * 2048 + k * 1024); } while (0)
#define PG8_LDB(dst, b, h) do { _Pragma("unroll") for (int n = 0; n < 2; ++n) _Pragma("unroll") for (int k = 0; k < 2; ++k) dst[n][k] = *(const PG8_LAS bf16x8*)(lds + PG8_SB(b, h) + boff + n * 2048 + k * 1024); } while (0)
#define PG8_MMA(ai, bj, At, Bt) do { __builtin_amdgcn_s_setprio(1); _Pragma("unroll") for (int m = 0; m < 4; ++m) _Pragma("unroll") for (int n = 0; n < 2; ++n) _Pragma("unroll") for (int k = 0; k < 2; ++k) \
        acc[ai][bj][m][n] = __builtin_amdgcn_mfma_f32_16x16x32_bf16(Bt[n][k], At[m][k], acc[ai][bj][m][n], 0, 0, 0); __builtin_amdgcn_s_setprio(0); } while (0)
#define PG8_WAIT_V(n) asm volatile("s_waitcnt vmcnt(" #n ")" ::: "memory")
#define PG8_WAIT_L(n) asm volatile("s_waitcnt lgkmcnt(" #n ")" ::: "memory")
#define PG8_BAR __builtin_amdgcn_s_barrier()
#define PG8_SCHED __builtin_amdgcn_sched_barrier(0)
    Unit cur, nxt; int ui = 0;
    if (!S.next(0, cur)) return;
    f32x4 acc[2][2][4][2];
#pragma unroll
    for (int a = 0; a < 2; ++a)
#pragma unroll
        for (int b = 0; b < 2; ++b)
#pragma unroll
            for (int m = 0; m < 4; ++m)
#pragma unroll
                for (int n = 0; n < 2; ++n) acc[a][b][m][n] = (f32x4){0.f, 0.f, 0.f, 0.f};
    bf16x8 At[4][2], B0[2][2], B1[2][2];
    const char* cA = (const char*)g.A + (size_t)cur.pm * tstep; const char* cB = (const char*)g.Bt + (size_t)cur.pn * tstep;
    S.a_ready(cur);
    if constexpr (SP2) {
        PG8_STAGE(PG8_SB(0, 0), cB, voffB); PG8_STAGE(PG8_SB(0, 1), cB + hstep, voffB); PG8_STAGE(PG8_SA(0, 0), cA, voffA); PG8_STAGE(PG8_SA(0, 1), cA + hstep, voffA);
        if (wr == 1) PG8_BAR;
        PG8_WAIT_V(2); PG8_BAR;
        PG8_STAGE(PG8_SB(1, 0), cB + kstep, voffB); PG8_STAGE(PG8_SA(1, 0), cA + kstep, voffA); PG8_STAGE(PG8_SB(1, 1), cB + hstep + kstep, voffB);
        PG8_WAIT_V(6); PG8_BAR;
    } else {
        PG8_STAGE(PG8_SB(0, 0), cB, voffB); PG8_STAGE(PG8_SA(0, 0), cA, voffA); PG8_STAGE(PG8_SB(0, 1), cB + hstep, voffB); PG8_STAGE(PG8_SA(0, 1), cA + hstep, voffA);
        if (wr == 1) PG8_BAR;
        PG8_WAIT_V(4); PG8_BAR;
        PG8_STAGE(PG8_SB(1, 0), cB + kstep, voffB); PG8_STAGE(PG8_SA(1, 0), cA + kstep, voffA); PG8_STAGE(PG8_SB(1, 1), cB + hstep + kstep, voffB);
        PG8_WAIT_V(6); PG8_BAR;
    }
    for (;;) {
        const bool has_next = S.next(ui + 1, nxt);
        const char* nA = has_next ? (const char*)g.A + (size_t)nxt.pm * tstep : cA; const char* nB = has_next ? (const char*)g.Bt + (size_t)nxt.pn * tstep : cB;
#pragma unroll 1
        for (int t = 0; t < nt; t += 2) {
            const bool last = (t == nt - 2);
            const char* a1 = cA + (size_t)(t + 1) * kstep;
            const char* a2 = last ? nA : cA + (size_t)(t + 2) * kstep; const char* b2 = last ? nB : cB + (size_t)(t + 2) * kstep;
            const char* a3 = a2 + kstep; const char* b3 = b2 + kstep;
            if (last && has_next) S.a_ready(nxt);
            if constexpr (SP2) {
            PG8_LDB(B0, 0, 0); PG8_LDB(B1, 0, 1); PG8_SCHED; PG8_LDA(At, 0, 0); PG8_STAGE(PG8_SA(1, 1), a1 + hstep, voffA);
            PG8_WAIT_V(8); PG8_WAIT_L(0); PG8_BAR; PG8_MMA(0, 0, At, B0); PG8_MMA(0, 1, At, B1); PG8_BAR; PG8_SCHED;
            PG8_LDA(At, 0, 1); PG8_STAGE(PG8_SB(0, 0), b2, voffB); PG8_STAGE(PG8_SB(0, 1), b2 + hstep, voffB); PG8_STAGE(PG8_SA(0, 0), a2, voffA);
            PG8_WAIT_V(8); PG8_WAIT_L(0); PG8_BAR; PG8_MMA(1, 0, At, B0); PG8_MMA(1, 1, At, B1); PG8_BAR; PG8_SCHED;
            PG8_LDB(B0, 1, 0); PG8_LDB(B1, 1, 1); PG8_SCHED; PG8_LDA(At, 1, 0); PG8_STAGE(PG8_SA(0, 1), a2 + hstep, voffA);
            PG8_WAIT_V(8); PG8_WAIT_L(0); PG8_BAR; PG8_MMA(0, 0, At, B0); PG8_MMA(0, 1, At, B1); PG8_BAR; PG8_SCHED;
            PG8_LDA(At, 1, 1); PG8_STAGE(PG8_SB(1, 0), b3, voffB); PG8_STAGE(PG8_SB(1, 1), b3 + hstep, voffB); PG8_STAGE(PG8_SA(1, 0), a3, voffA);
            PG8_WAIT_V(8); PG8_WAIT_L(0); PG8_BAR; PG8_MMA(1, 0, At, B0); PG8_MMA(1, 1, At, B1); PG8_BAR; PG8_SCHED;
            } else {
            PG8_LDB(B0, 0, 0); PG8_SCHED; PG8_LDA(At, 0, 0); PG8_STAGE(PG8_SA(1, 1), a1 + hstep, voffA);
            PG8_WAIT_L(8); PG8_BAR; PG8_WAIT_L(0); PG8_MMA(0, 0, At, B0); PG8_BAR; PG8_SCHED;
            PG8_LDB(B1, 0, 1); PG8_STAGE(PG8_SB(0, 0), b2, voffB);
            PG8_BAR; PG8_WAIT_L(0); PG8_MMA(0, 1, At, B1); PG8_BAR;
            PG8_LDA(At, 0, 1); PG8_STAGE(PG8_SA(0, 0), a2, voffA);
            PG8_BAR; PG8_WAIT_L(0); PG8_MMA(1, 0, At, B0); PG8_BAR; PG8_SCHED;
            PG8_STAGE(PG8_SB(0, 1), b2 + hstep, voffB);
            PG8_WAIT_V(6); PG8_BAR; PG8_MMA(1, 1, At, B1); PG8_BAR;
            PG8_LDB(B0, 1, 0); PG8_SCHED; PG8_LDA(At, 1, 0); PG8_STAGE(PG8_SA(0, 1), a2 + hstep, voffA);
            PG8_WAIT_L(8); PG8_BAR; PG8_WAIT_L(0); PG8_MMA(0, 0, At, B0); PG8_BAR; PG8_SCHED;
            PG8_LDB(B1, 1, 1); PG8_STAGE(PG8_SB(1, 0), b3, voffB);
            PG8_BAR; PG8_WAIT_L(0); PG8_MMA(0, 1, At, B1); PG8_BAR;
            PG8_LDA(At, 1, 1); PG8_STAGE(PG8_SA(1, 0), a3, voffA);
            PG8_BAR; PG8_WAIT_L(0); PG8_MMA(1, 0, At, B0); PG8_BAR; PG8_SCHED;
            PG8_STAGE(PG8_SB(1, 1), b3 + hstep, voffB);
            PG8_WAIT_V(6); PG8_BAR; PG8_MMA(1, 1, At, B1); PG8_BAR;
            }
        }
        if constexpr (ALIGN_EPI) { if (wr == 0) PG8_BAR; }
        if constexpr (!Epi::AFTER_DRAIN) { E(acc, cur, wr, wc, fr, fq); S.done(cur); }
        if (!has_next) break;
#pragma unroll
        for (int a = 0; a < 2; ++a)
#pragma unroll
            for (int b = 0; b < 2; ++b)
#pragma unroll
                for (int m = 0; m < 4; ++m)
#pragma unroll
                    for (int n = 0; n < 2; ++n) acc[a][b][m][n] = (f32x4){0.f, 0.f, 0.f, 0.f};
        cur = nxt; cA = nA; cB = nB; ++ui;
        if constexpr (ALIGN_EPI) { if (wr == 1) PG8_BAR; }
    }
    PG8_WAIT_V(0);
    if constexpr (!ALIGN_EPI) { if (wr == 0) PG8_BAR; }
    PG8_BAR;
    if constexpr (Epi::AFTER_DRAIN) { E.fused(acc, cur, wr, wc, fr, fq, lds, wid, lane); S.done(cur); }
#undef PG8_SA
#undef PG8_SB
#undef PG8_STAGE
#undef PG8_LDA
#undef PG8_LDB
#undef PG8_MMA
#undef PG8_WAIT_V
#undef PG8_WAIT_L
#undef PG8_BAR
#undef PG8_SCHED
}
}

namespace att {
using bf16x8 = __attribute__((ext_vector_type(8))) short;
using s16x4  = __attribute__((ext_vector_type(4))) short;
using f32x16 = __attribute__((ext_vector_type(16))) float;
using u32x4  = __attribute__((ext_vector_type(4))) unsigned;
typedef unsigned short bf16_t;
constexpr int NW = 8, QBLK = 32, KVBLK = 64;
constexpr int LDQ = LDQ_, LDKN = LDKV_, LDKR = DROPE, LDV = LDKV_, LDO = DM;
constexpr int SHM_V = 16384, SHM_KN = 16384, SHM_KR = 8192;
constexpr int OFF_V = 0, OFF_KN = 2 * SHM_V, OFF_KR = OFF_KN + 2 * SHM_KN, OFF_WS = OFF_KR + 2 * SHM_KR, ATTN_LDS = OFF_WS + NW * 64 * 4;
constexpr float THRL = 11.5f;
#define KSWZ(row, colB) ((row) * 256 + ((colB) ^ (((row) & 15) << 4)))
#define KRSWZ(row, colB) ((row) * 128 + ((colB) ^ ((((row) >> 1) & 7) << 4)))
#define SBAR() __builtin_amdgcn_sched_barrier(0)
__device__ __forceinline__ int crow(int r, int hi) { return (r & 3) + 8 * (r >> 2) + 4 * hi; }
__device__ __forceinline__ unsigned cvtpk(float lo, float hi) { unsigned r; asm volatile("v_cvt_pk_bf16_f32 %0, %1, %2" : "=v"(r) : "v"(lo), "v"(hi)); return r; }

__device__ __forceinline__ void partialSM(f32x16& p0, f32x16& p1, float& m_reg, float& mn, float& alpha) {
  float pmax = p0[0];
#pragma unroll
  for (int r = 1; r < 16; ++r) pmax = fmaxf(pmax, p0[r]);
#pragma unroll
  for (int r = 0; r < 16; ++r) pmax = fmaxf(pmax, p1[r]);
  { auto rr = __builtin_amdgcn_permlane32_swap(__float_as_uint(pmax), __float_as_uint(pmax), false, false);
    pmax = fmaxf(__uint_as_float(rr[0]), __uint_as_float(rr[1])); }
  if (__builtin_expect(__all(pmax - m_reg <= THRL), 1)) { mn = m_reg; alpha = 1.f; }
  else { mn = fmaxf(m_reg, pmax); alpha = __builtin_amdgcn_exp2f(m_reg - mn); m_reg = mn; }
#pragma unroll
  for (int r = 0; r < 16; ++r) p0[r] = p0[r] - mn;
#pragma unroll
  for (int r = 0; r < 16; ++r) p1[r] = p1[r] - mn;
#pragma unroll
  for (int r = 0; r < 16; ++r) p0[r] = __builtin_amdgcn_exp2f(p0[r]);
}
__device__ __forceinline__ void finishSM(f32x16& p0, f32x16& p1, float alpha, float& l_reg, bf16x8& pa0, bf16x8& pa1, bf16x8& pa2, bf16x8& pa3) {
#pragma unroll
  for (int r = 0; r < 16; ++r) p1[r] = __builtin_amdgcn_exp2f(p1[r]);
  float ps = 0;
#pragma unroll
  for (int r = 0; r < 16; ++r) ps += p0[r];
#pragma unroll
  for (int r = 0; r < 16; ++r) ps += p1[r];
  { auto rr = __builtin_amdgcn_permlane32_swap(__float_as_uint(ps), __float_as_uint(ps), false, false);
    ps = __uint_as_float(rr[0]) + __uint_as_float(rr[1]); }
  l_reg = l_reg * alpha + ps;
#define PK4(P, BASE, OUT) do { unsigned a0 = cvtpk(P[BASE + 0], P[BASE + 1]), a1 = cvtpk(P[BASE + 2], P[BASE + 3]);   \
    unsigned b0 = cvtpk(P[BASE + 4], P[BASE + 5]), b1 = cvtpk(P[BASE + 6], P[BASE + 7]);                              \
    auto r0 = __builtin_amdgcn_permlane32_swap(a0, b0, false, false); auto r1 = __builtin_amdgcn_permlane32_swap(a1, b1, false, false); \
    u32x4 w = {r0[0], r1[0], r0[1], r1[1]}; OUT = *reinterpret_cast<bf16x8*>(&w); } while (0)
  PK4(p0, 0, pa0); PK4(p0, 8, pa1); PK4(p1, 0, pa2); PK4(p1, 8, pa3);
#undef PK4
}
__device__ __forceinline__ void qkt(f32x16& p0, f32x16& p1, const char* Kn, const char* Kr, const bf16x8* qr, int r32, int hi) {
  p0 = f32x16{}; p1 = f32x16{};
#define KFRAG(dst, d0) do { const int cb_ = (((d0) & 7) * 16 + hi * 8) * 2; \
    if ((d0) < 8) { dst[0] = *reinterpret_cast<const bf16x8*>(Kn + KSWZ(r32, cb_)); dst[1] = *reinterpret_cast<const bf16x8*>(Kn + KSWZ(32 + r32, cb_)); } \
    else { dst[0] = *reinterpret_cast<const bf16x8*>(Kr + KRSWZ(r32, cb_)); dst[1] = *reinterpret_cast<const bf16x8*>(Kr + KRSWZ(32 + r32, cb_)); } } while (0)
#define KMMA(src, d0) do { p0 = __builtin_amdgcn_mfma_f32_32x32x16_bf16(src[0], qr[d0], p0, 0, 0, 0); p1 = __builtin_amdgcn_mfma_f32_32x32x16_bf16(src[1], qr[d0], p1, 0, 0, 0); } while (0)
  bf16x8 fa[2], fb[2], fc[2];
  KFRAG(fa, 0); KFRAG(fb, 1); SBAR();
  KFRAG(fc, 2); SBAR(); KMMA(fa, 0); SBAR();
  KFRAG(fa, 3); SBAR(); KMMA(fb, 1); SBAR();
  KFRAG(fb, 4); SBAR(); KMMA(fc, 2); SBAR();
  KFRAG(fc, 5); SBAR(); KMMA(fa, 3); SBAR();
  KFRAG(fa, 6); SBAR(); KMMA(fb, 4); SBAR();
  KFRAG(fb, 7); SBAR(); KMMA(fc, 5); SBAR();
  KFRAG(fc, 8); SBAR(); KMMA(fa, 6); SBAR();
  KFRAG(fa, 9); SBAR(); KMMA(fb, 7); SBAR();
  KFRAG(fb, 10); SBAR(); KMMA(fc, 8); SBAR();
  KFRAG(fc, 11); SBAR(); KMMA(fa, 9); SBAR();
  KMMA(fb, 10); KMMA(fc, 11);
#undef KFRAG
#undef KMMA
}
__device__ __forceinline__ int v_st(int k, int c) { const int kk = (k & ~0xC) | ((k & 4) << 1) | ((k & 8) >> 1); return ((kk >> 3) * 4 + (c >> 5)) * 512 + ((kk & 7) * 32 + (c & 31)) * 2; }
__device__ __forceinline__ int v_rd_base(int lane) { return ((lane & 3) << 3) | (((lane >> 2) & 3) << 6) | (((lane >> 4) & 1) << 5) | (((lane >> 5) & 1) << 8); }
constexpr int v_rd_off(int d0, int ks, int half) { return d0 * 512 + ks * 4096 + half * 2048; }
template <int OFF> __device__ __forceinline__ s16x4 tr_read(int vb) {
  s16x4 r; asm volatile("ds_read_b64_tr_b16 %0, %1 offset:%2" : "=&v"(r) : "v"(vb), "i"(OFF) : "memory"); return r;
}
template <int D0> __device__ __forceinline__ void pv_one(f32x16& od, int vb, bf16x8 pa0, bf16x8 pa1, bf16x8 pa2, bf16x8 pa3) {
  const s16x4 l0 = tr_read<v_rd_off(D0, 0, 0)>(vb), h0 = tr_read<v_rd_off(D0, 0, 1)>(vb), l1 = tr_read<v_rd_off(D0, 1, 0)>(vb), h1 = tr_read<v_rd_off(D0, 1, 1)>(vb);
  const s16x4 l2 = tr_read<v_rd_off(D0, 2, 0)>(vb), h2 = tr_read<v_rd_off(D0, 2, 1)>(vb), l3 = tr_read<v_rd_off(D0, 3, 0)>(vb), h3 = tr_read<v_rd_off(D0, 3, 1)>(vb);
  asm volatile("s_waitcnt lgkmcnt(0)" ::: "memory"); SBAR();
#define PK(L, H) (bf16x8){L[0], L[1], L[2], L[3], H[0], H[1], H[2], H[3]}
  od = __builtin_amdgcn_mfma_f32_32x32x16_bf16(pa0, PK(l0, h0), od, 0, 0, 0);
  od = __builtin_amdgcn_mfma_f32_32x32x16_bf16(pa1, PK(l1, h1), od, 0, 0, 0);
  od = __builtin_amdgcn_mfma_f32_32x32x16_bf16(pa2, PK(l2, h2), od, 0, 0, 0);
  od = __builtin_amdgcn_mfma_f32_32x32x16_bf16(pa3, PK(l3, h3), od, 0, 0, 0);
#undef PK
}
__device__ __forceinline__ void pv_d0(f32x16* o, int vb, bf16x8 pa0, bf16x8 pa1, bf16x8 pa2, bf16x8 pa3) {
  pv_one<0>(o[0], vb, pa0, pa1, pa2, pa3); pv_one<1>(o[1], vb, pa0, pa1, pa2, pa3); pv_one<2>(o[2], vb, pa0, pa1, pa2, pa3); pv_one<3>(o[3], vb, pa0, pa1, pa2, pa3);
}

__device__ __forceinline__ void sm_half(f32x16& p, float& m_reg, float& l_reg, float& alpha, bf16x8& paL, bf16x8& paH) {
  float a = fmaxf(fmaxf(p[0], p[1]), p[2]), b = fmaxf(fmaxf(p[3], p[4]), p[5]);
  a = fmaxf(fmaxf(a, p[6]), p[7]); b = fmaxf(fmaxf(b, p[8]), p[9]); a = fmaxf(fmaxf(a, p[10]), p[11]); b = fmaxf(fmaxf(b, p[12]), p[13]); a = fmaxf(fmaxf(a, p[14]), p[15]);
  float pmax = fmaxf(a, b);
  { auto rr = __builtin_amdgcn_permlane32_swap(__float_as_uint(pmax), __float_as_uint(pmax), false, false);
    pmax = fmaxf(__uint_as_float(rr[0]), __uint_as_float(rr[1])); }
  const bool keep = __all(pmax - m_reg <= THRL);
  const float mn = keep ? m_reg : fmaxf(m_reg, pmax);
  alpha = __builtin_amdgcn_exp2f(m_reg - mn); m_reg = mn;
#pragma unroll
  for (int r = 0; r < 16; ++r) p[r] = __builtin_amdgcn_exp2f(p[r] - mn);
  float ps = 0;
#pragma unroll
  for (int r = 0; r < 16; ++r) ps += p[r];
  { auto rr = __builtin_amdgcn_permlane32_swap(__float_as_uint(ps), __float_as_uint(ps), false, false);
    ps = __uint_as_float(rr[0]) + __uint_as_float(rr[1]); }
  l_reg = l_reg * alpha + ps;
#define PK4(P, BASE, OUT) do { unsigned a0 = cvtpk(P[BASE + 0], P[BASE + 1]), a1 = cvtpk(P[BASE + 2], P[BASE + 3]);   \
    unsigned b0 = cvtpk(P[BASE + 4], P[BASE + 5]), b1 = cvtpk(P[BASE + 6], P[BASE + 7]);                              \
    auto r0 = __builtin_amdgcn_permlane32_swap(a0, b0, false, false); auto r1 = __builtin_amdgcn_permlane32_swap(a1, b1, false, false); \
    u32x4 w = {r0[0], r1[0], r0[1], r1[1]}; OUT = *reinterpret_cast<bf16x8*>(&w); } while (0)
  PK4(p, 0, paL); PK4(p, 8, paH);
#undef PK4
}
template <int H> __device__ __forceinline__ void qkt_half(f32x16& p, const char* Kn, const char* Kr, const bf16x8* qr, int r32, int hi) {
  p = f32x16{};
#pragma unroll
  for (int d0 = 0; d0 < 8; ++d0) { const int cb = (d0 * 16 + hi * 8) * 2;
    const bf16x8 f = *reinterpret_cast<const bf16x8*>(Kn + KSWZ(32 * H + r32, cb)); p = __builtin_amdgcn_mfma_f32_32x32x16_bf16(f, qr[d0], p, 0, 0, 0); }
#pragma unroll
  for (int d0 = 0; d0 < 4; ++d0) { const int cb = (d0 * 16 + hi * 8) * 2;
    const bf16x8 f = *reinterpret_cast<const bf16x8*>(Kr + KRSWZ(32 * H + r32, cb)); p = __builtin_amdgcn_mfma_f32_32x32x16_bf16(f, qr[8 + d0], p, 0, 0, 0); }
}
struct VFrag { s16x4 l0, h0, l1, h1; };
template <int H, int D0> __device__ __forceinline__ VFrag pv_rd(int vb) {
  VFrag f; f.l0 = tr_read<v_rd_off(D0, 2 * H, 0)>(vb); f.h0 = tr_read<v_rd_off(D0, 2 * H, 1)>(vb); f.l1 = tr_read<v_rd_off(D0, 2 * H + 1, 0)>(vb); f.h1 = tr_read<v_rd_off(D0, 2 * H + 1, 1)>(vb); return f;
}
__device__ __forceinline__ void pv_mma(f32x16& od, VFrag& f, bf16x8 paL, bf16x8 paH) {
#define PK(L, Hh) (bf16x8){L[0], L[1], L[2], L[3], Hh[0], Hh[1], Hh[2], Hh[3]}
  od = __builtin_amdgcn_mfma_f32_32x32x16_bf16(paL, PK(f.l0, f.h0), od, 0, 0, 0);
  od = __builtin_amdgcn_mfma_f32_32x32x16_bf16(paH, PK(f.l1, f.h1), od, 0, 0, 0);
#undef PK
}
#define VWAIT(N, f) asm volatile("s_waitcnt lgkmcnt(" #N ")" : "+v"(f.l0), "+v"(f.h0), "+v"(f.l1), "+v"(f.h1) :: "memory")
template <int H> __device__ __forceinline__ void pv_half(f32x16* o, int vb, bf16x8 paL, bf16x8 paH) {
  VFrag fa = pv_rd<H, 0>(vb), fb = pv_rd<H, 1>(vb);
  VWAIT(4, fa); pv_mma(o[0], fa, paL, paH);
  fa = pv_rd<H, 2>(vb);
  VWAIT(4, fb); pv_mma(o[1], fb, paL, paH);
  fb = pv_rd<H, 3>(vb);
  VWAIT(4, fa); pv_mma(o[2], fa, paL, paH);
  VWAIT(0, fb); pv_mma(o[3], fb, paL, paH);
}
#undef VWAIT

__device__ __forceinline__ void attn_unit(const bf16_t* __restrict__ Qb, const bf16_t* __restrict__ KNh, const bf16_t* __restrict__ KRs, const bf16_t* __restrict__ Vh,
                                          bf16_t* __restrict__ Ob, float* __restrict__ ssa, int seq, char* lds) {
  const int tid = threadIdx.x, wid = __builtin_amdgcn_readfirstlane(tid >> 6), lane = tid & 63, r32 = lane & 31, hi = lane >> 5;
  char* V_lds = lds + OFF_V; char* KN_lds = lds + OFF_KN; char* KR_lds = lds + OFF_KR;
  float* ws = (float*)(lds + OFF_WS) + wid * 64; float* li_l = ws; float* al_l = ws + 32;
  float m_reg = -1e30f, l_reg = 0; f32x16 o[4] = {}; bf16x8 qr[12];
  const bf16_t* Qw = Qb + (long)(wid * QBLK + r32) * LDQ + hi * 8;
#pragma unroll
  for (int d0 = 0; d0 < 12; ++d0) qr[d0] = *reinterpret_cast<const bf16x8*>(Qw + d0 * 16);
  const int vb0 = (int)(uintptr_t)V_lds + v_rd_base(lane);
  unsigned kn_off[2], v_off[2], kr_off;
#pragma unroll
  for (int i = 0; i < 2; ++i) {
    const int q = (wid * 2 + i) * 64 + lane;
    { const int row = q >> 4, c = (q & 15) ^ (row & 15); kn_off[i] = (unsigned)(row * LDKN * 2 + c * 16); }
    { const int sub = q >> 5, kk = (sub >> 2) * 8 + ((q & 31) >> 2), cc = (sub & 3) * 32 + (q & 3) * 8, k = (kk & ~0xC) | ((kk & 4) << 1) | ((kk & 8) >> 1);
      v_off[i] = (unsigned)(k * LDV * 2 + cc * 2); }
  }
  { const int q = wid * 64 + lane, row = q >> 3, c = (q & 7) ^ ((row >> 1) & 7); kr_off = (unsigned)(row * LDKR * 2 + c * 16); }
  typedef __attribute__((address_space(3))) unsigned lds_u32;
#define GLDS(gp, lp) __builtin_amdgcn_global_load_lds((const unsigned*)(gp), (lds_u32*)(lp), 16, 0, 0)
#define DMA_KN(k0, s) do { const char* kb_ = (const char*)KNh + (size_t)(k0) * (LDKN * 2); \
    GLDS(kb_ + kn_off[0], KN_lds + (s) * SHM_KN + (wid * 2) * 1024); GLDS(kb_ + kn_off[1], KN_lds + (s) * SHM_KN + (wid * 2 + 1) * 1024); } while (0)
#define DMA_KR(k0, s) do { const char* rb_ = (const char*)KRs + (size_t)(k0) * (LDKR * 2); GLDS(rb_ + kr_off, KR_lds + (s) * SHM_KR + wid * 1024); } while (0)
#define DMA_K(k0, s) do { DMA_KN(k0, s); DMA_KR(k0, s); } while (0)
#define DMA_V(k0, off) do { const char* vb_ = (const char*)Vh + (size_t)(k0) * (LDV * 2); \
    GLDS(vb_ + v_off[0], V_lds + (off) + (wid * 2) * 1024); GLDS(vb_ + v_off[1], V_lds + (off) + (wid * 2 + 1) * 1024); } while (0)
#define RESC(a) do { if (__any((a) < 1.f)) { if (hi == 0) al_l[r32] = (a); asm volatile("s_waitcnt lgkmcnt(0)" ::: "memory"); \
    _Pragma("unroll") for (int d = 0; d < 4; ++d) _Pragma("unroll") for (int r = 0; r < 16; ++r) o[d][r] *= al_l[crow(r, hi)]; } } while (0)
  f32x16 p0, p1; float al0, al1; bf16x8 pa0, pa1, pa2, pa3; const int NT = seq / KVBLK;
#define STEP(b, j) do { \
    if ((j) + 1 < NT) { DMA_KN(((j) + 1) * KVBLK, (b) ^ 1); } SBAR(); \
    qkt_half<0>(p0, KN_lds + (b) * SHM_KN, KR_lds + (b) * SHM_KR, qr, r32, hi); SBAR(); \
    qkt_half<1>(p1, KN_lds + (b) * SHM_KN, KR_lds + (b) * SHM_KR, qr, r32, hi); sm_half(p0, m_reg, l_reg, al0, pa0, pa1); SBAR(); \
    RESC(al0); SBAR(); \
    if ((j) + 1 < NT) { DMA_KR(((j) + 1) * KVBLK, (b) ^ 1); DMA_V(((j) + 1) * KVBLK, ((b) ^ 1) * SHM_V); } SBAR();     \
    pv_half<0>(o, vb0 + (b) * SHM_V, pa0, pa1); sm_half(p1, m_reg, l_reg, al1, pa2, pa3); SBAR(); \
    RESC(al1); SBAR(); \
    pv_half<1>(o, vb0 + (b) * SHM_V, pa2, pa3); \
    asm volatile("s_waitcnt vmcnt(0)" ::: "memory"); __syncthreads(); } while (0)
  DMA_K(0, 0); DMA_V(0, 0);
  asm volatile("s_waitcnt vmcnt(0)" ::: "memory"); __syncthreads();
#pragma unroll 1
  for (int j = 0; j < NT; j += 2) { STEP(0, j); STEP(1, j + 1); }
#undef STEP
  if (hi == 0) li_l[r32] = l_reg; asm volatile("s_waitcnt lgkmcnt(0)" ::: "memory");
  int zo = 0; asm volatile("" : "+v"(zo));
  bf16_t* Ow = Ob + (long)(wid * QBLK) * LDO; float* ssw = ssa + wid * QBLK;
#pragma unroll
  for (int r = 0; r < 16; ++r) { const int orow = crow(r, hi) + zo; const float rl = __builtin_amdgcn_rcpf(li_l[orow]); float s = 0.f;
#pragma unroll
    for (int d0 = 0; d0 < 4; ++d0) { const float v = o[d0][r] * rl; s += v * v; Ow[(long)orow * LDO + d0 * 32 + r32] = (bf16_t)(cvtpk(v, v) & 0xffffu); }
    s += __shfl_xor(s, 1); s += __shfl_xor(s, 2); s += __shfl_xor(s, 4); s += __shfl_xor(s, 8); s += __shfl_xor(s, 16);
    if (r32 == 0) atomicAdd(ssw + orow, s); }
  __syncthreads();
#undef GLDS
#undef DMA_K
#undef DMA_KN
#undef DMA_KR
#undef DMA_V
#undef RESC
}
#undef KSWZ
#undef KRSWZ
#undef SBAR
}

constexpr int NWAVES = 8, NTHREADS = 512;
constexpr size_t MiB = 1u << 20;
constexpr size_t WS_SS = 0;
constexpr size_t WS_MOD = 2 * MiB;
constexpr size_t WS_ROPE = 3 * MiB;
constexpr size_t WS_WIN = 7 * MiB, WS_WUQ = 9 * MiB, WS_WUKV = 10 * MiB, WS_WOUT = 11 * MiB, WS_WGU = 13 * MiB, WS_WD = 24 * MiB;
constexpr size_t WS_HB = 32 * MiB;
constexpr size_t WS_U = 192 * MiB, WS_CQ = 232 * MiB, WS_CKV = 292 * MiB, WS_KR = 332 * MiB;
constexpr size_t WS_Q = 342 * MiB, WS_KN = 522 * MiB, WS_V = 642 * MiB, WS_MX = 762 * MiB, WS_END = 922 * MiB;
constexpr size_t WS_MG = WS_Q;
constexpr size_t WS_ACT = WS_U;
constexpr size_t WS_F = WS_V;
static_assert(WS_ACT + (size_t)TT * DFF * 2 <= WS_F && WS_F + (size_t)TT * DM * 2 <= WS_END && WS_WD + (size_t)DM * DFF * 2 <= WS_HB, "d_ws map");
constexpr int LDS_BYTES = 147456;
constexpr int MISC_OFF = 131072 + 320;
constexpr size_t WS_BAR = 1835008;

#define LAS __attribute__((address_space(3)))
typedef unsigned short bf16;
typedef float f32x4 __attribute__((ext_vector_type(4)));
typedef unsigned v4u __attribute__((ext_vector_type(4)));
typedef unsigned v2u __attribute__((ext_vector_type(2)));
__device__ __forceinline__ unsigned pkbf(float lo, float hi) { unsigned r; asm volatile("v_cvt_pk_bf16_f32 %0, %1, %2" : "=v"(r) : "v"(lo), "v"(hi)); return r; }
__device__ __forceinline__ float bf2f(unsigned short b) { return __uint_as_float((unsigned)b << 16); }
__device__ __forceinline__ float wave_sum(float v) {
#pragma unroll
    for (int o = 1; o < 64; o <<= 1) v += __shfl_xor(v, o);
    return v;
}

struct Params { const float* in[23]; float* out; unsigned char* ws; int ph_lo, ph_hi; };
enum { I_XP = 0, I_XS, I_CP, I_CS, I_WADA, I_BADA, I_GMIXPRE, I_GMIXPOST, I_WIN, I_POOLW, I_POOLSCALE, I_GQA, I_WUQ, I_GKVA, I_WUKV, I_GPOOLOUT, I_GATTNOUT, I_WOUT, I_GFFNPRE, I_GFFNPOST, I_WGATE, I_WUP, I_WDOWN };

struct WSrc { const float* p; int col; };
__device__ __forceinline__ WSrc wmap(const Params& a, int mat, int n) {
    if (mat == 0) {
        if (n >= 960) return {nullptr, 0};
        if (n < 896) return {a.in[I_WIN], n};
        const int pp = n - 896, ch = pp >> 5, w = pp & 31, nn = w >> 4, i = 16 * ch + (w & 15); return {a.in[I_WIN], 896 + i + 32 * nn};
    } else if (mat == 1) {
        const int cc = n >> 5, w = n & 31; if (cc >= 36) return {nullptr, 0};
        const int h = cc / 6, j6 = cc - 6 * h;
        if (j6 < 4) return {a.in[I_WUQ], h * DQK + 32 * j6 + w};
        const int nn = w >> 4, i = 16 * (j6 - 4) + (w & 15); return {a.in[I_WUQ], h * DQK + DNOPE + i + 32 * nn};
    } else if (mat == 2) return {a.in[I_WUKV], n};
    else if (mat == 3) return {a.in[I_WOUT], n};
    else if (mat == 4) { const int cc = n >> 5, w = n & 31, nn = w >> 4; return {nn ? a.in[I_WUP] : a.in[I_WGATE], 16 * cc + (w & 15)}; }
    return {a.in[I_WDOWN], n};
}
__device__ __forceinline__ float wgain(const Params& a, int mat, int k) {
    if (mat == 1) return a.in[I_GQA][k];
    if (mat == 2) return a.in[I_GKVA][k];
    if (mat == 3) return k < POOLW ? a.in[I_GPOOLOUT][k] : a.in[I_GATTNOUT][k - POOLW];
    return 1.0f;
}
__device__ __forceinline__ void p0_transpose_item(const Params& a, int mat, int K, int Nsrc, int Ndst, bf16* WT, LAS float* scr, int item, int lane) {
    const int nblk = Ndst / 32, kb = item / nblk, nb = item % nblk, k0 = 64 * kb, n0 = 32 * nb;
    const WSrc s = wmap(a, mat, n0 + (lane & 31));
#pragma unroll 8
    for (int i = 0; i < 32; ++i) { const int kk = 2 * i + (lane >> 5); scr[kk * 33 + (lane & 31)] = s.p ? s.p[(size_t)(k0 + kk) * Nsrc + s.col] * wgain(a, mat, k0 + kk) : 0.f; }
    asm volatile("s_waitcnt lgkmcnt(0)" ::: "memory");
    const int c = lane & 7;
#pragma unroll
    for (int j = 0; j < 4; ++j) { const int n = (lane >> 3) + 8 * j; const LAS float* sp = scr + (8 * c) * 33 + n;
        v4u o; o.x = pkbf(sp[0 * 33], sp[1 * 33]); o.y = pkbf(sp[2 * 33], sp[3 * 33]); o.z = pkbf(sp[4 * 33], sp[5 * 33]); o.w = pkbf(sp[6 * 33], sp[7 * 33]);
        *(v4u*)(WT + (size_t)(n0 + n) * K + k0 + 8 * c) = o; }
    asm volatile("s_waitcnt lgkmcnt(0)" ::: "memory");
}
__constant__ double INV_FREQ[32] = {1.0, 0.7498942093324559, 0.5623413251903491, 0.4216965034285822, 0.31622776601683794, 0.23713737056616552, 0.1778279410038923, 0.1333521432163324,
    0.1, 0.07498942093324558, 0.05623413251903491, 0.042169650342858224, 0.03162277660168379, 0.023713737056616554, 0.01778279410038923, 0.01333521432163324,
    0.01, 0.007498942093324558, 0.005623413251903491, 0.004216965034285823, 0.0031622776601683794, 0.0023713737056616554, 0.0017782794100389228, 0.001333521432163324,
    0.001, 0.0007498942093324559, 0.0005623413251903491, 0.00042169650342858224, 0.00031622776601683794, 0.00023713737056616554, 0.00017782794100389227, 0.0001333521432163324};
__device__ __forceinline__ void rope_entry(float* dst, int s, int i) {
    const double ang = (double)s * INV_FREQ[i];
    const double q = __builtin_rint(ang * 0.6366197723675814);
    double r = __builtin_fma(-q, 1.5707963267948966, ang); r = __builtin_fma(-q, 6.123233995736766e-17, r);
    const double r2 = r * r;
    const double sn = r * (1.0 + r2 * (-1.0 / 6 + r2 * (1.0 / 120 + r2 * (-1.0 / 5040 + r2 * (1.0 / 362880 + r2 * (-1.0 / 39916800 + r2 * (1.0 / 6227020800.0)))))));
    const double cn = 1.0 + r2 * (-0.5 + r2 * (1.0 / 24 + r2 * (-1.0 / 720 + r2 * (1.0 / 40320 + r2 * (-1.0 / 3628800 + r2 * (1.0 / 479001600 + r2 * (-1.0 / 87178291200.0)))))));
    const int qi = (int)((long long)q & 3);
    const double c = (qi == 0) ? cn : (qi == 1) ? -sn : (qi == 2) ? -cn : sn;
    const double sv = (qi == 0) ? sn : (qi == 1) ? cn : (qi == 2) ? -sn : -cn;
    dst[0] = (float)c; dst[1] = (float)sv;
}
__device__ __forceinline__ void p0a_prologue(const Params& a, LAS unsigned char* lds) {
    const int tid = threadIdx.x, lane = tid & 63, wave = __builtin_amdgcn_readfirstlane(tid >> 6);
    unsigned char* ws = a.ws;
    const int G = gridDim.x, gw = blockIdx.x * NWAVES + wave, NGW = G * NWAVES, gt = blockIdx.x * NTHREADS + tid, NGT = G * NTHREADS;
    { f32x4* z = (f32x4*)(ws + WS_SS); for (int i = gt; i < 5 * TT / 4; i += NGT) z[i] = (f32x4){0.f, 0.f, 0.f, 0.f}; }
    { float* rt = (float*)(ws + WS_ROPE); for (int i = gt; i < SEQ_S * 32; i += NGT) rope_entry(rt + 2 * (size_t)i, i >> 5, i & 31); }
    {
        LAS float* scr = (LAS float*)(lds + wave * 16384);
        constexpr int I0 = 16 * 32, I1 = 6 * 40, I2 = 4 * 48, I3 = 16 * 32, I4 = 16 * 176, I5 = 44 * 32;
        constexpr int NITEMS = I0 + I1 + I2 + I3 + I4 + I5;
        for (int it = gw; it < NITEMS; it += NGW) {
            int r = it;
            if (r < I0) { p0_transpose_item(a, 0, DM, 960, 1024, (bf16*)(ws + WS_WIN), scr, r, lane); continue; } r -= I0;
            if (r < I1) { p0_transpose_item(a, 1, QLR, LDQ_, 1280, (bf16*)(ws + WS_WUQ), scr, r, lane); continue; } r -= I1;
            if (r < I2) { p0_transpose_item(a, 2, KVLR, 1536, 1536, (bf16*)(ws + WS_WUKV), scr, r, lane); continue; } r -= I2;
            if (r < I3) { p0_transpose_item(a, 3, DM, DM, DM, (bf16*)(ws + WS_WOUT), scr, r, lane); continue; } r -= I3;
            if (r < I4) { p0_transpose_item(a, 4, DM, DFF, 2 * DFF, (bf16*)(ws + WS_WGU), scr, r, lane); continue; } r -= I4;
            p0_transpose_item(a, 5, DFF, DM, DM, (bf16*)(ws + WS_WD), scr, r, lane);
        }
    }
    __syncthreads();
    for (int bb = blockIdx.x; bb < 96; bb += G) {
        float accb[NBATCH];
#pragma unroll
        for (int b = 0; b < NBATCH; ++b) accb[b] = 0.f;
        const float* wa = a.in[I_WADA] + bb * 64 + lane;
        for (int k0 = wave * 128; k0 < wave * 128 + 128; k0 += 16) {
            float w[16];
#pragma unroll
            for (int kk = 0; kk < 16; ++kk) w[kk] = wa[(size_t)(k0 + kk) * 6144];
#pragma unroll
            for (int kk = 0; kk < 16; ++kk) {
#pragma unroll
                for (int b = 0; b < NBATCH; ++b) { const float c = (b < 8) ? a.in[I_CP][b * DM + k0 + kk] : a.in[I_CS][k0 + kk]; accb[b] += (c / (1.0f + __expf(-c))) * w[kk]; } }
        }
        LAS float* red = (LAS float*)lds;
#pragma unroll
        for (int b = 0; b < NBATCH; ++b) red[(wave * NBATCH + b) * 64 + lane] = accb[b];
        __syncthreads();
        for (int idx = tid; idx < NBATCH * 64; idx += NTHREADS) { const int b = idx >> 6, l = idx & 63; float s = a.in[I_BADA][bb * 64 + l];
#pragma unroll
            for (int w = 0; w < 8; ++w) s += red[(w * NBATCH + b) * 64 + l];
            ((float*)(ws + WS_MOD))[b * 6144 + bb * 64 + l] = s; }
        __syncthreads();
    }
}

__device__ __forceinline__ const float* xrow_ptr(const Params& a, int t) { return t < T_P ? a.in[I_XP] + (size_t)t * DM : a.in[I_XS] + (size_t)(t - T_P) * DM; }
__device__ __forceinline__ int batch_of(int t) { return t < T_P ? (t >> 13) : 8; }
__device__ __forceinline__ void st4bf(bf16* p, f32x4 v) { v2u w; w.x = pkbf(v[0], v[1]); w.y = pkbf(v[2], v[3]); *(v2u*)p = w; }
__device__ __forceinline__ f32x4 ld4bf(const bf16* p) { const v2u w = *(const v2u*)p; return (f32x4){__uint_as_float(w.x << 16), __uint_as_float(w.x & 0xffff0000u), __uint_as_float(w.y << 16), __uint_as_float(w.y & 0xffff0000u)}; }

__device__ __forceinline__ void wave_sum2(float& a, float& b) {
#pragma unroll
    for (int o = 1; o < 64; o <<= 1) { const float ta = __shfl_xor(a, o), tb = __shfl_xor(b, o); a += ta; b += tb; }
}
__device__ __forceinline__ float ssq4(f32x4 v) { return (v[0] * v[0] + v[1] * v[1]) + (v[2] * v[2] + v[3] * v[3]); }
#define ROWS_SETUP const int tid = threadIdx.x, lane = tid & 63, wave = __builtin_amdgcn_readfirstlane(tid >> 6); \
    const int NGW = gridDim.x * NWAVES, gw = blockIdx.x * NWAVES + wave, per = (((TT + NGW - 1) / NGW) + 1) & ~1, t_lo = gw * per, t_hi = min(TT, t_lo + per); (void)tid;
__device__ __forceinline__ void p0b_rows(const Params& a) {
    ROWS_SETUP
    const float* mod = (const float*)(a.ws + WS_MOD); bf16* HB = (bf16*)(a.ws + WS_HB);
    int bcur = -1; f32x4 A0[4], S1[4];
    for (int t = t_lo; t < t_hi; t += 2) {
        const int b = batch_of(t);
        if (b != bcur) { bcur = b;
#pragma unroll
            for (int j = 0; j < 4; ++j) { const int c = 4 * lane + 256 * j; const f32x4 g = *(const f32x4*)(a.in[I_GMIXPRE] + c), sc = *(const f32x4*)(mod + b * 6144 + 1024 + c);
                A0[j] = g * (sc + 1.0f); S1[j] = *(const f32x4*)(mod + b * 6144 + c); } }
        const f32x4* xr = (const f32x4*)xrow_ptr(a, t) + lane; f32x4 v[2][4]; float s0 = 0.f, s1 = 0.f;
#pragma unroll
        for (int j = 0; j < 4; ++j) { v[0][j] = xr[64 * j]; v[1][j] = xr[256 + 64 * j]; }
#pragma unroll
        for (int j = 0; j < 4; ++j) { s0 += ssq4(v[0][j]); s1 += ssq4(v[1][j]); }
        wave_sum2(s0, s1);
        const float r0 = 1.0f / sqrtf(s0 * (1.0f / DM) + EPS), r1 = 1.0f / sqrtf(s1 * (1.0f / DM) + EPS);
#pragma unroll
        for (int j = 0; j < 4; ++j) { st4bf(HB + (size_t)t * DM + 4 * lane + 256 * j, v[0][j] * r0 * A0[j] + S1[j]); st4bf(HB + (size_t)(t + 1) * DM + 4 * lane + 256 * j, v[1][j] * r1 * A0[j] + S1[j]); }
    }
}
__device__ __forceinline__ void p6_rows(const Params& a) {
    ROWS_SETUP
    const float* mod = (const float*)(a.ws + WS_MOD); bf16* HB = (bf16*)(a.ws + WS_HB); const bf16* MG = (const bf16*)(a.ws + WS_MG);
    const float* ssm = (const float*)(a.ws + WS_SS) + 3 * (size_t)TT;
    int bcur = -1; f32x4 A1[4], B2[4], S2[4];
    for (int t = t_lo; t < t_hi; t += 2) {
        const int b = batch_of(t);
        if (b != bcur) { bcur = b;
#pragma unroll
            for (int j = 0; j < 4; ++j) { const int c = 4 * lane + 256 * j;
                A1[j] = *(const f32x4*)(mod + b * 6144 + 2048 + c) * *(const f32x4*)(a.in[I_GMIXPOST] + c);
                B2[j] = *(const f32x4*)(a.in[I_GFFNPRE] + c) * (*(const f32x4*)(mod + b * 6144 + 4096 + c) + 1.0f);
                S2[j] = *(const f32x4*)(mod + b * 6144 + 3072 + c); } }
        const float rm0 = 1.0f / sqrtf(ssm[t] * (1.0f / DM) + EPS), rm1 = 1.0f / sqrtf(ssm[t + 1] * (1.0f / DM) + EPS);
        const f32x4* xr = (const f32x4*)xrow_ptr(a, t) + lane; f32x4 v[2][4], mg[2][4]; float s0 = 0.f, s1 = 0.f;
#pragma unroll
        for (int j = 0; j < 4; ++j) { v[0][j] = xr[64 * j]; v[1][j] = xr[256 + 64 * j];
            mg[0][j] = ld4bf(MG + (size_t)t * DM + 4 * lane + 256 * j); mg[1][j] = ld4bf(MG + (size_t)(t + 1) * DM + 4 * lane + 256 * j); }
#pragma unroll
        for (int j = 0; j < 4; ++j) { v[0][j] = v[0][j] + A1[j] * (mg[0][j] * rm0); v[1][j] = v[1][j] + A1[j] * (mg[1][j] * rm1); s0 += ssq4(v[0][j]); s1 += ssq4(v[1][j]); }
        wave_sum2(s0, s1);
        const float r0 = 1.0f / sqrtf(s0 * (1.0f / DM) + EPS), r1 = 1.0f / sqrtf(s1 * (1.0f / DM) + EPS);
        f32x4* orow = (f32x4*)(a.out + (size_t)t * DM) + lane;
#pragma unroll
        for (int j = 0; j < 4; ++j) { orow[64 * j] = v[0][j]; orow[256 + 64 * j] = v[1][j];
            st4bf(HB + (size_t)t * DM + 4 * lane + 256 * j, v[0][j] * r0 * B2[j] + S2[j]); st4bf(HB + (size_t)(t + 1) * DM + 4 * lane + 256 * j, v[1][j] * r1 * B2[j] + S2[j]); }
    }
}
__device__ __forceinline__ void p9_rows(const Params& a) {
    ROWS_SETUP
    const float* mod = (const float*)(a.ws + WS_MOD); const bf16* FB = (const bf16*)(a.ws + WS_F);
    const float* ssf = (const float*)(a.ws + WS_SS) + 4 * (size_t)TT;
    int bcur = -1; f32x4 A2[4];
    for (int t = t_lo; t < t_hi; t += 2) {
        const int b = batch_of(t);
        if (b != bcur) { bcur = b;
#pragma unroll
            for (int j = 0; j < 4; ++j) { const int c = 4 * lane + 256 * j; A2[j] = *(const f32x4*)(mod + b * 6144 + 5120 + c) * *(const f32x4*)(a.in[I_GFFNPOST] + c); } }
        const float rf0 = 1.0f / sqrtf(ssf[t] * (1.0f / DM) + EPS), rf1 = 1.0f / sqrtf(ssf[t + 1] * (1.0f / DM) + EPS);
        f32x4* orow = (f32x4*)(a.out + (size_t)t * DM) + lane; f32x4 x1[2][4], f[2][4];
#pragma unroll
        for (int j = 0; j < 4; ++j) { x1[0][j] = orow[64 * j]; x1[1][j] = orow[256 + 64 * j];
            f[0][j] = ld4bf(FB + (size_t)t * DM + 4 * lane + 256 * j); f[1][j] = ld4bf(FB + (size_t)(t + 1) * DM + 4 * lane + 256 * j); }
#pragma unroll
        for (int j = 0; j < 4; ++j) { orow[64 * j] = x1[0][j] + A2[j] * (f[0][j] * rf0); orow[256 + 64 * j] = x1[1][j] + A2[j] * (f[1][j] * rf1); }
    }
}
#undef ROWS_SETUP

__device__ __forceinline__ void pool_phase(const Params& a, LAS unsigned char* lds) {
    const int tid = threadIdx.x, lane = tid & 63, wave = __builtin_amdgcn_readfirstlane(tid >> 6);
    const bf16* U = (const bf16*)(a.ws + WS_U); bf16* MX = (bf16*)(a.ws + WS_MX); const float* ssa = (const float*)(a.ws + WS_SS) + 2 * (size_t)TT;
    LAS float* ps = (LAS float*)lds;
    LAS float* ssl = (LAS float*)(lds + 65536);
    LAS unsigned char* us = lds + 65536 + 1024;
    const int g = wave & 3, half = wave >> 2, d = lane;
    float wreg[64];
#pragma unroll
    for (int c = 0; c < 64; ++c) wreg[c] = a.in[I_POOLW][g * 4096 + c * 64 + d];
    const float pscale = a.in[I_POOLSCALE][64 * g + d];
    for (int tile = blockIdx.x; tile < TT / 64; tile += gridDim.x) {
        const int t0 = tile * 64, sb = t0 < T_P ? (t0 & ~(SEQ_P - 1)) : T_P, se = t0 < T_P ? sb + SEQ_P : TT;
#pragma unroll
        for (int it = 0; it < 5; ++it) { const int idx = tid + NTHREADS * it, rl = idx >> 5, ch8 = idx & 31, tr = t0 - 8 + rl;
            if (tr >= sb && tr < se) *(LAS v4u*)(us + rl * 512 + ch8 * 16) = *(const v4u*)(U + (size_t)tr * POOLW + ch8 * 8); }
        __syncthreads();
#pragma unroll 1
        for (int it = 0; it < 4; ++it) {
            const int idx = tid + NTHREADS * it, tl = idx >> 5, ch8 = idx & 31, t = t0 + tl, w = 2 << (ch8 >> 3);
            const int lo = max(t - (w >> 1), sb), hi = min(t + w - (w >> 1), se);
            float sum[8];
#pragma unroll
            for (int e = 0; e < 8; ++e) sum[e] = 0.f;
            for (int j = lo; j < hi; ++j) { const v4u q = *(const LAS v4u*)(us + (j - t0 + 8) * 512 + ch8 * 16);
#pragma unroll
                for (int e = 0; e < 4; ++e) { sum[2 * e] += __uint_as_float(q[e] << 16); sum[2 * e + 1] += __uint_as_float(q[e] & 0xffff0000u); } }
            const v4u q = *(const LAS v4u*)(us + (tl + 8) * 512 + ch8 * 16); const float inv = 1.0f / (float)(hi - lo);
            f32x4 o0, o1;
#pragma unroll
            for (int e = 0; e < 2; ++e) { o0[2 * e] = sum[2 * e] * inv - __uint_as_float(q[e] << 16); o0[2 * e + 1] = sum[2 * e + 1] * inv - __uint_as_float(q[e] & 0xffff0000u);
                o1[2 * e] = sum[4 + 2 * e] * inv - __uint_as_float(q[2 + e] << 16); o1[2 * e + 1] = sum[5 + 2 * e] * inv - __uint_as_float(q[2 + e] & 0xffff0000u); }
            *(LAS f32x4*)(ps + tl * 256 + ch8 * 8) = o0; *(LAS f32x4*)(ps + tl * 256 + ch8 * 8 + 4) = o1;
        }
        __syncthreads();
        float o[32];
#pragma unroll
        for (int tt = 0; tt < 32; ++tt) { const int tl = half * 32 + tt; float acc = 0.f;
#pragma unroll
            for (int c4 = 0; c4 < 16; ++c4) { const f32x4 pv = *(const LAS f32x4*)(ps + tl * 256 + g * 64 + c4 * 4);
                acc += pv[0] * wreg[4 * c4] + pv[1] * wreg[4 * c4 + 1] + pv[2] * wreg[4 * c4 + 2] + pv[3] * wreg[4 * c4 + 3]; }
            o[tt] = acc * pscale; const float s = wave_sum(o[tt] * o[tt]);
            if (lane == 0) ssl[g * 64 + tl] = s; }
        __syncthreads();
#pragma unroll
        for (int tt = 0; tt < 32; ++tt) { const int tl = half * 32 + tt, t = t0 + tl;
            const float f = sqrtf(ssa[t] * (1.0f / (NH * DV)) + EPS) / sqrtf(((ssl[tl] + ssl[64 + tl]) + (ssl[128 + tl] + ssl[192 + tl])) * (1.0f / POOLW) + EPS);
            MX[(size_t)t * DM + 64 * g + d] = (bf16)(pkbf(o[tt] * f, 0.f) & 0xffffu); }
        __syncthreads();
    }
}
#define XB_TMO      128
#define XB_XCNT(j)  (256  + 64 * (j))
#define XB_XSUB(j)  (1280 + 64 * (j))
#define XB_XGEN(j)  (2304 + 64 * (j))
#define XB_TOP      3328
#define XB_TOPGEN   3392
#define XCD_BAR_WORDS 3456
#define XB_SPIN_CAP (1u << 18)

__device__ __forceinline__ unsigned xb_ld(unsigned* p)              { return __hip_atomic_load(p, __ATOMIC_RELAXED, __HIP_MEMORY_SCOPE_AGENT); }
__device__ __forceinline__ unsigned xb_add(unsigned* p, unsigned v) { return __hip_atomic_fetch_add(p, v, __ATOMIC_RELAXED, __HIP_MEMORY_SCOPE_AGENT); }
__device__ __forceinline__ unsigned xb_xcc_id() { return (unsigned)__builtin_amdgcn_s_getreg((3 << 11) | 20) & 0xFu; }
#define XB_SPIN(cond, bar) do { unsigned _sp = 0; while (cond) { __builtin_amdgcn_s_sleep(1); \
    if ((++_sp & 255u) == 0u) { if (xb_ld(&(bar)[XB_TMO])) break; if (_sp > XB_SPIN_CAP) { atomicAdd(&(bar)[XB_TMO], 1u); break; } } } } while (0)

struct XcdBarrier {
    unsigned* bar; unsigned x;
    volatile LAS unsigned* st;
};

__device__ __forceinline__ XcdBarrier xcd_barrier_post(unsigned* bar, volatile LAS unsigned* st) {
    XcdBarrier b; b.bar = bar; b.x = xb_xcc_id(); b.st = st;
    if (threadIdx.x == 0) (void)xb_add(&bar[XB_XCNT(b.x)], 1u);
    return b;
}
__device__ __forceinline__ void xcd_barrier_complete(unsigned* bar, unsigned x, unsigned& nloc, unsigned& nx) {
    const unsigned G = gridDim.x * gridDim.y * gridDim.z;
    unsigned sum, cnt, mine, sp = 0u;
    for (;;) {
        sum = 0u; cnt = 0u; mine = 0u;
#pragma unroll
        for (unsigned j = 0; j < 16; ++j) { const unsigned c = xb_ld(&bar[XB_XCNT(j)]); sum += c; cnt += (c > 0u) ? 1u : 0u; mine = (j == x) ? c : mine; }
        if (sum == G) break;
        __builtin_amdgcn_s_sleep(1);
        if ((++sp & 255u) == 0u) { if (xb_ld(&bar[XB_TMO])) break; if (sp > XB_SPIN_CAP) { atomicAdd(&bar[XB_TMO], 1u); break; } }
    }
    nloc = mine > 0u ? mine : 1u; nx = cnt > 0u ? cnt : 1u;
}

__device__ __forceinline__ void xcd_barrier(const XcdBarrier& b) {
    asm volatile("s_waitcnt vmcnt(0)" ::: "memory");
    __syncthreads();
    if (threadIdx.x == 0) {
        unsigned* bar = b.bar;
        __builtin_amdgcn_s_waitcnt(0);
        unsigned nloc = b.st[0], nx = b.st[1];
        if (nloc == 0u) { xcd_barrier_complete(bar, b.x, nloc, nx); b.st[0] = nloc; b.st[1] = nx; }
        const unsigned old = xb_add(&bar[XB_XSUB(b.x)], 1u);
        const unsigned gen = old / nloc;
        if (old + 1u == (gen + 1u) * nloc) {
            __builtin_amdgcn_fence(__ATOMIC_RELEASE, "agent");
            asm volatile("s_waitcnt vmcnt(0)" ::: "memory");
            const unsigned og = xb_add(&bar[XB_TOP], 1u);
            const unsigned tg = og / nx;
            if (og + 1u == (tg + 1u) * nx) xb_add(&bar[XB_TOPGEN], 1u);
            else XB_SPIN(xb_ld(&bar[XB_TOPGEN]) == tg, bar);
            __builtin_amdgcn_fence(__ATOMIC_ACQUIRE, "agent");
            xb_add(&bar[XB_XGEN(b.x)], 1u);
            asm volatile("s_waitcnt vmcnt(0)" ::: "memory");
        } else {
            XB_SPIN(xb_ld(&bar[XB_XGEN(b.x)]) == gen, bar);
            __builtin_amdgcn_fence(__ATOMIC_ACQUIRE, "agent");
            asm volatile("s_waitcnt vmcnt(0)" ::: "memory");
        }
    }
    __syncthreads();
}

constexpr int N_PHASES = 10;
__device__ __forceinline__ void attn_phase(const Params& a, unsigned char* lds) {
    const att::bf16_t* Q = (const att::bf16_t*)(a.ws + WS_Q); const att::bf16_t* KN = (const att::bf16_t*)(a.ws + WS_KN); const att::bf16_t* KR = (const att::bf16_t*)(a.ws + WS_KR);
    const att::bf16_t* V = (const att::bf16_t*)(a.ws + WS_V); att::bf16_t* MX = (att::bf16_t*)(a.ws + WS_MX); float* ssa = (float*)(a.ws + WS_SS) + 2 * (size_t)TT;
    const int G = gridDim.x;
    const int x = blockIdx.x & 7, cu = blockIdx.x >> 3;
    const int ns = x < 4 ? 2 : 1, np = x < 4 ? 5 : 7, p0 = x < 4 ? 5 * x : 20 + 7 * (x - 4);
    const int nunits = (G == 256) ? ns + np : ((TT / 256) * NH - (int)blockIdx.x + G - 1) / G;
    for (int i = 0; i < nunits; ++i) {
        int row0, k0, h, seq;
        if (G == 256) {
            if (i < ns) { h = x < 4 ? x : 4 + ((x - 4) >> 1); const int qb = x < 4 ? cu + 32 * i : ((x - 4) & 1) * 32 + cu; row0 = T_P + qb * 256; k0 = T_P; seq = SEQ_S; }
            else { const int p = p0 + (i - ns), sq = p / NH; h = p - sq * NH; row0 = sq * SEQ_P + cu * 256; k0 = sq * SEQ_P; seq = SEQ_P; }
        } else { const int uidx = blockIdx.x + i * G, rb = uidx / NH; h = uidx - rb * NH; row0 = rb * 256; k0 = row0 < T_P ? (row0 & ~(SEQ_P - 1)) : T_P; seq = row0 < T_P ? SEQ_P : SEQ_S; }
        att::attn_unit(Q + (size_t)row0 * LDQ_ + h * DQK, KN + (size_t)k0 * LDKV_ + h * DNOPE, KR + (size_t)k0 * DROPE, V + (size_t)k0 * LDKV_ + h * DV,
                       MX + (size_t)row0 * DM + POOLW + h * DV, ssa + row0, seq, (char*)lds);
    }
}

__global__ void __launch_bounds__(NTHREADS, 2) enc_fwd(Params a) {
    extern __shared__ __attribute__((aligned(16))) unsigned char lds_raw[];
    LAS unsigned char* lds = (LAS unsigned char*)lds_raw;
    const int lo = a.ph_lo, hi = a.ph_hi, G = gridDim.x;
    unsigned char* ws = a.ws;
    float* SS = (float*)(ws + WS_SS);
#define IN(k) (lo <= (k) && (k) < hi)
    unsigned* barw = (unsigned*)(ws + WS_BAR);
    volatile LAS unsigned* MISC = (volatile LAS unsigned*)(lds + MISC_OFF);
    if (threadIdx.x < 16) MISC[threadIdx.x] = 0u;
    if (IN(0) && IN(1) && blockIdx.x == 0) for (int i = threadIdx.x; i < XCD_BAR_WORDS; i += NTHREADS) barw[i] = 0u;
    __syncthreads();
    XcdBarrier xb; xb.bar = barw; xb.x = 0; xb.st = MISC + 8;
#define SEAM(k) do { if (IN(k) && IN((k) + 1)) { if ((k) == 0) { cg::this_grid().sync(); xb = xcd_barrier_post(barw, MISC + 8); } else xcd_barrier(xb); } } while (0)
    if (IN(0)) { p0a_prologue(a, lds); } SEAM(0);
    if (IN(1)) { p0b_rows(a); } SEAM(1);
    if (IN(2)) {
        pg8::Gemm g{(const pg8::bf16_t*)(ws + WS_HB), (const pg8::bf16_t*)(ws + WS_WIN), TT, 1024, DM}; pg8::StaticOrder S; S.init(TT, 1024, G, (int)blockIdx.x);
        pg8::EpiZ E{(pg8::bf16_t*)(ws + WS_U), (pg8::bf16_t*)(ws + WS_CQ), (pg8::bf16_t*)(ws + WS_CKV), (pg8::bf16_t*)(ws + WS_KR), SS, SS + TT, (const float*)(ws + WS_ROPE)};
        pg8::gemm_phase<pg8::EpiZ, pg8::StaticOrder, true, true>(lds, g, S, E);
    } SEAM(2);
    if (IN(3)) {
        { pg8::Gemm g{(const pg8::bf16_t*)(ws + WS_CQ), (const pg8::bf16_t*)(ws + WS_WUQ), TT, 1280, QLR}; pg8::StaticOrder S; S.init(TT, 1280, G, (int)blockIdx.x);
          pg8::EpiQ E{(pg8::bf16_t*)(ws + WS_Q), SS, (const float*)(ws + WS_ROPE)};
          pg8::gemm_phase<pg8::EpiQ, pg8::StaticOrder, true, true>(lds, g, S, E); }
        { pg8::Gemm g{(const pg8::bf16_t*)(ws + WS_CKV), (const pg8::bf16_t*)(ws + WS_WUKV), TT, 1536, KVLR}; pg8::StaticOrder S; S.init(TT, 1536, G, (int)blockIdx.x);
          pg8::EpiKV E{(pg8::bf16_t*)(ws + WS_KN), (pg8::bf16_t*)(ws + WS_V), SS + TT};
          pg8::gemm_phase<pg8::EpiKV, pg8::StaticOrder, true, true>(lds, g, S, E); }
    } SEAM(3);
    if (IN(4)) { attn_phase(a, lds_raw); } SEAM(4);
    if (IN(5)) { pool_phase(a, lds); } SEAM(5);
    if (IN(6)) {
        pg8::Gemm g{(const pg8::bf16_t*)(ws + WS_MX), (const pg8::bf16_t*)(ws + WS_WOUT), TT, DM, DM}; pg8::StaticOrder S; S.init(TT, DM, G, (int)blockIdx.x);
        pg8::EpiRowScaleSS E{(pg8::bf16_t*)(ws + WS_MG), SS + 2 * (size_t)TT, 1.0f / (NH * DV), SS + 3 * (size_t)TT};
        pg8::gemm_phase<pg8::EpiRowScaleSS, pg8::StaticOrder, true, true>(lds, g, S, E);
    } SEAM(6);
    if (IN(7)) { p6_rows(a); } SEAM(7);
    if (IN(8)) {
        pg8::Gemm g{(const pg8::bf16_t*)(ws + WS_HB), (const pg8::bf16_t*)(ws + WS_WGU), TT, 2 * DFF, DM}; pg8::StaticOrder S; S.init(TT, 2 * DFF, G, (int)blockIdx.x);
        pg8::EpiGU E{(pg8::bf16_t*)(ws + WS_ACT)};
        pg8::gemm_phase<pg8::EpiGU, pg8::StaticOrder, true, true>(lds, g, S, E);
    } SEAM(8);
    if (IN(9)) {
        pg8::Gemm g{(const pg8::bf16_t*)(ws + WS_ACT), (const pg8::bf16_t*)(ws + WS_WD), TT, DM, DFF}; pg8::StaticOrder S; S.init(TT, DM, G, (int)blockIdx.x);
        pg8::EpiRowScaleSS E{(pg8::bf16_t*)(ws + WS_F), nullptr, 0.f, SS + 4 * (size_t)TT};
        pg8::gemm_phase<pg8::EpiRowScaleSS, pg8::StaticOrder, true, true>(lds, g, S, E);
    } SEAM(9);
    if (IN(10)) { p9_rows(a); }
#undef IN
#undef SEAM
}

extern "C" void kernel_launch(void* const* d_in, const int* in_sizes, int n_in, void* d_out, int out_size, void* d_ws, size_t ws_size, hipStream_t stream) {
    static int grid = 0;
    if (grid == 0) {
        if (n_in != 23 || out_size != TT * DM || ws_size < WS_END) { fprintf(stderr, "kernel_launch: unexpected shapes: n_in %d out %d ws %zu (need %zu)\n", n_in, out_size, ws_size, (size_t)WS_END); grid = -1; return; }
        int dev = 0, cus = 0, per_cu = 0;
        if (hipGetDevice(&dev) != hipSuccess || hipDeviceGetAttribute(&cus, hipDeviceAttributeMultiprocessorCount, dev) != hipSuccess) { grid = -1; return; }
        if (hipFuncSetAttribute((const void*)enc_fwd, hipFuncAttributeMaxDynamicSharedMemorySize, LDS_BYTES) != hipSuccess) { fprintf(stderr, "kernel_launch: hipFuncSetAttribute failed\n"); grid = -1; return; }
        if (hipOccupancyMaxActiveBlocksPerMultiprocessor(&per_cu, (const void*)enc_fwd, NTHREADS, LDS_BYTES) != hipSuccess || per_cu < 1) per_cu = 1;
        (void)hipGetLastError();
        grid = cus;
    }
    if (grid < 0) return;
    Params p{};
    for (int i = 0; i < 23; ++i) p.in[i] = (const float*)d_in[i];
    p.out = (float*)d_out; p.ws = (unsigned char*)d_ws;
#if MK_PER_PHASE
    for (int ph = 0; ph <= N_PHASES; ++ph) { p.ph_lo = ph; p.ph_hi = ph + 1; hipLaunchKernelGGL(enc_fwd, dim3(grid), dim3(NTHREADS), LDS_BYTES, stream, p); }
#else
    p.ph_lo = 0; p.ph_hi = N_PHASES + 1;
    void* args[] = {&p};
    hipError_t e = hipLaunchCooperativeKernel((const void*)enc_fwd, dim3(grid), dim3(NTHREADS), args, LDS_BYTES, stream);
    if (e != hipSuccess) fprintf(stderr, "kernel_launch: cooperative launch failed: %s (grid %d)\n", hipGetErrorString(e), grid);
#endif
}
```

```cpp
#include <hip/hip_runtime.h>
#include <hip/hip_cooperative_groups.h>
#include <cstdio>
#include <cstdint>
namespace cg = cooperative_groups;

#ifndef MK_PER_PHASE
#define MK_PER_PHASE 0
#endif

constexpr int DM = 1024, T_P = 65536, T_S = 16384, TT = T_P + T_S, SEQ_P = 8192, SEQ_S = 16384, NBATCH = 9;
constexpr int NH = 6, DQK = 192, DNOPE = 128, DROPE = 64, DV = 128, QLR = 384, KVLR = 256, DFF = 2816, POOLW = 256;
constexpr int LDQ_ = NH * DQK  , LDKV_ = NH * DNOPE  ;
constexpr float EPS = 1e-6f;
constexpr float QSCALE = 0.07216878364870322f * 1.4426950408889634f;

namespace pg8 {
#define PG8_LAS __attribute__((address_space(3)))
typedef unsigned short bf16_t;
typedef short bf16x8 __attribute__((ext_vector_type(8)));
typedef float f32x4 __attribute__((ext_vector_type(4)));
typedef unsigned u32x4 __attribute__((ext_vector_type(4)));
constexpr int BM = 256, BK = 64, HALF = 128, HTB = HALF * BK * 2  , STAGE_BYTES = 8 * HTB, NXCD = 8, WGM = 8;

__host__ __device__ __forceinline__ int lds_byte(int r, int c) { const int st = (r >> 4) * 2 + (c >> 5), rr = r & 15, cc = c & 31, ob = rr * 64 + cc * 2; return st * 1024 + (ob ^ (((ob >> 9) & 1) << 5)); }
__host__ __device__ __forceinline__ void stage_rc(int b, int& R, int& C) { const int st = b / 1024, sb = b % 1024, swz = sb ^ (((sb >> 9) & 1) << 5); R = (st >> 1) * 16 + swz / 64; C = (st & 1) * 32 + (swz % 64) / 2; }
__host__ __device__ __forceinline__ int perm32(int rho) { const int n = rho >> 4, i = rho & 15; return 8 * (i >> 2) + 4 * n + (i & 3); }

struct Unit { int pm, pn; };
struct Gemm { const bf16_t* A; const bf16_t* Bt; int M, N, K; };

struct StaticOrder {
    int nM, nN, nwg, G, c;
    __host__ __device__ void init(int M, int N, int G_, int c_) { nM = M / BM; nN = N / BM; nwg = nM * nN; G = G_; c = c_; }
    __host__ __device__ bool next(int i, Unit& u) const {
        const long L = (long)i * G + c; if (L >= nwg) return false;
        int wgid = (int)L; { const int q = nwg / NXCD, r = nwg % NXCD, xcd = wgid % NXCD, off = wgid / NXCD; wgid = (xcd < r ? xcd * (q + 1) : r * (q + 1) + (xcd - r) * q) + off; }
        const int nig = WGM * nN, gid = wgid / nig, fm = gid * WGM, gsz = (nM - fm) < WGM ? (nM - fm) : WGM;
        u.pm = fm + ((wgid % nig) % gsz); u.pn = (wgid % nig) / gsz; return true;
    }
    __device__ __forceinline__ void a_ready(const Unit&) const {}
    __device__ __forceinline__ void done(const Unit&) const {}
};


__device__ __forceinline__ unsigned cvt_pk_bf16(float lo, float hi) { unsigned r; asm volatile("v_cvt_pk_bf16_f32 %0, %1, %2" : "=v"(r) : "v"(lo), "v"(hi)); return r; }
typedef unsigned u32x2 __attribute__((ext_vector_type(2)));
__device__ __forceinline__ void st4(bf16_t* p, f32x4 v) { u32x2 w; w.x = cvt_pk_bf16(v[0], v[1]); w.y = cvt_pk_bf16(v[2], v[3]); *(u32x2*)p = w; }
__device__ __forceinline__ void st8(bf16_t* p, f32x4 a, f32x4 b) { u32x4 w; w.x = cvt_pk_bf16(a[0], a[1]); w.y = cvt_pk_bf16(a[2], a[3]); w.z = cvt_pk_bf16(b[0], b[1]); w.w = cvt_pk_bf16(b[2], b[3]); *(u32x4*)p = w; }
__device__ __forceinline__ float sq4(f32x4 v) { return (v[0] * v[0] + v[1] * v[1]) + (v[2] * v[2] + v[3] * v[3]); }
__device__ __forceinline__ void row_ss_add(float* ss, int row, float s, int fq) { s += __shfl_xor(s, 16); s += __shfl_xor(s, 32); if (fq == 0) atomicAdd(ss + row, s); }
__device__ __forceinline__ int seq_pos(int row) { return row < T_P ? (row & (SEQ_P - 1)) : (row - T_P); }
#define PG8_ROWS_BEGIN _Pragma("unroll") for (int ai = 0; ai < 2; ++ai) _Pragma("unroll") for (int m = 0; m < 4; ++m) { const int row = u.pm * BM + ai * HALF + wr * 64 + m * 16 + fr + zo_;
#define PG8_ROWS_END asm volatile("" ::: "memory"); }

struct EpiZ {
    static constexpr bool PERM = true, AFTER_DRAIN = false;
    bf16_t *U, *CQ, *CKV, *KR; float *ssq, *sskv; const float* rope;
    __device__ __forceinline__ void operator()(const f32x4 (&acc)[2][2][4][2], const Unit& u, int wr, int wc, int fr_in, int fq_in) const {
        int zo_ = 0, fr = fr_in, fq = fq_in; asm volatile("" : "+v"(zo_), "+v"(fr), "+v"(fq));
#pragma unroll
        for (int bj = 0; bj < 2; ++bj) {
            const int cc = u.pn * 8 + bj * 4 + wc;
            if (cc < 8) {
                PG8_ROWS_BEGIN
                    st8(U + (size_t)row * POOLW + cc * 32 + 8 * fq, acc[ai][bj][m][0], acc[ai][bj][m][1]);
                PG8_ROWS_END
            } else if (cc < 20) {
                PG8_ROWS_BEGIN
                    st8(CQ + (size_t)row * QLR + (cc - 8) * 32 + 8 * fq, acc[ai][bj][m][0], acc[ai][bj][m][1]);
                    row_ss_add(ssq, row, sq4(acc[ai][bj][m][0]) + sq4(acc[ai][bj][m][1]), fq);
                PG8_ROWS_END
            } else if (cc < 28) {
                PG8_ROWS_BEGIN
                    st8(CKV + (size_t)row * KVLR + (cc - 20) * 32 + 8 * fq, acc[ai][bj][m][0], acc[ai][bj][m][1]);
                    row_ss_add(sskv, row, sq4(acc[ai][bj][m][0]) + sq4(acc[ai][bj][m][1]), fq);
                PG8_ROWS_END
            } else if (cc < 30) {
                const int i0 = 16 * (cc - 28) + 4 * fq;
                PG8_ROWS_BEGIN
                    const float* rp = rope + ((size_t)seq_pos(row) * 32 + i0) * 2;
                    const f32x4 cs0 = *(const f32x4*)rp, cs1 = *(const f32x4*)(rp + 4);
                    const f32x4 x1 = acc[ai][bj][m][0], x2 = acc[ai][bj][m][1];
                    const f32x4 c = {cs0[0], cs0[2], cs1[0], cs1[2]}, s = {cs0[1], cs0[3], cs1[1], cs1[3]};
                    bf16_t* p = KR + (size_t)row * DROPE + i0; st4(p, x1 * c - x2 * s); st4(p + 32, x2 * c + x1 * s);
                PG8_ROWS_END
            }
        }
    }
};
struct EpiQ {
    static constexpr bool PERM = true, AFTER_DRAIN = false;
    bf16_t* Q; const float* ssq; const float* rope;
    __device__ __forceinline__ void operator()(const f32x4 (&acc)[2][2][4][2], const Unit& u, int wr, int wc, int fr_in, int fq_in) const {
        int zo_ = 0, fr = fr_in, fq = fq_in; asm volatile("" : "+v"(zo_), "+v"(fr), "+v"(fq));
#pragma unroll
        for (int bj = 0; bj < 2; ++bj) {
            const int cc = u.pn * 8 + bj * 4 + wc;
            if (cc >= 36) continue;
            const int h = cc / 6, j6 = cc - 6 * h;
            if (j6 < 4) {
                PG8_ROWS_BEGIN
                    const float rq = QSCALE / sqrtf(ssq[row] * (1.0f / QLR) + EPS);
                    st8(Q + (size_t)row * LDQ_ + h * DQK + j6 * 32 + 8 * fq, acc[ai][bj][m][0] * rq, acc[ai][bj][m][1] * rq);
                PG8_ROWS_END
            } else {
                const int i0 = 16 * (j6 - 4) + 4 * fq;
                PG8_ROWS_BEGIN
                    const float rq = QSCALE / sqrtf(ssq[row] * (1.0f / QLR) + EPS);
                    const float* rp = rope + ((size_t)seq_pos(row) * 32 + i0) * 2;
                    const f32x4 cs0 = *(const f32x4*)rp, cs1 = *(const f32x4*)(rp + 4);
                    const f32x4 x1 = acc[ai][bj][m][0] * rq, x2 = acc[ai][bj][m][1] * rq;
                    const f32x4 c = {cs0[0], cs0[2], cs1[0], cs1[2]}, s = {cs0[1], cs0[3], cs1[1], cs1[3]};
                    bf16_t* p = Q + (size_t)row * LDQ_ + h * DQK + DNOPE + i0; st4(p, x1 * c - x2 * s); st4(p + 32, x2 * c + x1 * s);
                PG8_ROWS_END
            }
        }
    }
};
struct EpiKV {
    static constexpr bool PERM = true, AFTER_DRAIN = false;
    bf16_t *KN, *V; const float* sskv;
    __device__ __forceinline__ void operator()(const f32x4 (&acc)[2][2][4][2], const Unit& u, int wr, int wc, int fr_in, int fq_in) const {
        int zo_ = 0, fr = fr_in, fq = fq_in; asm volatile("" : "+v"(zo_), "+v"(fr), "+v"(fq));
        PG8_ROWS_BEGIN
            const float rk = 1.0f / sqrtf(sskv[row] * (1.0f / KVLR) + EPS);
            const size_t o = (size_t)row * LDKV_ + u.pn * DNOPE + wc * 32 + 8 * fq;
            st8(KN + o, acc[ai][0][m][0] * rk, acc[ai][0][m][1] * rk);
            st8(V + o, acc[ai][1][m][0] * rk, acc[ai][1][m][1] * rk);
        PG8_ROWS_END
    }
};
struct EpiRowScaleSS {
    static constexpr bool PERM = true, AFTER_DRAIN = false;
    bf16_t* O; const float* rs; float rs_div; float* ss;
    __device__ __forceinline__ void operator()(const f32x4 (&acc)[2][2][4][2], const Unit& u, int wr, int wc, int fr_in, int fq_in) const {
        int zo_ = 0, fr = fr_in, fq = fq_in; asm volatile("" : "+v"(zo_), "+v"(fr), "+v"(fq));
        PG8_ROWS_BEGIN
            const float r = rs ? 1.0f / sqrtf(rs[row] * rs_div + EPS) : 1.0f;
            float s = 0.f;
#pragma unroll
            for (int bj = 0; bj < 2; ++bj) {
                const f32x4 v0 = acc[ai][bj][m][0] * r, v1 = acc[ai][bj][m][1] * r;
                st8(O + (size_t)row * DM + u.pn * BM + bj * HALF + wc * 32 + 8 * fq, v0, v1);
                s += sq4(v0) + sq4(v1);
            }
            row_ss_add(ss, row, s, fq);
        PG8_ROWS_END
    }
};
struct EpiGU {
    static constexpr bool PERM = false, AFTER_DRAIN = false;
    bf16_t* ACT;
    __device__ __forceinline__ void operator()(const f32x4 (&acc)[2][2][4][2], const Unit& u, int wr, int wc, int fr_in, int fq_in) const {
        int zo_ = 0, fr = fr_in, fq = fq_in; asm volatile("" : "+v"(zo_), "+v"(fr), "+v"(fq));
        PG8_ROWS_BEGIN
#pragma unroll
            for (int bj = 0; bj < 2; ++bj) {
                const int cc = u.pn * 8 + bj * 4 + wc;
                const f32x4 g = acc[ai][bj][m][0], up = acc[ai][bj][m][1]; f32x4 o;
#pragma unroll
                for (int j = 0; j < 4; ++j) o[j] = g[j] * __builtin_amdgcn_rcpf(1.0f + __builtin_amdgcn_exp2f(-1.4426950408889634f * g[j])) * up[j];
                st4(ACT + (size_t)row * DFF + cc * 16 + 4 * fq, o);
            }
        PG8_ROWS_END
    }
};
#undef PG8_ROWS_BEGIN
#undef PG8_ROWS_END

template <class Epi, class Sched, bool ALIGN_EPI = false, bool SP2 = false>
__device__ __forceinline__ void gemm_phase(PG8_LAS unsigned char* lds, const Gemm g, const Sched& S, const Epi& E) {
    const int tid = threadIdx.x, wid = __builtin_amdgcn_readfirstlane(tid >> 6), lane = tid & 63, wr = wid >> 2, wc = wid & 3, fr = lane & 15, fq = lane >> 4;
    const int K = g.K, nt = K / BK;
    unsigned voffA[2], voffB[2];
#pragma unroll
    for (int i = 0; i < 2; ++i) { int R, C; stage_rc(tid * 16 + i * 8192, R, C); const int Rb = Epi::PERM ? ((R & ~31) + perm32(R & 31)) : R;
        voffA[i] = (unsigned)(R * K + C) * 2u; voffB[i] = (unsigned)(Rb * K + C) * 2u; }
    const size_t kstep = (size_t)(BK * 2);
    const size_t hstep = (size_t)HALF * K * 2;
    const size_t tstep = 2 * hstep;
    const unsigned ldsw = (unsigned)wid * 1024u;
    const int aoff = lds_byte(wr * 64 + fr, fq * 8), boff = lds_byte(wc * 32 + fr, fq * 8);
#define PG8_SA(b, h) (((b) * 2 + (h)) * HTB)
#define PG8_SB(b, h) ((4 + (b) * 2 + (h)) * HTB)
#define PG8_STAGE(bufoff, gbase, voff) do { _Pragma("unroll") for (int _i = 0; _i < 2; ++_i) \
        __builtin_amdgcn_global_load_lds((const unsigned*)((const char*)(gbase) + (voff)[_i]), (PG8_LAS unsigned*)(lds + (bufoff) + ldsw + _i * 8192), 16, 0, 0); } while (0)
#define PG8_LDA(dst, b, h) do { _Pragma("unroll") for (int m = 0; m < 4; ++m) _Pragma("unroll") for (int k = 0; k < 2; ++k) dst[m][k] = *(const PG8_LAS bf16x8*)(lds + PG8_SA(b, h) + aoff + m * 2048 + k * 1024); } while (0)
#define PG8_LDB(dst, b, h) do { _Pragma("unroll") for (int n = 0; n < 2; ++n) _Pragma("unroll") for (int k = 0; k < 2; ++k) dst[n][k] = *(const PG8_LAS bf16x8*)(lds + PG8_SB(b, h) + boff + n * 2048 + k * 1024); } while (0)
#define PG8_MMA(ai, bj, At, Bt) do { __builtin_amdgcn_s_setprio(1); _Pragma("unroll") for (int m = 0; m < 4; ++m) _Pragma("unroll") for (int n = 0; n < 2; ++n) _Pragma("unroll") for (int k = 0; k < 2; ++k) \
        acc[ai][bj][m][n] = __builtin_amdgcn_mfma_f32_16x16x32_bf16(Bt[n][k], At[m][k], acc[ai][bj][m][n], 0, 0, 0); __builtin_amdgcn_s_setprio(0); } while (0)
#define PG8_WAIT_V(n) asm volatile("s_waitcnt vmcnt(" #n ")" ::: "memory")
#define PG8_WAIT_L(n) asm volatile("s_waitcnt lgkmcnt(" #n ")" ::: "memory")
#define PG8_BAR __builtin_amdgcn_s_barrier()
#define PG8_SCHED __builtin_amdgcn_sched_barrier(0)
    Unit cur, nxt; int ui = 0;
    if (!S.next(0, cur)) return;
    f32x4 acc[2][2][4][2];
#pragma unroll
    for (int a = 0; a < 2; ++a)
#pragma unroll
        for (int b = 0; b < 2; ++b)
#pragma unroll
            for (int m = 0; m < 4; ++m)
#pragma unroll
                for (int n = 0; n < 2; ++n) acc[a][b][m][n] = (f32x4){0.f, 0.f, 0.f, 0.f};
    bf16x8 At[4][2], B0[2][2], B1[2][2];
    const char* cA = (const char*)g.A + (size_t)cur.pm * tstep; const char* cB = (const char*)g.Bt + (size_t)cur.pn * tstep;
    S.a_ready(cur);
    if constexpr (SP2) {
        PG8_STAGE(PG8_SB(0, 0), cB, voffB); PG8_STAGE(PG8_SB(0, 1), cB + hstep, voffB); PG8_STAGE(PG8_SA(0, 0), cA, voffA); PG8_STAGE(PG8_SA(0, 1), cA + hstep, voffA);
        if (wr == 1) PG8_BAR;
        PG8_WAIT_V(2); PG8_BAR;
        PG8_STAGE(PG8_SB(1, 0), cB + kstep, voffB); PG8_STAGE(PG8_SA(1, 0), cA + kstep, voffA); PG8_STAGE(PG8_SB(1, 1), cB + hstep + kstep, voffB);
        PG8_WAIT_V(6); PG8_BAR;
    } else {
        PG8_STAGE(PG8_SB(0, 0), cB, voffB); PG8_STAGE(PG8_SA(0, 0), cA, voffA); PG8_STAGE(PG8_SB(0, 1), cB + hstep, voffB); PG8_STAGE(PG8_SA(0, 1), cA + hstep, voffA);
        if (wr == 1) PG8_BAR;
        PG8_WAIT_V(4); PG8_BAR;
        PG8_STAGE(PG8_SB(1, 0), cB + kstep, voffB); PG8_STAGE(PG8_SA(1, 0), cA + kstep, voffA); PG8_STAGE(PG8_SB(1, 1), cB + hstep + kstep, voffB);
        PG8_WAIT_V(6); PG8_BAR;
    }
    for (;;) {
        const bool has_next = S.next(ui + 1, nxt);
        const char* nA = has_next ? (const char*)g.A + (size_t)nxt.pm * tstep : cA; const char* nB = has_next ? (const char*)g.Bt + (size_t)nxt.pn * tstep : cB;
#pragma unroll 1
        for (int t = 0; t < nt; t += 2) {
            const bool last = (t == nt - 2);
            const char* a1 = cA + (size_t)(t + 1) * kstep;
            const char* a2 = last ? nA : cA + (size_t)(t + 2) * kstep; const char* b2 = last ? nB : cB + (size_t)(t + 2) * kstep;
            const char* a3 = a2 + kstep; const char* b3 = b2 + kstep;
            if (last && has_next) S.a_ready(nxt);
            if constexpr (SP2) {
            PG8_LDB(B0, 0, 0); PG8_LDB(B1, 0, 1); PG8_SCHED; PG8_LDA(At, 0, 0); PG8_STAGE(PG8_SA(1, 1), a1 + hstep, voffA);
            PG8_WAIT_V(8); PG8_WAIT_L(0); PG8_BAR; PG8_MMA(0, 0, At, B0); PG8_MMA(0, 1, At, B1); PG8_BAR; PG8_SCHED;
            PG8_LDA(At, 0, 1); PG8_STAGE(PG8_SB(0, 0), b2, voffB); PG8_STAGE(PG8_SB(0, 1), b2 + hstep, voffB); PG8_STAGE(PG8_SA(0, 0), a2, voffA);
            PG8_WAIT_V(8); PG8_WAIT_L(0); PG8_BAR; PG8_MMA(1, 0, At, B0); PG8_MMA(1, 1, At, B1); PG8_BAR; PG8_SCHED;
            PG8_LDB(B0, 1, 0); PG8_LDB(B1, 1, 1); PG8_SCHED; PG8_LDA(At, 1, 0); PG8_STAGE(PG8_SA(0, 1), a2 + hstep, voffA);
            PG8_WAIT_V(8); PG8_WAIT_L(0); PG8_BAR; PG8_MMA(0, 0, At, B0); PG8_MMA(0, 1, At, B1); PG8_BAR; PG8_SCHED;
            PG8_LDA(At, 1, 1); PG8_STAGE(PG8_SB(1, 0), b3, voffB); PG8_STAGE(PG8_SB(1, 1), b3 + hstep, voffB); PG8_STAGE(PG8_SA(1, 0), a3, voffA);
            PG8_WAIT_V(8); PG8_WAIT_L(0); PG8_BAR; PG8_MMA(1, 0, At, B0); PG8_MMA(1, 1, At, B1); PG8_BAR; PG8_SCHED;
            } else {
            PG8_LDB(B0, 0, 0); PG8_SCHED; PG8_LDA(At, 0, 0); PG8_STAGE(PG8_SA(1, 1), a1 + hstep, voffA);
            PG8_WAIT_L(8); PG8_BAR; PG8_WAIT_L(0); PG8_MMA(0, 0, At, B0); PG8_BAR; PG8_SCHED;
            PG8_LDB(B1, 0, 1); PG8_STAGE(PG8_SB(0, 0), b2, voffB);
            PG8_BAR; PG8_WAIT_L(0); PG8_MMA(0, 1, At, B1); PG8_BAR;
            PG8_LDA(At, 0, 1); PG8_STAGE(PG8_SA(0, 0), a2, voffA);
            PG8_BAR; PG8_WAIT_L(0); PG8_MMA(1, 0, At, B0); PG8_BAR; PG8_SCHED;
            PG8_STAGE(PG8_SB(0, 1), b2 + hstep, voffB);
            PG8_WAIT_V(6); PG8_BAR; PG8_MMA(1, 1, At, B1); PG8_BAR;
            PG8_LDB(B0, 1, 0); PG8_SCHED; PG8_LDA(At, 1, 0); PG8_STAGE(PG8_SA(0, 1), a2 + hstep, voffA);
            PG8_WAIT_L(8); PG8_BAR; PG8_WAIT_L(0); PG8_MMA(0, 0, At, B0); PG8_BAR; PG8_SCHED;
            PG8_LDB(B1, 1, 1); PG8_STAGE(PG8_SB(1, 0), b3, voffB);
            PG8_BAR; PG8_WAIT_L(0); PG8_MMA(0, 1, At, B1); PG8_BAR;
            PG8_LDA(At, 1, 1); PG8_STAGE(PG8_SA(1, 0), a3, voffA);
            PG8_BAR; PG8_WAIT_L(0); PG8_MMA(1, 0, At, B0); PG8_BAR; PG8_SCHED;
            PG8_STAGE(PG8_SB(1, 1), b3 + hstep, voffB);
            PG8_WAIT_V(6); PG8_BAR; PG8_MMA(1, 1, At, B1); PG8_BAR;
            }
        }
        if constexpr (ALIGN_EPI) { if (wr == 0) PG8_BAR; }
        if constexpr (!Epi::AFTER_DRAIN) { E(acc, cur, wr, wc, fr, fq); S.done(cur); }
        if (!has_next) break;
#pragma unroll
        for (int a = 0; a < 2; ++a)
#pragma unroll
            for (int b = 0; b < 2; ++b)
#pragma unroll
                for (int m = 0; m < 4; ++m)
#pragma unroll
                    for (int n = 0; n < 2; ++n) acc[a][b][m][n] = (f32x4){0.f, 0.f, 0.f, 0.f};
        cur = nxt; cA = nA; cB = nB; ++ui;
        if constexpr (ALIGN_EPI) { if (wr == 1) PG8_BAR; }
    }
    PG8_WAIT_V(0);
    if constexpr (!ALIGN_EPI) { if (wr == 0) PG8_BAR; }
    PG8_BAR;
    if constexpr (Epi::AFTER_DRAIN) { E.fused(acc, cur, wr, wc, fr, fq, lds, wid, lane); S.done(cur); }
#undef PG8_SA
#undef PG8_SB
#undef PG8_STAGE
#undef PG8_LDA
#undef PG8_LDB
#undef PG8_MMA
#undef PG8_WAIT_V
#undef PG8_WAIT_L
#undef PG8_BAR
#undef PG8_SCHED
}
}

namespace att {
using bf16x8 = __attribute__((ext_vector_type(8))) short;
using s16x4  = __attribute__((ext_vector_type(4))) short;
using f32x16 = __attribute__((ext_vector_type(16))) float;
using u32x4  = __attribute__((ext_vector_type(4))) unsigned;
typedef unsigned short bf16_t;
constexpr int NW = 8, QBLK = 32, KVBLK = 64;
constexpr int LDQ = LDQ_, LDKN = LDKV_, LDKR = DROPE, LDV = LDKV_, LDO = DM;
constexpr int SHM_V = 16384, SHM_KN = 16384, SHM_KR = 8192;
constexpr int OFF_V = 0, OFF_KN = 2 * SHM_V, OFF_KR = OFF_KN + 2 * SHM_KN, OFF_WS = OFF_KR + 2 * SHM_KR, ATTN_LDS = OFF_WS + NW * 64 * 4;
constexpr float THRL = 11.5f;
#define KSWZ(row, colB) ((row) * 256 + ((colB) ^ (((row) & 15) << 4)))
#define KRSWZ(row, colB) ((row) * 128 + ((colB) ^ ((((row) >> 1) & 7) << 4)))
#define SBAR() __builtin_amdgcn_sched_barrier(0)
__device__ __forceinline__ int crow(int r, int hi) { return (r & 3) + 8 * (r >> 2) + 4 * hi; }
__device__ __forceinline__ unsigned cvtpk(float lo, float hi) { unsigned r; asm volatile("v_cvt_pk_bf16_f32 %0, %1, %2" : "=v"(r) : "v"(lo), "v"(hi)); return r; }

__device__ __forceinline__ void partialSM(f32x16& p0, f32x16& p1, float& m_reg, float& mn, float& alpha) {
  float pmax = p0[0];
#pragma unroll
  for (int r = 1; r < 16; ++r) pmax = fmaxf(pmax, p0[r]);
#pragma unroll
  for (int r = 0; r < 16; ++r) pmax = fmaxf(pmax, p1[r]);
  { auto rr = __builtin_amdgcn_permlane32_swap(__float_as_uint(pmax), __float_as_uint(pmax), false, false);
    pmax = fmaxf(__uint_as_float(rr[0]), __uint_as_float(rr[1])); }
  if (__builtin_expect(__all(pmax - m_reg <= THRL), 1)) { mn = m_reg; alpha = 1.f; }
  else { mn = fmaxf(m_reg, pmax); alpha = __builtin_amdgcn_exp2f(m_reg - mn); m_reg = mn; }
#pragma unroll
  for (int r = 0; r < 16; ++r) p0[r] = p0[r] - mn;
#pragma unroll
  for (int r = 0; r < 16; ++r) p1[r] = p1[r] - mn;
#pragma unroll
  for (int r = 0; r < 16; ++r) p0[r] = __builtin_amdgcn_exp2f(p0[r]);
}
__device__ __forceinline__ void finishSM(f32x16& p0, f32x16& p1, float alpha, float& l_reg, bf16x8& pa0, bf16x8& pa1, bf16x8& pa2, bf16x8& pa3) {
#pragma unroll
  for (int r = 0; r < 16; ++r) p1[r] = __builtin_amdgcn_exp2f(p1[r]);
  float ps = 0;
#pragma unroll
  for (int r = 0; r < 16; ++r) ps += p0[r];
#pragma unroll
  for (int r = 0; r < 16; ++r) ps += p1[r];
  { auto rr = __builtin_amdgcn_permlane32_swap(__float_as_uint(ps), __float_as_uint(ps), false, false);
    ps = __uint_as_float(rr[0]) + __uint_as_float(rr[1]); }
  l_reg = l_reg * alpha + ps;
#define PK4(P, BASE, OUT) do { unsigned a0 = cvtpk(P[BASE + 0], P[BASE + 1]), a1 = cvtpk(P[BASE + 2], P[BASE + 3]);   \
    unsigned b0 = cvtpk(P[BASE + 4], P[BASE + 5]), b1 = cvtpk(P[BASE + 6], P[BASE + 7]);                              \
    auto r0 = __builtin_amdgcn_permlane32_swap(a0, b0, false, false); auto r1 = __builtin_amdgcn_permlane32_swap(a1, b1, false, false); \
    u32x4 w = {r0[0], r1[0], r0[1], r1[1]}; OUT = *reinterpret_cast<bf16x8*>(&w); } while (0)
  PK4(p0, 0, pa0); PK4(p0, 8, pa1); PK4(p1, 0, pa2); PK4(p1, 8, pa3);
#undef PK4
}
__device__ __forceinline__ void qkt(f32x16& p0, f32x16& p1, const char* Kn, const char* Kr, const bf16x8* qr, int r32, int hi) {
  p0 = f32x16{}; p1 = f32x16{};
#define KFRAG(dst, d0) do { const int cb_ = (((d0) & 7) * 16 + hi * 8) * 2; \
    if ((d0) < 8) { dst[0] = *reinterpret_cast<const bf16x8*>(Kn + KSWZ(r32, cb_)); dst[1] = *reinterpret_cast<const bf16x8*>(Kn + KSWZ(32 + r32, cb_)); } \
    else { dst[0] = *reinterpret_cast<const bf16x8*>(Kr + KRSWZ(r32, cb_)); dst[1] = *reinterpret_cast<const bf16x8*>(Kr + KRSWZ(32 + r32, cb_)); } } while (0)
#define KMMA(src, d0) do { p0 = __builtin_amdgcn_mfma_f32_32x32x16_bf16(src[0], qr[d0], p0, 0, 0, 0); p1 = __builtin_amdgcn_mfma_f32_32x32x16_bf16(src[1], qr[d0], p1, 0, 0, 0); } while (0)
  bf16x8 fa[2], fb[2], fc[2];
  KFRAG(fa, 0); KFRAG(fb, 1); SBAR();
  KFRAG(fc, 2); SBAR(); KMMA(fa, 0); SBAR();
  KFRAG(fa, 3); SBAR(); KMMA(fb, 1); SBAR();
  KFRAG(fb, 4); SBAR(); KMMA(fc, 2); SBAR();
  KFRAG(fc, 5); SBAR(); KMMA(fa, 3); SBAR();
  KFRAG(fa, 6); SBAR(); KMMA(fb, 4); SBAR();
  KFRAG(fb, 7); SBAR(); KMMA(fc, 5); SBAR();
  KFRAG(fc, 8); SBAR(); KMMA(fa, 6); SBAR();
  KFRAG(fa, 9); SBAR(); KMMA(fb, 7); SBAR();
  KFRAG(fb, 10); SBAR(); KMMA(fc, 8); SBAR();
  KFRAG(fc, 11); SBAR(); KMMA(fa, 9); SBAR();
  KMMA(fb, 10); KMMA(fc, 11);
#undef KFRAG
#undef KMMA
}
__device__ __forceinline__ int v_st(int k, int c) { const int kk = (k & ~0xC) | ((k & 4) << 1) | ((k & 8) >> 1); return ((kk >> 3) * 4 + (c >> 5)) * 512 + ((kk & 7) * 32 + (c & 31)) * 2; }
__device__ __forceinline__ int v_rd_base(int lane) { return ((lane & 3) << 3) | (((lane >> 2) & 3) << 6) | (((lane >> 4) & 1) << 5) | (((lane >> 5) & 1) << 8); }
constexpr int v_rd_off(int d0, int ks, int half) { return d0 * 512 + ks * 4096 + half * 2048; }
template <int OFF> __device__ __forceinline__ s16x4 tr_read(int vb) {
  s16x4 r; asm volatile("ds_read_b64_tr_b16 %0, %1 offset:%2" : "=&v"(r) : "v"(vb), "i"(OFF) : "memory"); return r;
}
template <int D0> __device__ __forceinline__ void pv_one(f32x16& od, int vb, bf16x8 pa0, bf16x8 pa1, bf16x8 pa2, bf16x8 pa3) {
  const s16x4 l0 = tr_read<v_rd_off(D0, 0, 0)>(vb), h0 = tr_read<v_rd_off(D0, 0, 1)>(vb), l1 = tr_read<v_rd_off(D0, 1, 0)>(vb), h1 = tr_read<v_rd_off(D0, 1, 1)>(vb);
  const s16x4 l2 = tr_read<v_rd_off(D0, 2, 0)>(vb), h2 = tr_read<v_rd_off(D0, 2, 1)>(vb), l3 = tr_read<v_rd_off(D0, 3, 0)>(vb), h3 = tr_read<v_rd_off(D0, 3, 1)>(vb);
  asm volatile("s_waitcnt lgkmcnt(0)" ::: "memory"); SBAR();
#define PK(L, H) (bf16x8){L[0], L[1], L[2], L[3], H[0], H[1], H[2], H[3]}
  od = __builtin_amdgcn_mfma_f32_32x32x16_bf16(pa0, PK(l0, h0), od, 0, 0, 0);
  od = __builtin_amdgcn_mfma_f32_32x32x16_bf16(pa1, PK(l1, h1), od, 0, 0, 0);
  od = __builtin_amdgcn_mfma_f32_32x32x16_bf16(pa2, PK(l2, h2), od, 0, 0, 0);
  od = __builtin_amdgcn_mfma_f32_32x32x16_bf16(pa3, PK(l3, h3), od, 0, 0, 0);
#undef PK
}
__device__ __forceinline__ void pv_d0(f32x16* o, int vb, bf16x8 pa0, bf16x8 pa1, bf16x8 pa2, bf16x8 pa3) {
  pv_one<0>(o[0], vb, pa0, pa1, pa2, pa3); pv_one<1>(o[1], vb, pa0, pa1, pa2, pa3); pv_one<2>(o[2], vb, pa0, pa1, pa2, pa3); pv_one<3>(o[3], vb, pa0, pa1, pa2, pa3);
}

__device__ __forceinline__ void sm_half(f32x16& p, float& m_reg, float& l_reg, float& alpha, bf16x8& paL, bf16x8& paH) {
  float a = fmaxf(fmaxf(p[0], p[1]), p[2]), b = fmaxf(fmaxf(p[3], p[4]), p[5]);
  a = fmaxf(fmaxf(a, p[6]), p[7]); b = fmaxf(fmaxf(b, p[8]), p[9]); a = fmaxf(fmaxf(a, p[10]), p[11]); b = fmaxf(fmaxf(b, p[12]), p[13]); a = fmaxf(fmaxf(a, p[14]), p[15]);
  float pmax = fmaxf(a, b);
  { auto rr = __builtin_amdgcn_permlane32_swap(__float_as_uint(pmax), __float_as_uint(pmax), false, false);
    pmax = fmaxf(__uint_as_float(rr[0]), __uint_as_float(rr[1])); }
  const bool keep = __all(pmax - m_reg <= THRL);
  const float mn = keep ? m_reg : fmaxf(m_reg, pmax);
  alpha = __builtin_amdgcn_exp2f(m_reg - mn); m_reg = mn;
#pragma unroll
  for (int r = 0; r < 16; ++r) p[r] = __builtin_amdgcn_exp2f(p[r] - mn);
  float ps = 0;
#pragma unroll
  for (int r = 0; r < 16; ++r) ps += p[r];
  { auto rr = __builtin_amdgcn_permlane32_swap(__float_as_uint(ps), __float_as_uint(ps), false, false);
    ps = __uint_as_float(rr[0]) + __uint_as_float(rr[1]); }
  l_reg = l_reg * alpha + ps;
#define PK4(P, BASE, OUT) do { unsigned a0 = cvtpk(P[BASE + 0], P[BASE + 1]), a1 = cvtpk(P[BASE + 2], P[BASE + 3]);   \
    unsigned b0 = cvtpk(P[BASE + 4], P[BASE + 5]), b1 = cvtpk(P[BASE + 6], P[BASE + 7]);                              \
    auto r0 = __builtin_amdgcn_permlane32_swap(a0, b0, false, false); auto r1 = __builtin_amdgcn_permlane32_swap(a1, b1, false, false); \
    u32x4 w = {r0[0], r1[0], r0[1], r1[1]}; OUT = *reinterpret_cast<bf16x8*>(&w); } while (0)
  PK4(p, 0, paL); PK4(p, 8, paH);
#undef PK4
}
template <int H> __device__ __forceinline__ void qkt_half(f32x16& p, const char* Kn, const char* Kr, const bf16x8* qr, int r32, int hi) {
  p = f32x16{};
#pragma unroll
  for (int d0 = 0; d0 < 8; ++d0) { const int cb = (d0 * 16 + hi * 8) * 2;
    const bf16x8 f = *reinterpret_cast<const bf16x8*>(Kn + KSWZ(32 * H + r32, cb)); p = __builtin_amdgcn_mfma_f32_32x32x16_bf16(f, qr[d0], p, 0, 0, 0); }
#pragma unroll
  for (int d0 = 0; d0 < 4; ++d0) { const int cb = (d0 * 16 + hi * 8) * 2;
    const bf16x8 f = *reinterpret_cast<const bf16x8*>(Kr + KRSWZ(32 * H + r32, cb)); p = __builtin_amdgcn_mfma_f32_32x32x16_bf16(f, qr[8 + d0], p, 0, 0, 0); }
}
struct VFrag { s16x4 l0, h0, l1, h1; };
template <int H, int D0> __device__ __forceinline__ VFrag pv_rd(int vb) {
  VFrag f; f.l0 = tr_read<v_rd_off(D0, 2 * H, 0)>(vb); f.h0 = tr_read<v_rd_off(D0, 2 * H, 1)>(vb); f.l1 = tr_read<v_rd_off(D0, 2 * H + 1, 0)>(vb); f.h1 = tr_read<v_rd_off(D0, 2 * H + 1, 1)>(vb); return f;
}
__device__ __forceinline__ void pv_mma(f32x16& od, VFrag& f, bf16x8 paL, bf16x8 paH) {
#define PK(L, Hh) (bf16x8){L[0], L[1], L[2], L[3], Hh[0], Hh[1], Hh[2], Hh[3]}
  od = __builtin_amdgcn_mfma_f32_32x32x16_bf16(paL, PK(f.l0, f.h0), od, 0, 0, 0);
  od = __builtin_amdgcn_mfma_f32_32x32x16_bf16(paH, PK(f.l1, f.h1), od, 0, 0, 0);
#undef PK
}
#define VWAIT(N, f) asm volatile("s_waitcnt lgkmcnt(" #N ")" : "+v"(f.l0), "+v"(f.h0), "+v"(f.l1), "+v"(f.h1) :: "memory")
template <int H> __device__ __forceinline__ void pv_half(f32x16* o, int vb, bf16x8 paL, bf16x8 paH) {
  VFrag fa = pv_rd<H, 0>(vb), fb = pv_rd<H, 1>(vb);
  VWAIT(4, fa); pv_mma(o[0], fa, paL, paH);
  fa = pv_rd<H, 2>(vb);
  VWAIT(4, fb); pv_mma(o[1], fb, paL, paH);
  fb = pv_rd<H, 3>(vb);
  VWAIT(4, fa); pv_mma(o[2], fa, paL, paH);
  VWAIT(0, fb); pv_mma(o[3], fb, paL, paH);
}
#undef VWAIT

__device__ __forceinline__ void attn_unit(const bf16_t* __restrict__ Qb, const bf16_t* __restrict__ KNh, const bf16_t* __restrict__ KRs, const bf16_t* __restrict__ Vh,
                                          bf16_t* __restrict__ Ob, float* __restrict__ ssa, int seq, char* lds) {
  const int tid = threadIdx.x, wid = __builtin_amdgcn_readfirstlane(tid >> 6), lane = tid & 63, r32 = lane & 31, hi = lane >> 5;
  char* V_lds = lds + OFF_V; char* KN_lds = lds + OFF_KN; char* KR_lds = lds + OFF_KR;
  float* ws = (float*)(lds + OFF_WS) + wid * 64; float* li_l = ws; float* al_l = ws + 32;
  float m_reg = -1e30f, l_reg = 0; f32x16 o[4] = {}; bf16x8 qr[12];
  const bf16_t* Qw = Qb + (long)(wid * QBLK + r32) * LDQ + hi * 8;
#pragma unroll
  for (int d0 = 0; d0 < 12; ++d0) qr[d0] = *reinterpret_cast<const bf16x8*>(Qw + d0 * 16);
  const int vb0 = (int)(uintptr_t)V_lds + v_rd_base(lane);
  unsigned kn_off[2], v_off[2], kr_off;
#pragma unroll
  for (int i = 0; i < 2; ++i) {
    const int q = (wid * 2 + i) * 64 + lane;
    { const int row = q >> 4, c = (q & 15) ^ (row & 15); kn_off[i] = (unsigned)(row * LDKN * 2 + c * 16); }
    { const int sub = q >> 5, kk = (sub >> 2) * 8 + ((q & 31) >> 2), cc = (sub & 3) * 32 + (q & 3) * 8, k = (kk & ~0xC) | ((kk & 4) << 1) | ((kk & 8) >> 1);
      v_off[i] = (unsigned)(k * LDV * 2 + cc * 2); }
  }
  { const int q = wid * 64 + lane, row = q >> 3, c = (q & 7) ^ ((row >> 1) & 7); kr_off = (unsigned)(row * LDKR * 2 + c * 16); }
  typedef __attribute__((address_space(3))) unsigned lds_u32;
#define GLDS(gp, lp) __builtin_amdgcn_global_load_lds((const unsigned*)(gp), (lds_u32*)(lp), 16, 0, 0)
#define DMA_KN(k0, s) do { const char* kb_ = (const char*)KNh + (size_t)(k0) * (LDKN * 2); \
    GLDS(kb_ + kn_off[0], KN_lds + (s) * SHM_KN + (wid * 2) * 1024); GLDS(kb_ + kn_off[1], KN_lds + (s) * SHM_KN + (wid * 2 + 1) * 1024); } while (0)
#define DMA_KR(k0, s) do { const char* rb_ = (const char*)KRs + (size_t)(k0) * (LDKR * 2); GLDS(rb_ + kr_off, KR_lds + (s) * SHM_KR + wid * 1024); } while (0)
#define DMA_K(k0, s) do { DMA_KN(k0, s); DMA_KR(k0, s); } while (0)
#define DMA_V(k0, off) do { const char* vb_ = (const char*)Vh + (size_t)(k0) * (LDV * 2); \
    GLDS(vb_ + v_off[0], V_lds + (off) + (wid * 2) * 1024); GLDS(vb_ + v_off[1], V_lds + (off) + (wid * 2 + 1) * 1024); } while (0)
#define RESC(a) do { if (__any((a) < 1.f)) { if (hi == 0) al_l[r32] = (a); asm volatile("s_waitcnt lgkmcnt(0)" ::: "memory"); \
    _Pragma("unroll") for (int d = 0; d < 4; ++d) _Pragma("unroll") for (int r = 0; r < 16; ++r) o[d][r] *= al_l[crow(r, hi)]; } } while (0)
  f32x16 p0, p1; float al0, al1; bf16x8 pa0, pa1, pa2, pa3; const int NT = seq / KVBLK;
#define STEP(b, j) do { \
    if ((j) + 1 < NT) { DMA_KN(((j) + 1) * KVBLK, (b) ^ 1); } SBAR(); \
    qkt_half<0>(p0, KN_lds + (b) * SHM_KN, KR_lds + (b) * SHM_KR, qr, r32, hi); SBAR(); \
    qkt_half<1>(p1, KN_lds + (b) * SHM_KN, KR_lds + (b) * SHM_KR, qr, r32, hi); sm_half(p0, m_reg, l_reg, al0, pa0, pa1); SBAR(); \
    RESC(al0); SBAR(); \
    if ((j) + 1 < NT) { DMA_KR(((j) + 1) * KVBLK, (b) ^ 1); DMA_V(((j) + 1) * KVBLK, ((b) ^ 1) * SHM_V); } SBAR();     \
    pv_half<0>(o, vb0 + (b) * SHM_V, pa0, pa1); sm_half(p1, m_reg, l_reg, al1, pa2, pa3); SBAR(); \
    RESC(al1); SBAR(); \
    pv_half<1>(o, vb0 + (b) * SHM_V, pa2, pa3); \
    asm volatile("s_waitcnt vmcnt(0)" ::: "memory"); __syncthreads(); } while (0)
  DMA_K(0, 0); DMA_V(0, 0);
  asm volatile("s_waitcnt vmcnt(0)" ::: "memory"); __syncthreads();
#pragma unroll 1
  for (int j = 0; j < NT; j += 2) { STEP(0, j); STEP(1, j + 1); }
#undef STEP
  if (hi == 0) li_l[r32] = l_reg; asm volatile("s_waitcnt lgkmcnt(0)" ::: "memory");
  int zo = 0; asm volatile("" : "+v"(zo));
  bf16_t* Ow = Ob + (long)(wid * QBLK) * LDO; float* ssw = ssa + wid * QBLK;
#pragma unroll
  for (int r = 0; r < 16; ++r) { const int orow = crow(r, hi) + zo; const float rl = __builtin_amdgcn_rcpf(li_l[orow]); float s = 0.f;
#pragma unroll
    for (int d0 = 0; d0 < 4; ++d0) { const float v = o[d0][r] * rl; s += v * v; Ow[(long)orow * LDO + d0 * 32 + r32] = (bf16_t)(cvtpk(v, v) & 0xffffu); }
    s += __shfl_xor(s, 1); s += __shfl_xor(s, 2); s += __shfl_xor(s, 4); s += __shfl_xor(s, 8); s += __shfl_xor(s, 16);
    if (r32 == 0) atomicAdd(ssw + orow, s); }
  __syncthreads();
#undef GLDS
#undef DMA_K
#undef DMA_KN
#undef DMA_KR
#undef DMA_V
#undef RESC
}
#undef KSWZ
#undef KRSWZ
#undef SBAR
}

constexpr int NWAVES = 8, NTHREADS = 512;
constexpr size_t MiB = 1u << 20;
constexpr size_t WS_SS = 0;
constexpr size_t WS_MOD = 2 * MiB;
constexpr size_t WS_ROPE = 3 * MiB;
constexpr size_t WS_WIN = 7 * MiB, WS_WUQ = 9 * MiB, WS_WUKV = 10 * MiB, WS_WOUT = 11 * MiB, WS_WGU = 13 * MiB, WS_WD = 24 * MiB;
constexpr size_t WS_HB = 32 * MiB;
constexpr size_t WS_U = 192 * MiB, WS_CQ = 232 * MiB, WS_CKV = 292 * MiB, WS_KR = 332 * MiB;
constexpr size_t WS_Q = 342 * MiB, WS_KN = 522 * MiB, WS_V = 642 * MiB, WS_MX = 762 * MiB, WS_END = 922 * MiB;
constexpr size_t WS_MG = WS_Q;
constexpr size_t WS_ACT = WS_U;
constexpr size_t WS_F = WS_V;
static_assert(WS_ACT + (size_t)TT * DFF * 2 <= WS_F && WS_F + (size_t)TT * DM * 2 <= WS_END && WS_WD + (size_t)DM * DFF * 2 <= WS_HB, "d_ws map");
constexpr int LDS_BYTES = 147456;
constexpr int MISC_OFF = 131072 + 320;
constexpr size_t WS_BAR = 1835008;

#define LAS __attribute__((address_space(3)))
typedef unsigned short bf16;
typedef float f32x4 __attribute__((ext_vector_type(4)));
typedef unsigned v4u __attribute__((ext_vector_type(4)));
typedef unsigned v2u __attribute__((ext_vector_type(2)));
__device__ __forceinline__ unsigned pkbf(float lo, float hi) { unsigned r; asm volatile("v_cvt_pk_bf16_f32 %0, %1, %2" : "=v"(r) : "v"(lo), "v"(hi)); return r; }
__device__ __forceinline__ float bf2f(unsigned short b) { return __uint_as_float((unsigned)b << 16); }
__device__ __forceinline__ float wave_sum(float v) {
#pragma unroll
    for (int o = 1; o < 64; o <<= 1) v += __shfl_xor(v, o);
    return v;
}

struct Params { const float* in[23]; float* out; unsigned char* ws; int ph_lo, ph_hi; };
enum { I_XP = 0, I_XS, I_CP, I_CS, I_WADA, I_BADA, I_GMIXPRE, I_GMIXPOST, I_WIN, I_POOLW, I_POOLSCALE, I_GQA, I_WUQ, I_GKVA, I_WUKV, I_GPOOLOUT, I_GATTNOUT, I_WOUT, I_GFFNPRE, I_GFFNPOST, I_WGATE, I_WUP, I_WDOWN };

struct WSrc { const float* p; int col; };
__device__ __forceinline__ WSrc wmap(const Params& a, int mat, int n) {
    if (mat == 0) {
        if (n >= 960) return {nullptr, 0};
        if (n < 896) return {a.in[I_WIN], n};
        const int pp = n - 896, ch = pp >> 5, w = pp & 31, nn = (w >> 2) & 1, i = 16 * ch + 4 * (w >> 3) + (w & 3); return {a.in[I_WIN], 896 + i + 32 * nn};
    } else if (mat == 1) {
        const int cc = n >> 5, w = n & 31; if (cc >= 36) return {nullptr, 0};
        const int h = cc / 6, j6 = cc - 6 * h;
        if (j6 < 4) return {a.in[I_WUQ], h * DQK + 32 * j6 + w};
        const int nn = (w >> 2) & 1, i = 16 * (j6 - 4) + 4 * (w >> 3) + (w & 3); return {a.in[I_WUQ], h * DQK + DNOPE + i + 32 * nn};
    } else if (mat == 2) return {a.in[I_WUKV], n};
    else if (mat == 3) return {a.in[I_WOUT], n};
    else if (mat == 4) { const int cc = n >> 5, w = n & 31, nn = w >> 4; return {nn ? a.in[I_WUP] : a.in[I_WGATE], 16 * cc + (w & 15)}; }
    return {a.in[I_WDOWN], n};
}
__device__ __forceinline__ float wgain(const Params& a, int mat, int k) {
    if (mat == 1) return a.in[I_GQA][k];
    if (mat == 2) return a.in[I_GKVA][k];
    if (mat == 3) return k < POOLW ? a.in[I_GPOOLOUT][k] : a.in[I_GATTNOUT][k - POOLW];
    return 1.0f;
}
__device__ __forceinline__ void p0_transpose_item(const Params& a, int mat, int K, int Nsrc, int Ndst, bf16* WT, LAS float* scr, int item, int lane) {
    const int nblk = Ndst / 32, kb = item / nblk, nb = item % nblk, k0 = 64 * kb, n0 = 32 * nb;
    const WSrc s = wmap(a, mat, n0 + (lane & 31));
#pragma unroll 8
    for (int i = 0; i < 32; ++i) { const int kk = 2 * i + (lane >> 5); scr[kk * 33 + (lane & 31)] = s.p ? s.p[(size_t)(k0 + kk) * Nsrc + s.col] * wgain(a, mat, k0 + kk) : 0.f; }
    asm volatile("s_waitcnt lgkmcnt(0)" ::: "memory");
    const int c = lane & 7;
#pragma unroll
    for (int j = 0; j < 4; ++j) { const int n = (lane >> 3) + 8 * j; const LAS float* sp = scr + (8 * c) * 33 + n;
        v4u o; o.x = pkbf(sp[0 * 33], sp[1 * 33]); o.y = pkbf(sp[2 * 33], sp[3 * 33]); o.z = pkbf(sp[4 * 33], sp[5 * 33]); o.w = pkbf(sp[6 * 33], sp[7 * 33]);
        *(v4u*)(WT + (size_t)(n0 + n) * K + k0 + 8 * c) = o; }
    asm volatile("s_waitcnt lgkmcnt(0)" ::: "memory");
}
__constant__ double INV_FREQ[32] = {1.0, 0.7498942093324559, 0.5623413251903491, 0.4216965034285822, 0.31622776601683794, 0.23713737056616552, 0.1778279410038923, 0.1333521432163324,
    0.1, 0.07498942093324558, 0.05623413251903491, 0.042169650342858224, 0.03162277660168379, 0.023713737056616554, 0.01778279410038923, 0.01333521432163324,
    0.01, 0.007498942093324558, 0.005623413251903491, 0.004216965034285823, 0.0031622776601683794, 0.0023713737056616554, 0.0017782794100389228, 0.001333521432163324,
    0.001, 0.0007498942093324559, 0.0005623413251903491, 0.00042169650342858224, 0.00031622776601683794, 0.00023713737056616554, 0.00017782794100389227, 0.0001333521432163324};
__device__ __forceinline__ void rope_entry(float* dst, int s, int i) {
    const double ang = (double)s * INV_FREQ[i];
    const double q = __builtin_rint(ang * 0.6366197723675814);
    double r = __builtin_fma(-q, 1.5707963267948966, ang); r = __builtin_fma(-q, 6.123233995736766e-17, r);
    const double r2 = r * r;
    const double sn = r * (1.0 + r2 * (-1.0 / 6 + r2 * (1.0 / 120 + r2 * (-1.0 / 5040 + r2 * (1.0 / 362880 + r2 * (-1.0 / 39916800 + r2 * (1.0 / 6227020800.0)))))));
    const double cn = 1.0 + r2 * (-0.5 + r2 * (1.0 / 24 + r2 * (-1.0 / 720 + r2 * (1.0 / 40320 + r2 * (-1.0 / 3628800 + r2 * (1.0 / 479001600 + r2 * (-1.0 / 87178291200.0)))))));
    const int qi = (int)((long long)q & 3);
    const double c = (qi == 0) ? cn : (qi == 1) ? -sn : (qi == 2) ? -cn : sn;
    const double sv = (qi == 0) ? sn : (qi == 1) ? cn : (qi == 2) ? -sn : -cn;
    dst[0] = (float)c; dst[1] = (float)sv;
}
__device__ __forceinline__ void p0a_prologue(const Params& a, LAS unsigned char* lds) {
    const int tid = threadIdx.x, lane = tid & 63, wave = __builtin_amdgcn_readfirstlane(tid >> 6);
    unsigned char* ws = a.ws;
    const int G = gridDim.x, gw = blockIdx.x * NWAVES + wave, NGW = G * NWAVES, gt = blockIdx.x * NTHREADS + tid, NGT = G * NTHREADS;
    { f32x4* z = (f32x4*)(ws + WS_SS); for (int i = gt; i < 5 * TT / 4; i += NGT) z[i] = (f32x4){0.f, 0.f, 0.f, 0.f}; }
    { float* rt = (float*)(ws + WS_ROPE); for (int i = gt; i < SEQ_S * 32; i += NGT) rope_entry(rt + 2 * (size_t)i, i >> 5, i & 31); }
    {
        LAS float* scr = (LAS float*)(lds + wave * 16384);
        constexpr int I0 = 16 * 32, I1 = 6 * 40, I2 = 4 * 48, I3 = 16 * 32, I4 = 16 * 176, I5 = 44 * 32;
        constexpr int NITEMS = I0 + I1 + I2 + I3 + I4 + I5;
        for (int it = gw; it < NITEMS; it += NGW) {
            int r = it;
            if (r < I0) { p0_transpose_item(a, 0, DM, 960, 1024, (bf16*)(ws + WS_WIN), scr, r, lane); continue; } r -= I0;
            if (r < I1) { p0_transpose_item(a, 1, QLR, LDQ_, 1280, (bf16*)(ws + WS_WUQ), scr, r, lane); continue; } r -= I1;
            if (r < I2) { p0_transpose_item(a, 2, KVLR, 1536, 1536, (bf16*)(ws + WS_WUKV), scr, r, lane); continue; } r -= I2;
            if (r < I3) { p0_transpose_item(a, 3, DM, DM, DM, (bf16*)(ws + WS_WOUT), scr, r, lane); continue; } r -= I3;
            if (r < I4) { p0_transpose_item(a, 4, DM, DFF, 2 * DFF, (bf16*)(ws + WS_WGU), scr, r, lane); continue; } r -= I4;
            p0_transpose_item(a, 5, DFF, DM, DM, (bf16*)(ws + WS_WD), scr, r, lane);
        }
    }
    __syncthreads();
    for (int bb = blockIdx.x; bb < 96; bb += G) {
        float accb[NBATCH];
#pragma unroll
        for (int b = 0; b < NBATCH; ++b) accb[b] = 0.f;
        const float* wa = a.in[I_WADA] + bb * 64 + lane;
        for (int k0 = wave * 128; k0 < wave * 128 + 128; k0 += 16) {
            float w[16];
#pragma unroll
            for (int kk = 0; kk < 16; ++kk) w[kk] = wa[(size_t)(k0 + kk) * 6144];
#pragma unroll
            for (int kk = 0; kk < 16; ++kk) {
#pragma unroll
                for (int b = 0; b < NBATCH; ++b) { const float c = (b < 8) ? a.in[I_CP][b * DM + k0 + kk] : a.in[I_CS][k0 + kk]; accb[b] += (c / (1.0f + __expf(-c))) * w[kk]; } }
        }
        LAS float* red = (LAS float*)lds;
#pragma unroll
        for (int b = 0; b < NBATCH; ++b) red[(wave * NBATCH + b) * 64 + lane] = accb[b];
        __syncthreads();
        for (int idx = tid; idx < NBATCH * 64; idx += NTHREADS) { const int b = idx >> 6, l = idx & 63; float s = a.in[I_BADA][bb * 64 + l];
#pragma unroll
            for (int w = 0; w < 8; ++w) s += red[(w * NBATCH + b) * 64 + l];
            ((float*)(ws + WS_MOD))[b * 6144 + bb * 64 + l] = s; }
        __syncthreads();
    }
}

__device__ __forceinline__ const float* xrow_ptr(const Params& a, int t) { return t < T_P ? a.in[I_XP] + (size_t)t * DM : a.in[I_XS] + (size_t)(t - T_P) * DM; }
__device__ __forceinline__ int batch_of(int t) { return t < T_P ? (t >> 13) : 8; }
__device__ __forceinline__ void st4bf(bf16* p, f32x4 v) { v2u w; w.x = pkbf(v[0], v[1]); w.y = pkbf(v[2], v[3]); *(v2u*)p = w; }
__device__ __forceinline__ f32x4 ld4bf(const bf16* p) { const v2u w = *(const v2u*)p; return (f32x4){__uint_as_float(w.x << 16), __uint_as_float(w.x & 0xffff0000u), __uint_as_float(w.y << 16), __uint_as_float(w.y & 0xffff0000u)}; }

__device__ __forceinline__ void wave_sum2(float& a, float& b) {
#pragma unroll
    for (int o = 1; o < 64; o <<= 1) { const float ta = __shfl_xor(a, o), tb = __shfl_xor(b, o); a += ta; b += tb; }
}
__device__ __forceinline__ float ssq4(f32x4 v) { return (v[0] * v[0] + v[1] * v[1]) + (v[2] * v[2] + v[3] * v[3]); }
#define ROWS_SETUP const int tid = threadIdx.x, lane = tid & 63, wave = __builtin_amdgcn_readfirstlane(tid >> 6); \
    const int NGW = gridDim.x * NWAVES, gw = blockIdx.x * NWAVES + wave, per = (((TT + NGW - 1) / NGW) + 1) & ~1, t_lo = gw * per, t_hi = min(TT, t_lo + per); (void)tid;
__device__ __forceinline__ void p0b_rows(const Params& a) {
    ROWS_SETUP
    const float* mod = (const float*)(a.ws + WS_MOD); bf16* HB = (bf16*)(a.ws + WS_HB);
    int bcur = -1; f32x4 A0[4], S1[4];
    for (int t = t_lo; t < t_hi; t += 2) {
        const int b = batch_of(t);
        if (b != bcur) { bcur = b;
#pragma unroll
            for (int j = 0; j < 4; ++j) { const int c = 4 * lane + 256 * j; const f32x4 g = *(const f32x4*)(a.in[I_GMIXPRE] + c), sc = *(const f32x4*)(mod + b * 6144 + 1024 + c);
                A0[j] = g * (sc + 1.0f); S1[j] = *(const f32x4*)(mod + b * 6144 + c); } }
        const f32x4* xr = (const f32x4*)xrow_ptr(a, t) + lane; f32x4 v[2][4]; float s0 = 0.f, s1 = 0.f;
#pragma unroll
        for (int j = 0; j < 4; ++j) { v[0][j] = xr[64 * j]; v[1][j] = xr[256 + 64 * j]; }
#pragma unroll
        for (int j = 0; j < 4; ++j) { s0 += ssq4(v[0][j]); s1 += ssq4(v[1][j]); }
        wave_sum2(s0, s1);
        const float r0 = 1.0f / sqrtf(s0 * (1.0f / DM) + EPS), r1 = 1.0f / sqrtf(s1 * (1.0f / DM) + EPS);
#pragma unroll
        for (int j = 0; j < 4; ++j) { st4bf(HB + (size_t)t * DM + 4 * lane + 256 * j, v[0][j] * r0 * A0[j] + S1[j]); st4bf(HB + (size_t)(t + 1) * DM + 4 * lane + 256 * j, v[1][j] * r1 * A0[j] + S1[j]); }
    }
}
__device__ __forceinline__ void p6_rows(const Params& a) {
    ROWS_SETUP
    const float* mod = (const float*)(a.ws + WS_MOD); bf16* HB = (bf16*)(a.ws + WS_HB); const bf16* MG = (const bf16*)(a.ws + WS_MG);
    const float* ssm = (const float*)(a.ws + WS_SS) + 3 * (size_t)TT;
    int bcur = -1; f32x4 A1[4], B2[4], S2[4];
    for (int t = t_lo; t < t_hi; t += 2) {
        const int b = batch_of(t);
        if (b != bcur) { bcur = b;
#pragma unroll
            for (int j = 0; j < 4; ++j) { const int c = 4 * lane + 256 * j;
                A1[j] = *(const f32x4*)(mod + b * 6144 + 2048 + c) * *(const f32x4*)(a.in[I_GMIXPOST] + c);
                B2[j] = *(const f32x4*)(a.in[I_GFFNPRE] + c) * (*(const f32x4*)(mod + b * 6144 + 4096 + c) + 1.0f);
                S2[j] = *(const f32x4*)(mod + b * 6144 + 3072 + c); } }
        const float rm0 = 1.0f / sqrtf(ssm[t] * (1.0f / DM) + EPS), rm1 = 1.0f / sqrtf(ssm[t + 1] * (1.0f / DM) + EPS);
        const f32x4* xr = (const f32x4*)xrow_ptr(a, t) + lane; f32x4 v[2][4], mg[2][4]; float s0 = 0.f, s1 = 0.f;
#pragma unroll
        for (int j = 0; j < 4; ++j) { v[0][j] = xr[64 * j]; v[1][j] = xr[256 + 64 * j];
            mg[0][j] = ld4bf(MG + (size_t)t * DM + 4 * lane + 256 * j); mg[1][j] = ld4bf(MG + (size_t)(t + 1) * DM + 4 * lane + 256 * j); }
#pragma unroll
        for (int j = 0; j < 4; ++j) { v[0][j] = v[0][j] + A1[j] * (mg[0][j] * rm0); v[1][j] = v[1][j] + A1[j] * (mg[1][j] * rm1); s0 += ssq4(v[0][j]); s1 += ssq4(v[1][j]); }
        wave_sum2(s0, s1);
        const float r0 = 1.0f / sqrtf(s0 * (1.0f / DM) + EPS), r1 = 1.0f / sqrtf(s1 * (1.0f / DM) + EPS);
        f32x4* orow = (f32x4*)(a.out + (size_t)t * DM) + lane;
#pragma unroll
        for (int j = 0; j < 4; ++j) { orow[64 * j] = v[0][j]; orow[256 + 64 * j] = v[1][j];
            st4bf(HB + (size_t)t * DM + 4 * lane + 256 * j, v[0][j] * r0 * B2[j] + S2[j]); st4bf(HB + (size_t)(t + 1) * DM + 4 * lane + 256 * j, v[1][j] * r1 * B2[j] + S2[j]); }
    }
}
__device__ __forceinline__ void p9_rows(const Params& a) {
    ROWS_SETUP
    const float* mod = (const float*)(a.ws + WS_MOD); const bf16* FB = (const bf16*)(a.ws + WS_F);
    const float* ssf = (const float*)(a.ws + WS_SS) + 4 * (size_t)TT;
    int bcur = -1; f32x4 A2[4];
    for (int t = t_lo; t < t_hi; t += 2) {
        const int b = batch_of(t);
        if (b != bcur) { bcur = b;
#pragma unroll
            for (int j = 0; j < 4; ++j) { const int c = 4 * lane + 256 * j; A2[j] = *(const f32x4*)(mod + b * 6144 + 5120 + c) * *(const f32x4*)(a.in[I_GFFNPOST] + c); } }
        const float rf0 = 1.0f / sqrtf(ssf[t] * (1.0f / DM) + EPS), rf1 = 1.0f / sqrtf(ssf[t + 1] * (1.0f / DM) + EPS);
        f32x4* orow = (f32x4*)(a.out + (size_t)t * DM) + lane; f32x4 x1[2][4], f[2][4];
#pragma unroll
        for (int j = 0; j < 4; ++j) { x1[0][j] = orow[64 * j]; x1[1][j] = orow[256 + 64 * j];
            f[0][j] = ld4bf(FB + (size_t)t * DM + 4 * lane + 256 * j); f[1][j] = ld4bf(FB + (size_t)(t + 1) * DM + 4 * lane + 256 * j); }
#pragma unroll
        for (int j = 0; j < 4; ++j) { orow[64 * j] = x1[0][j] + A2[j] * (f[0][j] * rf0); orow[256 + 64 * j] = x1[1][j] + A2[j] * (f[1][j] * rf1); }
    }
}
#undef ROWS_SETUP

__device__ __forceinline__ void pool_phase(const Params& a, LAS unsigned char* lds) {
    const int tid = threadIdx.x, lane = tid & 63, wave = __builtin_amdgcn_readfirstlane(tid >> 6);
    const bf16* U = (const bf16*)(a.ws + WS_U); bf16* MX = (bf16*)(a.ws + WS_MX); const float* ssa = (const float*)(a.ws + WS_SS) + 2 * (size_t)TT;
    LAS float* ps = (LAS float*)lds;
    LAS float* ssl = (LAS float*)(lds + 65536);
    LAS unsigned char* us = lds + 65536 + 1024;
    const int g = wave & 3, half = wave >> 2, d = lane;
    float wreg[64];
#pragma unroll
    for (int c = 0; c < 64; ++c) wreg[c] = a.in[I_POOLW][g * 4096 + c * 64 + d];
    const float pscale = a.in[I_POOLSCALE][64 * g + d];
    for (int tile = blockIdx.x; tile < TT / 64; tile += gridDim.x) {
        const int t0 = tile * 64, sb = t0 < T_P ? (t0 & ~(SEQ_P - 1)) : T_P, se = t0 < T_P ? sb + SEQ_P : TT;
#pragma unroll
        for (int it = 0; it < 5; ++it) { const int idx = tid + NTHREADS * it, rl = idx >> 5, ch8 = idx & 31, tr = t0 - 8 + rl;
            if (tr >= sb && tr < se) *(LAS v4u*)(us + rl * 512 + ch8 * 16) = *(const v4u*)(U + (size_t)tr * POOLW + ch8 * 8); }
        __syncthreads();
#pragma unroll 1
        for (int it = 0; it < 4; ++it) {
            const int idx = tid + NTHREADS * it, tl = idx >> 5, ch8 = idx & 31, t = t0 + tl, w = 2 << (ch8 >> 3);
            const int lo = max(t - (w >> 1), sb), hi = min(t + w - (w >> 1), se);
            float sum[8];
#pragma unroll
            for (int e = 0; e < 8; ++e) sum[e] = 0.f;
            for (int j = lo; j < hi; ++j) { const v4u q = *(const LAS v4u*)(us + (j - t0 + 8) * 512 + ch8 * 16);
#pragma unroll
                for (int e = 0; e < 4; ++e) { sum[2 * e] += __uint_as_float(q[e] << 16); sum[2 * e + 1] += __uint_as_float(q[e] & 0xffff0000u); } }
            const v4u q = *(const LAS v4u*)(us + (tl + 8) * 512 + ch8 * 16); const float inv = 1.0f / (float)(hi - lo);
            f32x4 o0, o1;
#pragma unroll
            for (int e = 0; e < 2; ++e) { o0[2 * e] = sum[2 * e] * inv - __uint_as_float(q[e] << 16); o0[2 * e + 1] = sum[2 * e + 1] * inv - __uint_as_float(q[e] & 0xffff0000u);
                o1[2 * e] = sum[4 + 2 * e] * inv - __uint_as_float(q[2 + e] << 16); o1[2 * e + 1] = sum[5 + 2 * e] * inv - __uint_as_float(q[2 + e] & 0xffff0000u); }
            *(LAS f32x4*)(ps + tl * 256 + ch8 * 8) = o0; *(LAS f32x4*)(ps + tl * 256 + ch8 * 8 + 4) = o1;
        }
        __syncthreads();
        float o[32];
#pragma unroll
        for (int tt = 0; tt < 32; ++tt) { const int tl = half * 32 + tt; float acc = 0.f;
#pragma unroll
            for (int c4 = 0; c4 < 16; ++c4) { const f32x4 pv = *(const LAS f32x4*)(ps + tl * 256 + g * 64 + c4 * 4);
                acc += pv[0] * wreg[4 * c4] + pv[1] * wreg[4 * c4 + 1] + pv[2] * wreg[4 * c4 + 2] + pv[3] * wreg[4 * c4 + 3]; }
            o[tt] = acc * pscale; const float s = wave_sum(o[tt] * o[tt]);
            if (lane == 0) ssl[g * 64 + tl] = s; }
        __syncthreads();
#pragma unroll
        for (int tt = 0; tt < 32; ++tt) { const int tl = half * 32 + tt, t = t0 + tl;
            const float f = sqrtf(ssa[t] * (1.0f / (NH * DV)) + EPS) / sqrtf(((ssl[tl] + ssl[64 + tl]) + (ssl[128 + tl] + ssl[192 + tl])) * (1.0f / POOLW) + EPS);
            MX[(size_t)t * DM + 64 * g + d] = (bf16)(pkbf(o[tt] * f, 0.f) & 0xffffu); }
        __syncthreads();
    }
}
#define XB_TMO      128
#define XB_XCNT(j)  (256  + 64 * (j))
#define XB_XSUB(j)  (1280 + 64 * (j))
#define XB_XGEN(j)  (2304 + 64 * (j))
#define XB_TOP      3328
#define XB_TOPGEN   3392
#define XCD_BAR_WORDS 3456
#define XB_SPIN_CAP (1u << 18)

__device__ __forceinline__ unsigned xb_ld(unsigned* p)              { return __hip_atomic_load(p, __ATOMIC_RELAXED, __HIP_MEMORY_SCOPE_AGENT); }
__device__ __forceinline__ unsigned xb_add(unsigned* p, unsigned v) { return __hip_atomic_fetch_add(p, v, __ATOMIC_RELAXED, __HIP_MEMORY_SCOPE_AGENT); }
__device__ __forceinline__ unsigned xb_xcc_id() { return (unsigned)__builtin_amdgcn_s_getreg((3 << 11) | 20) & 0xFu; }
#define XB_SPIN(cond, bar) do { unsigned _sp = 0; while (cond) { __builtin_amdgcn_s_sleep(1); \
    if ((++_sp & 255u) == 0u) { if (xb_ld(&(bar)[XB_TMO])) break; if (_sp > XB_SPIN_CAP) { atomicAdd(&(bar)[XB_TMO], 1u); break; } } } } while (0)

struct XcdBarrier {
    unsigned* bar; unsigned x;
    volatile LAS unsigned* st;
};

__device__ __forceinline__ XcdBarrier xcd_barrier_post(unsigned* bar, volatile LAS unsigned* st) {
    XcdBarrier b; b.bar = bar; b.x = xb_xcc_id(); b.st = st;
    if (threadIdx.x == 0) (void)xb_add(&bar[XB_XCNT(b.x)], 1u);
    return b;
}
__device__ __forceinline__ void xcd_barrier_complete(unsigned* bar, unsigned x, unsigned& nloc, unsigned& nx) {
    const unsigned G = gridDim.x * gridDim.y * gridDim.z;
    unsigned sum, cnt, mine, sp = 0u;
    for (;;) {
        sum = 0u; cnt = 0u; mine = 0u;
#pragma unroll
        for (unsigned j = 0; j < 16; ++j) { const unsigned c = xb_ld(&bar[XB_XCNT(j)]); sum += c; cnt += (c > 0u) ? 1u : 0u; mine = (j == x) ? c : mine; }
        if (sum == G) break;
        __builtin_amdgcn_s_sleep(1);
        if ((++sp & 255u) == 0u) { if (xb_ld(&bar[XB_TMO])) break; if (sp > XB_SPIN_CAP) { atomicAdd(&bar[XB_TMO], 1u); break; } }
    }
    nloc = mine > 0u ? mine : 1u; nx = cnt > 0u ? cnt : 1u;
}

__device__ __forceinline__ void xcd_barrier(const XcdBarrier& b) {
    asm volatile("s_waitcnt vmcnt(0)" ::: "memory");
    __syncthreads();
    if (threadIdx.x == 0) {
        unsigned* bar = b.bar;
        __builtin_amdgcn_s_waitcnt(0);
        unsigned nloc = b.st[0], nx = b.st[1];
        if (nloc == 0u) { xcd_barrier_complete(bar, b.x, nloc, nx); b.st[0] = nloc; b.st[1] = nx; }
        const unsigned old = xb_add(&bar[XB_XSUB(b.x)], 1u);
        const unsigned gen = old / nloc;
        if (old + 1u == (gen + 1u) * nloc) {
            __builtin_amdgcn_fence(__ATOMIC_RELEASE, "agent");
            asm volatile("s_waitcnt vmcnt(0)" ::: "memory");
            const unsigned og = xb_add(&bar[XB_TOP], 1u);
            const unsigned tg = og / nx;
            if (og + 1u == (tg + 1u) * nx) xb_add(&bar[XB_TOPGEN], 1u);
            else XB_SPIN(xb_ld(&bar[XB_TOPGEN]) == tg, bar);
            __builtin_amdgcn_fence(__ATOMIC_ACQUIRE, "agent");
            xb_add(&bar[XB_XGEN(b.x)], 1u);
            asm volatile("s_waitcnt vmcnt(0)" ::: "memory");
        } else {
            XB_SPIN(xb_ld(&bar[XB_XGEN(b.x)]) == gen, bar);
            __builtin_amdgcn_fence(__ATOMIC_ACQUIRE, "agent");
            asm volatile("s_waitcnt vmcnt(0)" ::: "memory");
        }
    }
    __syncthreads();
}

constexpr int N_PHASES = 10;
__device__ __forceinline__ void attn_phase(const Params& a, unsigned char* lds) {
    const att::bf16_t* Q = (const att::bf16_t*)(a.ws + WS_Q); const att::bf16_t* KN = (const att::bf16_t*)(a.ws + WS_KN); const att::bf16_t* KR = (const att::bf16_t*)(a.ws + WS_KR);
    const att::bf16_t* V = (const att::bf16_t*)(a.ws + WS_V); att::bf16_t* MX = (att::bf16_t*)(a.ws + WS_MX); float* ssa = (float*)(a.ws + WS_SS) + 2 * (size_t)TT;
    const int G = gridDim.x;
    const int x = blockIdx.x & 7, cu = blockIdx.x >> 3;
    const int ns = x < 4 ? 2 : 1, np = x < 4 ? 5 : 7, p0 = x < 4 ? 5 * x : 20 + 7 * (x - 4);
    const int nunits = (G == 256) ? ns + np : ((TT / 256) * NH - (int)blockIdx.x + G - 1) / G;
    for (int i = 0; i < nunits; ++i) {
        int row0, k0, h, seq;
        if (G == 256) {
            if (i < ns) { h = x < 4 ? x : 4 + ((x - 4) >> 1); const int qb = x < 4 ? cu + 32 * i : ((x - 4) & 1) * 32 + cu; row0 = T_P + qb * 256; k0 = T_P; seq = SEQ_S; }
            else { const int p = p0 + (i - ns), sq = p / NH; h = p - sq * NH; row0 = sq * SEQ_P + cu * 256; k0 = sq * SEQ_P; seq = SEQ_P; }
        } else { const int uidx = blockIdx.x + i * G, rb = uidx / NH; h = uidx - rb * NH; row0 = rb * 256; k0 = row0 < T_P ? (row0 & ~(SEQ_P - 1)) : T_P; seq = row0 < T_P ? SEQ_P : SEQ_S; }
        att::attn_unit(Q + (size_t)row0 * LDQ_ + h * DQK, KN + (size_t)k0 * LDKV_ + h * DNOPE, KR + (size_t)k0 * DROPE, V + (size_t)k0 * LDKV_ + h * DV,
                       MX + (size_t)row0 * DM + POOLW + h * DV, ssa + row0, seq, (char*)lds);
    }
}

__global__ void __launch_bounds__(NTHREADS, 2) enc_fwd(Params a) {
    extern __shared__ __attribute__((aligned(16))) unsigned char lds_raw[];
    LAS unsigned char* lds = (LAS unsigned char*)lds_raw;
    const int lo = a.ph_lo, hi = a.ph_hi, G = gridDim.x;
    unsigned char* ws = a.ws;
    float* SS = (float*)(ws + WS_SS);
#define IN(k) (lo <= (k) && (k) < hi)
    unsigned* barw = (unsigned*)(ws + WS_BAR);
    volatile LAS unsigned* MISC = (volatile LAS unsigned*)(lds + MISC_OFF);
    if (threadIdx.x < 16) MISC[threadIdx.x] = 0u;
    if (IN(0) && IN(1) && blockIdx.x == 0) for (int i = threadIdx.x; i < XCD_BAR_WORDS; i += NTHREADS) barw[i] = 0u;
    __syncthreads();
    XcdBarrier xb; xb.bar = barw; xb.x = 0; xb.st = MISC + 8;
#define SEAM(k) do { if (IN(k) && IN((k) + 1)) { if ((k) == 0) { cg::this_grid().sync(); xb = xcd_barrier_post(barw, MISC + 8); } else xcd_barrier(xb); } } while (0)
    if (IN(0)) { p0a_prologue(a, lds); } SEAM(0);
    if (IN(1)) { p0b_rows(a); } SEAM(1);
    if (IN(2)) {
        pg8::Gemm g{(const pg8::bf16_t*)(ws + WS_HB), (const pg8::bf16_t*)(ws + WS_WIN), TT, 1024, DM}; pg8::StaticOrder S; S.init(TT, 1024, G, (int)blockIdx.x);
        pg8::EpiZ E{(pg8::bf16_t*)(ws + WS_U), (pg8::bf16_t*)(ws + WS_CQ), (pg8::bf16_t*)(ws + WS_CKV), (pg8::bf16_t*)(ws + WS_KR), SS, SS + TT, (const float*)(ws + WS_ROPE)};
        pg8::gemm_phase<pg8::EpiZ, pg8::StaticOrder, true, true>(lds, g, S, E);
    } SEAM(2);
    if (IN(3)) {
        { pg8::Gemm g{(const pg8::bf16_t*)(ws + WS_CQ), (const pg8::bf16_t*)(ws + WS_WUQ), TT, 1280, QLR}; pg8::StaticOrder S; S.init(TT, 1280, G, (int)blockIdx.x);
          pg8::EpiQ E{(pg8::bf16_t*)(ws + WS_Q), SS, (const float*)(ws + WS_ROPE)};
          pg8::gemm_phase<pg8::EpiQ, pg8::StaticOrder, true, true>(lds, g, S, E); }
        { pg8::Gemm g{(const pg8::bf16_t*)(ws + WS_CKV), (const pg8::bf16_t*)(ws + WS_WUKV), TT, 1536, KVLR}; pg8::StaticOrder S; S.init(TT, 1536, G, (int)blockIdx.x);
          pg8::EpiKV E{(pg8::bf16_t*)(ws + WS_KN), (pg8::bf16_t*)(ws + WS_V), SS + TT};
          pg8::gemm_phase<pg8::EpiKV, pg8::StaticOrder, true, true>(lds, g, S, E); }
    } SEAM(3);
    if (IN(4)) { attn_phase(a, lds_raw); } SEAM(4);
    if (IN(5)) { pool_phase(a, lds); } SEAM(5);
    if (IN(6)) {
        pg8::Gemm g{(const pg8::bf16_t*)(ws + WS_MX), (const pg8::bf16_t*)(ws + WS_WOUT), TT, DM, DM}; pg8::StaticOrder S; S.init(TT, DM, G, (int)blockIdx.x);
        pg8::EpiRowScaleSS E{(pg8::bf16_t*)(ws + WS_MG), SS + 2 * (size_t)TT, 1.0f / (NH * DV), SS + 3 * (size_t)TT};
        pg8::gemm_phase<pg8::EpiRowScaleSS, pg8::StaticOrder, true, true>(lds, g, S, E);
    } SEAM(6);
    if (IN(7)) { p6_rows(a); } SEAM(7);
    if (IN(8)) {
        pg8::Gemm g{(const pg8::bf16_t*)(ws + WS_HB), (const pg8::bf16_t*)(ws + WS_WGU), TT, 2 * DFF, DM}; pg8::StaticOrder S; S.init(TT, 2 * DFF, G, (int)blockIdx.x);
        pg8::EpiGU E{(pg8::bf16_t*)(ws + WS_ACT)};
        pg8::gemm_phase<pg8::EpiGU, pg8::StaticOrder, true, true>(lds, g, S, E);
    } SEAM(8);
    if (IN(9)) {
        pg8::Gemm g{(const pg8::bf16_t*)(ws + WS_ACT), (const pg8::bf16_t*)(ws + WS_WD), TT, DM, DFF}; pg8::StaticOrder S; S.init(TT, DM, G, (int)blockIdx.x);
        pg8::EpiRowScaleSS E{(pg8::bf16_t*)(ws + WS_F), nullptr, 0.f, SS + 4 * (size_t)TT};
        pg8::gemm_phase<pg8::EpiRowScaleSS, pg8::StaticOrder, true, true>(lds, g, S, E);
    } SEAM(9);
    if (IN(10)) { p9_rows(a); }
#undef IN
#undef SEAM
}

extern "C" void kernel_launch(void* const* d_in, const int* in_sizes, int n_in, void* d_out, int out_size, void* d_ws, size_t ws_size, hipStream_t stream) {
    static int grid = 0;
    if (grid == 0) {
        if (n_in != 23 || out_size != TT * DM || ws_size < WS_END) { fprintf(stderr, "kernel_launch: unexpected shapes: n_in %d out %d ws %zu (need %zu)\n", n_in, out_size, ws_size, (size_t)WS_END); grid = -1; return; }
        int dev = 0, cus = 0, per_cu = 0;
        if (hipGetDevice(&dev) != hipSuccess || hipDeviceGetAttribute(&cus, hipDeviceAttributeMultiprocessorCount, dev) != hipSuccess) { grid = -1; return; }
        if (hipFuncSetAttribute((const void*)enc_fwd, hipFuncAttributeMaxDynamicSharedMemorySize, LDS_BYTES) != hipSuccess) { fprintf(stderr, "kernel_launch: hipFuncSetAttribute failed\n"); grid = -1; return; }
        if (hipOccupancyMaxActiveBlocksPerMultiprocessor(&per_cu, (const void*)enc_fwd, NTHREADS, LDS_BYTES) != hipSuccess || per_cu < 1) per_cu = 1;
        (void)hipGetLastError();
        grid = cus;
    }
    if (grid < 0) return;
    Params p{};
    for (int i = 0; i < 23; ++i) p.in[i] = (const float*)d_in[i];
    p.out = (float*)d_out; p.ws = (unsigned char*)d_ws;
#if MK_PER_PHASE
    for (int ph = 0; ph <= N_PHASES; ++ph) { p.ph_lo = ph; p.ph_hi = ph + 1; hipLaunchKernelGGL(enc_fwd, dim3(grid), dim3(NTHREADS), LDS_BYTES, stream, p); }
#else
    p.ph_lo = 0; p.ph_hi = N_PHASES + 1;
    void* args[] = {&p};
    hipError_t e = hipLaunchCooperativeKernel((const void*)enc_fwd, dim3(grid), dim3(NTHREADS), args, LDS_BYTES, stream);
    if (e != hipSuccess) fprintf(stderr, "kernel_launch: cooperative launch failed: %s (grid %d)\n", hipGetErrorString(e), grid);
#endif
}
```

```cpp
#include <hip/hip_runtime.h>
#include <hip/hip_cooperative_groups.h>
#include <cstdio>
#include <cstdint>
namespace cg = cooperative_groups;

#ifndef MK_PER_PHASE
#define MK_PER_PHASE 0
#endif

constexpr int DM = 1024, T_P = 65536, T_S = 16384, TT = T_P + T_S, SEQ_P = 8192, SEQ_S = 16384, NBATCH = 9;
constexpr int NH = 6, DQK = 192, DNOPE = 128, DROPE = 64, DV = 128, QLR = 384, KVLR = 256, DFF = 2816, POOLW = 256;
constexpr int LDQ_ = NH * DQK  , LDKV_ = NH * DNOPE  ;
constexpr float EPS = 1e-6f;
constexpr float QSCALE = 0.07216878364870322f * 1.4426950408889634f;

namespace pg8 {
#define PG8_LAS __attribute__((address_space(3)))
typedef unsigned short bf16_t;
typedef short bf16x8 __attribute__((ext_vector_type(8)));
typedef float f32x4 __attribute__((ext_vector_type(4)));
typedef unsigned u32x4 __attribute__((ext_vector_type(4)));
constexpr int BM = 256, BK = 64, HALF = 128, HTB = HALF * BK * 2  , STAGE_BYTES = 8 * HTB, NXCD = 8, WGM = 8;

__host__ __device__ __forceinline__ int lds_byte(int r, int c) { const int st = (r >> 4) * 2 + (c >> 5), rr = r & 15, cc = c & 31, ob = rr * 64 + cc * 2; return st * 1024 + (ob ^ (((ob >> 9) & 1) << 5)); }
__host__ __device__ __forceinline__ void stage_rc(int b, int& R, int& C) { const int st = b / 1024, sb = b % 1024, swz = sb ^ (((sb >> 9) & 1) << 5); R = (st >> 1) * 16 + swz / 64; C = (st & 1) * 32 + (swz % 64) / 2; }
__host__ __device__ __forceinline__ int perm32(int rho) { const int n = rho >> 4, i = rho & 15; return 8 * (i >> 2) + 4 * n + (i & 3); }

struct Unit { int pm, pn; };
struct Gemm { const bf16_t* A; const bf16_t* Bt; int M, N, K; };

struct StaticOrder {
    int nM, nN, nwg, G, c;
    __host__ __device__ void init(int M, int N, int G_, int c_) { nM = M / BM; nN = N / BM; nwg = nM * nN; G = G_; c = c_; }
    __host__ __device__ bool next(int i, Unit& u) const {
        const long L = (long)i * G + c; if (L >= nwg) return false;
        int wgid = (int)L; { const int q = nwg / NXCD, r = nwg % NXCD, xcd = wgid % NXCD, off = wgid / NXCD; wgid = (xcd < r ? xcd * (q + 1) : r * (q + 1) + (xcd - r) * q) + off; }
        const int nig = WGM * nN, gid = wgid / nig, fm = gid * WGM, gsz = (nM - fm) < WGM ? (nM - fm) : WGM;
        u.pm = fm + ((wgid % nig) % gsz); u.pn = (wgid % nig) / gsz; return true;
    }
    __device__ __forceinline__ void a_ready(const Unit&) const {}
    __device__ __forceinline__ void done(const Unit&) const {}
};


__device__ __forceinline__ unsigned cvt_pk_bf16(float lo, float hi) { unsigned r; asm volatile("v_cvt_pk_bf16_f32 %0, %1, %2" : "=v"(r) : "v"(lo), "v"(hi)); return r; }
typedef unsigned u32x2 __attribute__((ext_vector_type(2)));
__device__ __forceinline__ void st4(bf16_t* p, f32x4 v) { u32x2 w; w.x = cvt_pk_bf16(v[0], v[1]); w.y = cvt_pk_bf16(v[2], v[3]); *(u32x2*)p = w; }
__device__ __forceinline__ void st8(bf16_t* p, f32x4 a, f32x4 b) { u32x4 w; w.x = cvt_pk_bf16(a[0], a[1]); w.y = cvt_pk_bf16(a[2], a[3]); w.z = cvt_pk_bf16(b[0], b[1]); w.w = cvt_pk_bf16(b[2], b[3]); *(u32x4*)p = w; }
__device__ __forceinline__ float sq4(f32x4 v) { return (v[0] * v[0] + v[1] * v[1]) + (v[2] * v[2] + v[3] * v[3]); }
__device__ __forceinline__ void row_ss_add(float* ss, int row, float s, int fq) { s += __shfl_xor(s, 16); s += __shfl_xor(s, 32); if (fq == 0) atomicAdd(ss + row, s); }
__device__ __forceinline__ int seq_pos(int row) { return row < T_P ? (row & (SEQ_P - 1)) : (row - T_P); }
#define PG8_ROWS_BEGIN _Pragma("unroll") for (int ai = 0; ai < 2; ++ai) _Pragma("unroll") for (int m = 0; m < 4; ++m) { const int row = u.pm * BM + ai * HALF + wr * 64 + m * 16 + fr + zo_;
#define PG8_ROWS_END asm volatile("" ::: "memory"); }

struct EpiZ {
    static constexpr bool PERM = true, AFTER_DRAIN = false;
    bf16_t *U, *CQ, *CKV, *KR; float *ssq, *sskv; const float* rope;
    __device__ __forceinline__ void operator()(const f32x4 (&acc)[2][2][4][2], const Unit& u, int wr, int wc, int fr_in, int fq_in) const {
        int zo_ = 0, fr = fr_in, fq = fq_in; asm volatile("" : "+v"(zo_), "+v"(fr), "+v"(fq));
#pragma unroll
        for (int bj = 0; bj < 2; ++bj) {
            const int cc = u.pn * 8 + bj * 4 + wc;
            if (cc < 8) {
                PG8_ROWS_BEGIN
                    st8(U + (size_t)row * POOLW + cc * 32 + 8 * fq, acc[ai][bj][m][0], acc[ai][bj][m][1]);
                PG8_ROWS_END
            } else if (cc < 20) {
                PG8_ROWS_BEGIN
                    st8(CQ + (size_t)row * QLR + (cc - 8) * 32 + 8 * fq, acc[ai][bj][m][0], acc[ai][bj][m][1]);
                    row_ss_add(ssq, row, sq4(acc[ai][bj][m][0]) + sq4(acc[ai][bj][m][1]), fq);
                PG8_ROWS_END
            } else if (cc < 28) {
                PG8_ROWS_BEGIN
                    st8(CKV + (size_t)row * KVLR + (cc - 20) * 32 + 8 * fq, acc[ai][bj][m][0], acc[ai][bj][m][1]);
                    row_ss_add(sskv, row, sq4(acc[ai][bj][m][0]) + sq4(acc[ai][bj][m][1]), fq);
                PG8_ROWS_END
            } else if (cc < 30) {
                const int i0 = 16 * (cc - 28) + 4 * fq;
                PG8_ROWS_BEGIN
                    const float* rp = rope + ((size_t)seq_pos(row) * 32 + i0) * 2;
                    const f32x4 cs0 = *(const f32x4*)rp, cs1 = *(const f32x4*)(rp + 4);
                    const f32x4 x1 = acc[ai][bj][m][0], x2 = acc[ai][bj][m][1];
                    const f32x4 c = {cs0[0], cs0[2], cs1[0], cs1[2]}, s = {cs0[1], cs0[3], cs1[1], cs1[3]};
                    bf16_t* p = KR + (size_t)row * DROPE + i0; st4(p, x1 * c - x2 * s); st4(p + 32, x2 * c + x1 * s);
                PG8_ROWS_END
            }
        }
    }
};
struct EpiQ {
    static constexpr bool PERM = true, AFTER_DRAIN = false;
    bf16_t* Q; const float* ssq; const float* rope;
    __device__ __forceinline__ void operator()(const f32x4 (&acc)[2][2][4][2], const Unit& u, int wr, int wc, int fr_in, int fq_in) const {
        int zo_ = 0, fr = fr_in, fq = fq_in; asm volatile("" : "+v"(zo_), "+v"(fr), "+v"(fq));
#pragma unroll
        for (int bj = 0; bj < 2; ++bj) {
            const int cc = u.pn * 8 + bj * 4 + wc;
            if (cc >= 36) continue;
            const int h = cc / 6, j6 = cc - 6 * h;
            if (j6 < 4) {
                PG8_ROWS_BEGIN
                    const float rq = QSCALE / sqrtf(ssq[row] * (1.0f / QLR) + EPS);
                    st8(Q + (size_t)row * LDQ_ + h * DQK + j6 * 32 + 8 * fq, acc[ai][bj][m][0] * rq, acc[ai][bj][m][1] * rq);
                PG8_ROWS_END
            } else {
                const int i0 = 16 * (j6 - 4) + 4 * fq;
                PG8_ROWS_BEGIN
                    const float rq = QSCALE / sqrtf(ssq[row] * (1.0f / QLR) + EPS);
                    const float* rp = rope + ((size_t)seq_pos(row) * 32 + i0) * 2;
                    const f32x4 cs0 = *(const f32x4*)rp, cs1 = *(const f32x4*)(rp + 4);
                    const f32x4 x1 = acc[ai][bj][m][0] * rq, x2 = acc[ai][bj][m][1] * rq;
                    const f32x4 c = {cs0[0], cs0[2], cs1[0], cs1[2]}, s = {cs0[1], cs0[3], cs1[1], cs1[3]};
                    bf16_t* p = Q + (size_t)row * LDQ_ + h * DQK + DNOPE + i0; st4(p, x1 * c - x2 * s); st4(p + 32, x2 * c + x1 * s);
                PG8_ROWS_END
            }
        }
    }
};
struct EpiKV {
    static constexpr bool PERM = true, AFTER_DRAIN = false;
    bf16_t *KN, *V; const float* sskv;
    __device__ __forceinline__ void operator()(const f32x4 (&acc)[2][2][4][2], const Unit& u, int wr, int wc, int fr_in, int fq_in) const {
        int zo_ = 0, fr = fr_in, fq = fq_in; asm volatile("" : "+v"(zo_), "+v"(fr), "+v"(fq));
        PG8_ROWS_BEGIN
            const float rk = 1.0f / sqrtf(sskv[row] * (1.0f / KVLR) + EPS);
            const size_t o = (size_t)row * LDKV_ + u.pn * DNOPE + wc * 32 + 8 * fq;
            st8(KN + o, acc[ai][0][m][0] * rk, acc[ai][0][m][1] * rk);
            st8(V + o, acc[ai][1][m][0] * rk, acc[ai][1][m][1] * rk);
        PG8_ROWS_END
    }
};
struct EpiRowScaleSS {
    static constexpr bool PERM = true, AFTER_DRAIN = false;
    bf16_t* O; const float* rs; float rs_div; float* ss;
    __device__ __forceinline__ void operator()(const f32x4 (&acc)[2][2][4][2], const Unit& u, int wr, int wc, int fr_in, int fq_in) const {
        int zo_ = 0, fr = fr_in, fq = fq_in; asm volatile("" : "+v"(zo_), "+v"(fr), "+v"(fq));
        PG8_ROWS_BEGIN
            const float r = rs ? 1.0f / sqrtf(rs[row] * rs_div + EPS) : 1.0f;
            float s = 0.f;
#pragma unroll
            for (int bj = 0; bj < 2; ++bj) {
                const f32x4 v0 = acc[ai][bj][m][0] * r, v1 = acc[ai][bj][m][1] * r;
                st8(O + (size_t)row * DM + u.pn * BM + bj * HALF + wc * 32 + 8 * fq, v0, v1);
                s += sq4(v0) + sq4(v1);
            }
            row_ss_add(ss, row, s, fq);
        PG8_ROWS_END
    }
};
struct EpiGU {
    static constexpr bool PERM = false, AFTER_DRAIN = false;
    bf16_t* ACT;
    __device__ __forceinline__ void operator()(const f32x4 (&acc)[2][2][4][2], const Unit& u, int wr, int wc, int fr_in, int fq_in) const {
        int zo_ = 0, fr = fr_in, fq = fq_in; asm volatile("" : "+v"(zo_), "+v"(fr), "+v"(fq));
        PG8_ROWS_BEGIN
#pragma unroll
            for (int bj = 0; bj < 2; ++bj) {
                const int cc = u.pn * 8 + bj * 4 + wc;
                const f32x4 g = acc[ai][bj][m][0], up = acc[ai][bj][m][1]; f32x4 o;
#pragma unroll
                for (int j = 0; j < 4; ++j) o[j] = g[j] * __builtin_amdgcn_rcpf(1.0f + __builtin_amdgcn_exp2f(-1.4426950408889634f * g[j])) * up[j];
                st4(ACT + (size_t)row * DFF + cc * 16 + 4 * fq, o);
            }
        PG8_ROWS_END
    }
};
#undef PG8_ROWS_BEGIN
#undef PG8_ROWS_END

template <class Epi, class Sched, bool ALIGN_EPI = false, bool SP2 = false>
__device__ __forceinline__ void gemm_phase(PG8_LAS unsigned char* lds, const Gemm g, const Sched& S, const Epi& E) {
    const int tid = threadIdx.x, wid = __builtin_amdgcn_readfirstlane(tid >> 6), lane = tid & 63, wr = wid >> 2, wc = wid & 3, fr = lane & 15, fq = lane >> 4;
    const int K = g.K, nt = K / BK;
    unsigned voffA[2], voffB[2];
#pragma unroll
    for (int i = 0; i < 2; ++i) { int R, C; stage_rc(tid * 16 + i * 8192, R, C); const int Rb = Epi::PERM ? ((R & ~31) + perm32(R & 31)) : R;
        voffA[i] = (unsigned)(R * K + C) * 2u; voffB[i] = (unsigned)(Rb * K + C) * 2u; }
    const size_t kstep = (size_t)(BK * 2);
    const size_t hstep = (size_t)HALF * K * 2;
    const size_t tstep = 2 * hstep;
    const unsigned ldsw = (unsigned)wid * 1024u;
    const int aoff = lds_byte(wr * 64 + fr, fq * 8), boff = lds_byte(wc * 32 + fr, fq * 8);
#define PG8_SA(b, h) (((b) * 2 + (h)) * HTB)
#define PG8_SB(b, h) ((4 + (b) * 2 + (h)) * HTB)
#define PG8_STAGE(bufoff, gbase, voff) do { _Pragma("unroll") for (int _i = 0; _i < 2; ++_i) \
        __builtin_amdgcn_global_load_lds((const unsigned*)((const char*)(gbase) + (voff)[_i]), (PG8_LAS unsigned*)(lds + (bufoff) + ldsw + _i * 8192), 16, 0, 0); } while (0)
#define PG8_LDA(dst, b, h) do { _Pragma("unroll") for (int m = 0; m < 4; ++m) _Pragma("unroll") for (int k = 0; k < 2; ++k) dst[m][k] = *(const PG8_LAS bf16x8*)(lds + PG8_SA(b, h) + aoff + m * 2048 + k * 1024); } while (0)
#define PG8_LDB(dst, b, h) do { _Pragma("unroll") for (int n = 0; n < 2; ++n) _Pragma("unroll") for (int k = 0; k < 2; ++k) dst[n][k] = *(const PG8_LAS bf16x8*)(lds + PG8_SB(b, h) + boff + n * 2048 + k * 1024); } while (0)
#define PG8_MMA(ai, bj, At, Bt) do { __builtin_amdgcn_s_setprio(1); _Pragma("unroll") for (int m = 0; m < 4; ++m) _Pragma("unroll") for (int n = 0; n < 2; ++n) _Pragma("unroll") for (int k = 0; k < 2; ++k) \
        acc[ai][bj][m][n] = __builtin_amdgcn_mfma_f32_16x16x32_bf16(Bt[n][k], At[m][k], acc[ai][bj][m][n], 0, 0, 0); __builtin_amdgcn_s_setprio(0); } while (0)
#define PG8_WAIT_V(n) asm volatile("s_waitcnt vmcnt(" #n ")" ::: "memory")
#define PG8_WAIT_L(n) asm volatile("s_waitcnt lgkmcnt(" #n ")" ::: "memory")
#define PG8_BAR __builtin_amdgcn_s_barrier()
#define PG8_SCHED __builtin_amdgcn_sched_barrier(0)
    Unit cur, nxt; int ui = 0;
    if (!S.next(0, cur)) return;
    f32x4 acc[2][2][4][2];
#pragma unroll
    for (int a = 0; a < 2; ++a)
#pragma unroll
        for (int b = 0; b < 2; ++b)
#pragma unroll
            for (int m = 0; m < 4; ++m)
#pragma unroll
                for (int n = 0; n < 2; ++n) acc[a][b][m][n] = (f32x4){0.f, 0.f, 0.f, 0.f};
    bf16x8 At[4][2], B0[2][2], B1[2][2];
    const char* cA = (const char*)g.A + (size_t)cur.pm * tstep; const char* cB = (const char*)g.Bt + (size_t)cur.pn * tstep;
    S.a_ready(cur);
    if constexpr (SP2) {
        PG8_STAGE(PG8_SB(0, 0), cB, voffB); PG8_STAGE(PG8_SB(0, 1), cB + hstep, voffB); PG8_STAGE(PG8_SA(0, 0), cA, voffA); PG8_STAGE(PG8_SA(0, 1), cA + hstep, voffA);
        if (wr == 1) PG8_BAR;
        PG8_WAIT_V(2); PG8_BAR;
        PG8_STAGE(PG8_SB(1, 0), cB + kstep, voffB); PG8_STAGE(PG8_SA(1, 0), cA + kstep, voffA); PG8_STAGE(PG8_SB(1, 1), cB + hstep + kstep, voffB);
        PG8_WAIT_V(6); PG8_BAR;
    } else {
        PG8_STAGE(PG8_SB(0, 0), cB, voffB); PG8_STAGE(PG8_SA(0, 0), cA, voffA); PG8_STAGE(PG8_SB(0, 1), cB + hstep, voffB); PG8_STAGE(PG8_SA(0, 1), cA + hstep, voffA);
        if (wr == 1) PG8_BAR;
        PG8_WAIT_V(4); PG8_BAR;
        PG8_STAGE(PG8_SB(1, 0), cB + kstep, voffB); PG8_STAGE(PG8_SA(1, 0), cA + kstep, voffA); PG8_STAGE(PG8_SB(1, 1), cB + hstep + kstep, voffB);
        PG8_WAIT_V(6); PG8_BAR;
    }
    for (;;) {
        const bool has_next = S.next(ui + 1, nxt);
        const char* nA = has_next ? (const char*)g.A + (size_t)nxt.pm * tstep : cA; const char* nB = has_next ? (const char*)g.Bt + (size_t)nxt.pn * tstep : cB;
#pragma unroll 1
        for (int t = 0; t < nt; t += 2) {
            const bool last = (t == nt - 2);
            const char* a1 = cA + (size_t)(t + 1) * kstep;
            const char* a2 = last ? nA : cA + (size_t)(t + 2) * kstep; const char* b2 = last ? nB : cB + (size_t)(t + 2) * kstep;
            const char* a3 = a2 + kstep; const char* b3 = b2 + kstep;
            if (last && has_next) S.a_ready(nxt);
            if constexpr (SP2) {
            PG8_LDB(B0, 0, 0); PG8_LDB(B1, 0, 1); PG8_SCHED; PG8_LDA(At, 0, 0); PG8_STAGE(PG8_SA(1, 1), a1 + hstep, voffA);
            PG8_WAIT_V(8); PG8_WAIT_L(0); PG8_BAR; PG8_MMA(0, 0, At, B0); PG8_MMA(0, 1, At, B1); PG8_BAR; PG8_SCHED;
            PG8_LDA(At, 0, 1); PG8_STAGE(PG8_SB(0, 0), b2, voffB); PG8_STAGE(PG8_SB(0, 1), b2 + hstep, voffB); PG8_STAGE(PG8_SA(0, 0), a2, voffA);
            PG8_WAIT_V(8); PG8_WAIT_L(0); PG8_BAR; PG8_MMA(1, 0, At, B0); PG8_MMA(1, 1, At, B1); PG8_BAR; PG8_SCHED;
            PG8_LDB(B0, 1, 0); PG8_LDB(B1, 1, 1); PG8_SCHED; PG8_LDA(At, 1, 0); PG8_STAGE(PG8_SA(0, 1), a2 + hstep, voffA);
            PG8_WAIT_V(8); PG8_WAIT_L(0); PG8_BAR; PG8_MMA(0, 0, At, B0); PG8_MMA(0, 1, At, B1); PG8_BAR; PG8_SCHED;
            PG8_LDA(At, 1, 1); PG8_STAGE(PG8_SB(1, 0), b3, voffB); PG8_STAGE(PG8_SB(1, 1), b3 + hstep, voffB); PG8_STAGE(PG8_SA(1, 0), a3, voffA);
            PG8_WAIT_V(8); PG8_WAIT_L(0); PG8_BAR; PG8_MMA(1, 0, At, B0); PG8_MMA(1, 1, At, B1); PG8_BAR; PG8_SCHED;
            } else {
            PG8_LDB(B0, 0, 0); PG8_SCHED; PG8_LDA(At, 0, 0); PG8_STAGE(PG8_SA(1, 1), a1 + hstep, voffA);
            PG8_WAIT_L(8); PG8_BAR; PG8_WAIT_L(0); PG8_MMA(0, 0, At, B0); PG8_BAR; PG8_SCHED;
            PG8_LDB(B1, 0, 1); PG8_STAGE(PG8_SB(0, 0), b2, voffB);
            PG8_BAR; PG8_WAIT_L(0); PG8_MMA(0, 1, At, B1); PG8_BAR;
            PG8_LDA(At, 0, 1); PG8_STAGE(PG8_SA(0, 0), a2, voffA);
            PG8_BAR; PG8_WAIT_L(0); PG8_MMA(1, 0, At, B0); PG8_BAR; PG8_SCHED;
            PG8_STAGE(PG8_SB(0, 1), b2 + hstep, voffB);
            PG8_WAIT_V(6); PG8_BAR; PG8_MMA(1, 1, At, B1); PG8_BAR;
            PG8_LDB(B0, 1, 0); PG8_SCHED; PG8_LDA(At, 1, 0); PG8_STAGE(PG8_SA(0, 1), a2 + hstep, voffA);
            PG8_WAIT_L(8); PG8_BAR; PG8_WAIT_L(0); PG8_MMA(0, 0, At, B0); PG8_BAR; PG8_SCHED;
            PG8_LDB(B1, 1, 1); PG8_STAGE(PG8_SB(1, 0), b3, voffB);
            PG8_BAR; PG8_WAIT_L(0); PG8_MMA(0, 1, At, B1); PG8_BAR;
            PG8_LDA(At, 1, 1); PG8_STAGE(PG8_SA(1, 0), a3, voffA);
            PG8_BAR; PG8_WAIT_L(0); PG8_MMA(1, 0, At, B0); PG8_BAR; PG8_SCHED;
            PG8_STAGE(PG8_SB(1, 1), b3 + hstep, voffB);
            PG8_WAIT_V(6); PG8_BAR; PG8_MMA(1, 1, At, B1); PG8_BAR;
            }
        }
        if constexpr (ALIGN_EPI) { if (wr == 0) PG8_BAR; }
        if constexpr (!Epi::AFTER_DRAIN) { E(acc, cur, wr, wc, fr, fq); S.done(cur); }
        if (!has_next) break;
#pragma unroll
        for (int a = 0; a < 2; ++a)
#pragma unroll
            for (int b = 0; b < 2; ++b)
#pragma unroll
                for (int m = 0; m < 4; ++m)
#pragma unroll
                    for (int n = 0; n < 2; ++n) acc[a][b][m][n] = (f32x4){0.f, 0.f, 0.f, 0.f};
        cur = nxt; cA = nA; cB = nB; ++ui;
        if constexpr (ALIGN_EPI) { if (wr == 1) PG8_BAR; }
    }
    PG8_WAIT_V(0);
    if constexpr (!ALIGN_EPI) { if (wr == 0) PG8_BAR; }
    PG8_BAR;
    if constexpr (Epi::AFTER_DRAIN) { E.fused(acc, cur, wr, wc, fr, fq, lds, wid, lane); S.done(cur); }
#undef PG8_SA
#undef PG8_SB
#undef PG8_STAGE
#undef PG8_LDA
#undef PG8_LDB
#undef PG8_MMA
#undef PG8_WAIT_V
#undef PG8_WAIT_L
#undef PG8_BAR
#undef PG8_SCHED
}
}

namespace att {
using bf16x8 = __attribute__((ext_vector_type(8))) short;
using s16x4  = __attribute__((ext_vector_type(4))) short;
using f32x16 = __attribute__((ext_vector_type(16))) float;
using u32x4  = __attribute__((ext_vector_type(4))) unsigned;
typedef unsigned short bf16_t;
constexpr int NW = 8, QBLK = 32, KVBLK = 64;
constexpr int LDQ = LDQ_, LDKN = LDKV_, LDKR = DROPE, LDV = LDKV_, LDO = DM;
constexpr int SHM_V = 16384, SHM_KN = 16384, SHM_KR = 8192;
constexpr int OFF_V = 0, OFF_KN = 2 * SHM_V, OFF_KR = OFF_KN + 2 * SHM_KN, OFF_WS = OFF_KR + 2 * SHM_KR, ATTN_LDS = OFF_WS + NW * 64 * 4;
constexpr float THRL = 11.5f;
#define KSWZ(row, colB) ((row) * 256 + ((colB) ^ (((row) & 15) << 4)))
#define KRSWZ(row, colB) ((row) * 128 + ((colB) ^ ((((row) >> 1) & 7) << 4)))
#define SBAR() __builtin_amdgcn_sched_barrier(0)
__device__ __forceinline__ int crow(int r, int hi) { return (r & 3) + 8 * (r >> 2) + 4 * hi; }
__device__ __forceinline__ unsigned cvtpk(float lo, float hi) { unsigned r; asm volatile("v_cvt_pk_bf16_f32 %0, %1, %2" : "=v"(r) : "v"(lo), "v"(hi)); return r; }

__device__ __forceinline__ void partialSM(f32x16& p0, f32x16& p1, float& m_reg, float& mn, float& alpha) {
  float pmax = p0[0];
#pragma unroll
  for (int r = 1; r < 16; ++r) pmax = fmaxf(pmax, p0[r]);
#pragma unroll
  for (int r = 0; r < 16; ++r) pmax = fmaxf(pmax, p1[r]);
  { auto rr = __builtin_amdgcn_permlane32_swap(__float_as_uint(pmax), __float_as_uint(pmax), false, false);
    pmax = fmaxf(__uint_as_float(rr[0]), __uint_as_float(rr[1])); }
  if (__builtin_expect(__all(pmax - m_reg <= THRL), 1)) { mn = m_reg; alpha = 1.f; }
  else { mn = fmaxf(m_reg, pmax); alpha = __builtin_amdgcn_exp2f(m_reg - mn); m_reg = mn; }
#pragma unroll
  for (int r = 0; r < 16; ++r) p0[r] = p0[r] - mn;
#pragma unroll
  for (int r = 0; r < 16; ++r) p1[r] = p1[r] - mn;
#pragma unroll
  for (int r = 0; r < 16; ++r) p0[r] = __builtin_amdgcn_exp2f(p0[r]);
}
__device__ __forceinline__ void finishSM(f32x16& p0, f32x16& p1, float alpha, float& l_reg, bf16x8& pa0, bf16x8& pa1, bf16x8& pa2, bf16x8& pa3) {
#pragma unroll
  for (int r = 0; r < 16; ++r) p1[r] = __builtin_amdgcn_exp2f(p1[r]);
  float ps = 0;
#pragma unroll
  for (int r = 0; r < 16; ++r) ps += p0[r];
#pragma unroll
  for (int r = 0; r < 16; ++r) ps += p1[r];
  { auto rr = __builtin_amdgcn_permlane32_swap(__float_as_uint(ps), __float_as_uint(ps), false, false);
    ps = __uint_as_float(rr[0]) + __uint_as_float(rr[1]); }
  l_reg = l_reg * alpha + ps;
#define PK4(P, BASE, OUT) do { unsigned a0 = cvtpk(P[BASE + 0], P[BASE + 1]), a1 = cvtpk(P[BASE + 2], P[BASE + 3]);   \
    unsigned b0 = cvtpk(P[BASE + 4], P[BASE + 5]), b1 = cvtpk(P[BASE + 6], P[BASE + 7]);                              \
    auto r0 = __builtin_amdgcn_permlane32_swap(a0, b0, false, false); auto r1 = __builtin_amdgcn_permlane32_swap(a1, b1, false, false); \
    u32x4 w = {r0[0], r1[0], r0[1], r1[1]}; OUT = *reinterpret_cast<bf16x8*>(&w); } while (0)
  PK4(p0, 0, pa0); PK4(p0, 8, pa1); PK4(p1, 0, pa2); PK4(p1, 8, pa3);
#undef PK4
}
__device__ __forceinline__ void qkt(f32x16& p0, f32x16& p1, const char* Kn, const char* Kr, const bf16x8* qr, int r32, int hi) {
  p0 = f32x16{}; p1 = f32x16{};
#define KFRAG(dst, d0) do { const int cb_ = (((d0) & 7) * 16 + hi * 8) * 2; \
    if ((d0) < 8) { dst[0] = *reinterpret_cast<const bf16x8*>(Kn + KSWZ(r32, cb_)); dst[1] = *reinterpret_cast<const bf16x8*>(Kn + KSWZ(32 + r32, cb_)); } \
    else { dst[0] = *reinterpret_cast<const bf16x8*>(Kr + KRSWZ(r32, cb_)); dst[1] = *reinterpret_cast<const bf16x8*>(Kr + KRSWZ(32 + r32, cb_)); } } while (0)
#define KMMA(src, d0) do { p0 = __builtin_amdgcn_mfma_f32_32x32x16_bf16(src[0], qr[d0], p0, 0, 0, 0); p1 = __builtin_amdgcn_mfma_f32_32x32x16_bf16(src[1], qr[d0], p1, 0, 0, 0); } while (0)
  bf16x8 fa[2], fb[2], fc[2];
  KFRAG(fa, 0); KFRAG(fb, 1); SBAR();
  KFRAG(fc, 2); SBAR(); KMMA(fa, 0); SBAR();
  KFRAG(fa, 3); SBAR(); KMMA(fb, 1); SBAR();
  KFRAG(fb, 4); SBAR(); KMMA(fc, 2); SBAR();
  KFRAG(fc, 5); SBAR(); KMMA(fa, 3); SBAR();
  KFRAG(fa, 6); SBAR(); KMMA(fb, 4); SBAR();
  KFRAG(fb, 7); SBAR(); KMMA(fc, 5); SBAR();
  KFRAG(fc, 8); SBAR(); KMMA(fa, 6); SBAR();
  KFRAG(fa, 9); SBAR(); KMMA(fb, 7); SBAR();
  KFRAG(fb, 10); SBAR(); KMMA(fc, 8); SBAR();
  KFRAG(fc, 11); SBAR(); KMMA(fa, 9); SBAR();
  KMMA(fb, 10); KMMA(fc, 11);
#undef KFRAG
#undef KMMA
}
__device__ __forceinline__ int v_st(int k, int c) { const int kk = (k & ~0xC) | ((k & 4) << 1) | ((k & 8) >> 1); return ((kk >> 3) * 4 + (c >> 5)) * 512 + ((kk & 7) * 32 + (c & 31)) * 2; }
__device__ __forceinline__ int v_rd_base(int lane) { return ((lane & 3) << 3) | (((lane >> 2) & 3) << 6) | (((lane >> 4) & 1) << 5) | (((lane >> 5) & 1) << 8); }
constexpr int v_rd_off(int d0, int ks, int half) { return d0 * 512 + ks * 4096 + half * 2048; }
template <int OFF> __device__ __forceinline__ s16x4 tr_read(int vb) {
  s16x4 r; asm volatile("ds_read_b64_tr_b16 %0, %1 offset:%2" : "=&v"(r) : "v"(vb), "i"(OFF) : "memory"); return r;
}
template <int D0> __device__ __forceinline__ void pv_one(f32x16& od, int vb, bf16x8 pa0, bf16x8 pa1, bf16x8 pa2, bf16x8 pa3) {
  const s16x4 l0 = tr_read<v_rd_off(D0, 0, 0)>(vb), h0 = tr_read<v_rd_off(D0, 0, 1)>(vb), l1 = tr_read<v_rd_off(D0, 1, 0)>(vb), h1 = tr_read<v_rd_off(D0, 1, 1)>(vb);
  const s16x4 l2 = tr_read<v_rd_off(D0, 2, 0)>(vb), h2 = tr_read<v_rd_off(D0, 2, 1)>(vb), l3 = tr_read<v_rd_off(D0, 3, 0)>(vb), h3 = tr_read<v_rd_off(D0, 3, 1)>(vb);
  asm volatile("s_waitcnt lgkmcnt(0)" ::: "memory"); SBAR();
#define PK(L, H) (bf16x8){L[0], L[1], L[2], L[3], H[0], H[1], H[2], H[3]}
  od = __builtin_amdgcn_mfma_f32_32x32x16_bf16(pa0, PK(l0, h0), od, 0, 0, 0);
  od = __builtin_amdgcn_mfma_f32_32x32x16_bf16(pa1, PK(l1, h1), od, 0, 0, 0);
  od = __builtin_amdgcn_mfma_f32_32x32x16_bf16(pa2, PK(l2, h2), od, 0, 0, 0);
  od = __builtin_amdgcn_mfma_f32_32x32x16_bf16(pa3, PK(l3, h3), od, 0, 0, 0);
#undef PK
}
__device__ __forceinline__ void pv_d0(f32x16* o, int vb, bf16x8 pa0, bf16x8 pa1, bf16x8 pa2, bf16x8 pa3) {
  pv_one<0>(o[0], vb, pa0, pa1, pa2, pa3); pv_one<1>(o[1], vb, pa0, pa1, pa2, pa3); pv_one<2>(o[2], vb, pa0, pa1, pa2, pa3); pv_one<3>(o[3], vb, pa0, pa1, pa2, pa3);
}

__device__ __forceinline__ void sm_half(f32x16& p, float& m_reg, float& l_reg, float& alpha, bf16x8& paL, bf16x8& paH) {
  float a = fmaxf(fmaxf(p[0], p[1]), p[2]), b = fmaxf(fmaxf(p[3], p[4]), p[5]);
  a = fmaxf(fmaxf(a, p[6]), p[7]); b = fmaxf(fmaxf(b, p[8]), p[9]); a = fmaxf(fmaxf(a, p[10]), p[11]); b = fmaxf(fmaxf(b, p[12]), p[13]); a = fmaxf(fmaxf(a, p[14]), p[15]);
  float pmax = fmaxf(a, b);
  { auto rr = __builtin_amdgcn_permlane32_swap(__float_as_uint(pmax), __float_as_uint(pmax), false, false);
    pmax = fmaxf(__uint_as_float(rr[0]), __uint_as_float(rr[1])); }
  const bool keep = __all(pmax - m_reg <= THRL);
  const float mn = keep ? m_reg : fmaxf(m_reg, pmax);
  alpha = __builtin_amdgcn_exp2f(m_reg - mn); m_reg = mn;
#pragma unroll
  for (int r = 0; r < 16; ++r) p[r] = __builtin_amdgcn_exp2f(p[r] - mn);
  float ps = 0;
#pragma unroll
  for (int r = 0; r < 16; ++r) ps += p[r];
  { auto rr = __builtin_amdgcn_permlane32_swap(__float_as_uint(ps), __float_as_uint(ps), false, false);
    ps = __uint_as_float(rr[0]) + __uint_as_float(rr[1]); }
  l_reg = l_reg * alpha + ps;
#define PK4(P, BASE, OUT) do { unsigned a0 = cvtpk(P[BASE + 0], P[BASE + 1]), a1 = cvtpk(P[BASE + 2], P[BASE + 3]);   \
    unsigned b0 = cvtpk(P[BASE + 4], P[BASE + 5]), b1 = cvtpk(P[BASE + 6], P[BASE + 7]);                              \
    auto r0 = __builtin_amdgcn_permlane32_swap(a0, b0, false, false); auto r1 = __builtin_amdgcn_permlane32_swap(a1, b1, false, false); \
    u32x4 w = {r0[0], r1[0], r0[1], r1[1]}; OUT = *reinterpret_cast<bf16x8*>(&w); } while (0)
  PK4(p, 0, paL); PK4(p, 8, paH);
#undef PK4
}
template <int H> __device__ __forceinline__ void qkt_half(f32x16& p, const char* Kn, const char* Kr, const bf16x8* qr, int r32, int hi) {
  p = f32x16{};
#pragma unroll
  for (int d0 = 0; d0 < 8; ++d0) { const int cb = (d0 * 16 + hi * 8) * 2;
    const bf16x8 f = *reinterpret_cast<const bf16x8*>(Kn + KSWZ(32 * H + r32, cb)); p = __builtin_amdgcn_mfma_f32_32x32x16_bf16(f, qr[d0], p, 0, 0, 0); }
#pragma unroll
  for (int d0 = 0; d0 < 4; ++d0) { const int cb = (d0 * 16 + hi * 8) * 2;
    const bf16x8 f = *reinterpret_cast<const bf16x8*>(Kr + KRSWZ(32 * H + r32, cb)); p = __builtin_amdgcn_mfma_f32_32x32x16_bf16(f, qr[8 + d0], p, 0, 0, 0); }
}
struct VFrag { s16x4 l0, h0, l1, h1; };
template <int H, int D0> __device__ __forceinline__ VFrag pv_rd(int vb) {
  VFrag f; f.l0 = tr_read<v_rd_off(D0, 2 * H, 0)>(vb); f.h0 = tr_read<v_rd_off(D0, 2 * H, 1)>(vb); f.l1 = tr_read<v_rd_off(D0, 2 * H + 1, 0)>(vb); f.h1 = tr_read<v_rd_off(D0, 2 * H + 1, 1)>(vb); return f;
}
__device__ __forceinline__ void pv_mma(f32x16& od, VFrag& f, bf16x8 paL, bf16x8 paH) {
#define PK(L, Hh) (bf16x8){L[0], L[1], L[2], L[3], Hh[0], Hh[1], Hh[2], Hh[3]}
  od = __builtin_amdgcn_mfma_f32_32x32x16_bf16(paL, PK(f.l0, f.h0), od, 0, 0, 0);
  od = __builtin_amdgcn_mfma_f32_32x32x16_bf16(paH, PK(f.l1, f.h1), od, 0, 0, 0);
#undef PK
}
#define VWAIT(N, f) asm volatile("s_waitcnt lgkmcnt(" #N ")" : "+v"(f.l0), "+v"(f.h0), "+v"(f.l1), "+v"(f.h1) :: "memory")
template <int H> __device__ __forceinline__ void pv_half(f32x16* o, int vb, bf16x8 paL, bf16x8 paH) {
  VFrag fa = pv_rd<H, 0>(vb), fb = pv_rd<H, 1>(vb);
  VWAIT(4, fa); pv_mma(o[0], fa, paL, paH);
  fa = pv_rd<H, 2>(vb);
  VWAIT(4, fb); pv_mma(o[1], fb, paL, paH);
  fb = pv_rd<H, 3>(vb);
  VWAIT(4, fa); pv_mma(o[2], fa, paL, paH);
  VWAIT(0, fb); pv_mma(o[3], fb, paL, paH);
}
#undef VWAIT

__device__ __forceinline__ void attn_unit(const bf16_t* __restrict__ Qb, const bf16_t* __restrict__ KNh, const bf16_t* __restrict__ KRs, const bf16_t* __restrict__ Vh,
                                          bf16_t* __restrict__ Ob, float* __restrict__ ssa, int seq, char* lds) {
  const int tid = threadIdx.x, wid = __builtin_amdgcn_readfirstlane(tid >> 6), lane = tid & 63, r32 = lane & 31, hi = lane >> 5;
  char* V_lds = lds + OFF_V; char* KN_lds = lds + OFF_KN; char* KR_lds = lds + OFF_KR;
  float* ws = (float*)(lds + OFF_WS) + wid * 64; float* li_l = ws; float* al_l = ws + 32;
  float m_reg = -1e30f, l_reg = 0; f32x16 o[4] = {}; bf16x8 qr[12];
  const bf16_t* Qw = Qb + (long)(wid * QBLK + r32) * LDQ + hi * 8;
#pragma unroll
  for (int d0 = 0; d0 < 12; ++d0) qr[d0] = *reinterpret_cast<const bf16x8*>(Qw + d0 * 16);
  const int vb0 = (int)(uintptr_t)V_lds + v_rd_base(lane);
  unsigned kn_off[2], v_off[2], kr_off;
#pragma unroll
  for (int i = 0; i < 2; ++i) {
    const int q = (wid * 2 + i) * 64 + lane;
    { const int row = q >> 4, c = (q & 15) ^ (row & 15); kn_off[i] = (unsigned)(row * LDKN * 2 + c * 16); }
    { const int sub = q >> 5, kk = (sub >> 2) * 8 + ((q & 31) >> 2), cc = (sub & 3) * 32 + (q & 3) * 8, k = (kk & ~0xC) | ((kk & 4) << 1) | ((kk & 8) >> 1);
      v_off[i] = (unsigned)(k * LDV * 2 + cc * 2); }
  }
  { const int q = wid * 64 + lane, row = q >> 3, c = (q & 7) ^ ((row >> 1) & 7); kr_off = (unsigned)(row * LDKR * 2 + c * 16); }
  typedef __attribute__((address_space(3))) unsigned lds_u32;
#define GLDS(gp, lp) __builtin_amdgcn_global_load_lds((const unsigned*)(gp), (lds_u32*)(lp), 16, 0, 0)
#define DMA_KN(k0, s) do { const char* kb_ = (const char*)KNh + (size_t)(k0) * (LDKN * 2); \
    GLDS(kb_ + kn_off[0], KN_lds + (s) * SHM_KN + (wid * 2) * 1024); GLDS(kb_ + kn_off[1], KN_lds + (s) * SHM_KN + (wid * 2 + 1) * 1024); } while (0)
#define DMA_KR(k0, s) do { const char* rb_ = (const char*)KRs + (size_t)(k0) * (LDKR * 2); GLDS(rb_ + kr_off, KR_lds + (s) * SHM_KR + wid * 1024); } while (0)
#define DMA_K(k0, s) do { DMA_KN(k0, s); DMA_KR(k0, s); } while (0)
#define DMA_V(k0, off) do { const char* vb_ = (const char*)Vh + (size_t)(k0) * (LDV * 2); \
    GLDS(vb_ + v_off[0], V_lds + (off) + (wid * 2) * 1024); GLDS(vb_ + v_off[1], V_lds + (off) + (wid * 2 + 1) * 1024); } while (0)
#define RESC(a) do { if (__any((a) < 1.f)) { if (hi == 0) al_l[r32] = (a); asm volatile("s_waitcnt lgkmcnt(0)" ::: "memory"); \
    _Pragma("unroll") for (int d = 0; d < 4; ++d) _Pragma("unroll") for (int r = 0; r < 16; ++r) o[d][r] *= al_l[crow(r, hi)]; } } while (0)
  f32x16 p0, p1; float al0, al1; bf16x8 pa0, pa1, pa2, pa3; const int NT = seq / KVBLK;
#define STEP(b, j) do { \
    if ((j) + 1 < NT) { DMA_KN(((j) + 1) * KVBLK, (b) ^ 1); } SBAR(); \
    qkt_half<0>(p0, KN_lds + (b) * SHM_KN, KR_lds + (b) * SHM_KR, qr, r32, hi); SBAR(); \
    qkt_half<1>(p1, KN_lds + (b) * SHM_KN, KR_lds + (b) * SHM_KR, qr, r32, hi); sm_half(p0, m_reg, l_reg, al0, pa0, pa1); SBAR(); \
    RESC(al0); SBAR(); \
    if ((j) + 1 < NT) { DMA_KR(((j) + 1) * KVBLK, (b) ^ 1); DMA_V(((j) + 1) * KVBLK, ((b) ^ 1) * SHM_V); } SBAR();     \
    pv_half<0>(o, vb0 + (b) * SHM_V, pa0, pa1); sm_half(p1, m_reg, l_reg, al1, pa2, pa3); SBAR(); \
    RESC(al1); SBAR(); \
    pv_half<1>(o, vb0 + (b) * SHM_V, pa2, pa3); \
    asm volatile("s_waitcnt vmcnt(0)" ::: "memory"); __syncthreads(); } while (0)
  DMA_K(0, 0); DMA_V(0, 0);
  asm volatile("s_waitcnt vmcnt(0)" ::: "memory"); __syncthreads();
#pragma unroll 1
  for (int j = 0; j < NT; j += 2) { STEP(0, j); STEP(1, j + 1); }
#undef STEP
  if (hi == 0) li_l[r32] = l_reg; asm volatile("s_waitcnt lgkmcnt(0)" ::: "memory");
  int zo = 0; asm volatile("" : "+v"(zo));
  bf16_t* Ow = Ob + (long)(wid * QBLK) * LDO; float* ssw = ssa + wid * QBLK;
#pragma unroll
  for (int r = 0; r < 16; ++r) { const int orow = crow(r, hi) + zo; const float rl = __builtin_amdgcn_rcpf(li_l[orow]); float s = 0.f;
#pragma unroll
    for (int d0 = 0; d0 < 4; ++d0) { const float v = o[d0][r] * rl; s += v * v; Ow[(long)orow * LDO + d0 * 32 + r32] = (bf16_t)(cvtpk(v, v) & 0xffffu); }
    s += __shfl_xor(s, 1); s += __shfl_xor(s, 2); s += __shfl_xor(s, 4); s += __shfl_xor(s, 8); s += __shfl_xor(s, 16);
    if (r32 == 0) atomicAdd(ssw + orow, s); }
  __syncthreads();
#undef GLDS
#undef DMA_K
#undef DMA_KN
#undef DMA_KR
#undef DMA_V
#undef RESC
}
#undef KSWZ
#undef KRSWZ
#undef SBAR
}

constexpr int NWAVES = 8, NTHREADS = 512;
constexpr size_t MiB = 1u << 20;
constexpr size_t WS_SS = 0;
constexpr size_t WS_MOD = 2 * MiB;
constexpr size_t WS_ROPE = 3 * MiB;
constexpr size_t WS_WIN = 7 * MiB, WS_WUQ = 9 * MiB, WS_WUKV = 10 * MiB, WS_WOUT = 11 * MiB, WS_WGU = 13 * MiB, WS_WD = 24 * MiB;
constexpr size_t WS_HB = 32 * MiB;
constexpr size_t WS_U = 192 * MiB, WS_CQ = 232 * MiB, WS_CKV = 292 * MiB, WS_KR = 332 * MiB;
constexpr size_t WS_Q = 342 * MiB, WS_KN = 522 * MiB, WS_V = 642 * MiB, WS_MX = 762 * MiB, WS_END = 922 * MiB;
constexpr size_t WS_MG = WS_Q;
constexpr size_t WS_ACT = WS_U;
constexpr size_t WS_F = WS_V;
static_assert(WS_ACT + (size_t)TT * DFF * 2 <= WS_F && WS_F + (size_t)TT * DM * 2 <= WS_END && WS_WD + (size_t)DM * DFF * 2 <= WS_HB, "d_ws map");
constexpr int LDS_BYTES = 147456;
constexpr int MISC_OFF = 131072 + 320;
constexpr size_t WS_BAR = 1835008;

#define LAS __attribute__((address_space(3)))
typedef unsigned short bf16;
typedef float f32x4 __attribute__((ext_vector_type(4)));
typedef unsigned v4u __attribute__((ext_vector_type(4)));
typedef unsigned v2u __attribute__((ext_vector_type(2)));
__device__ __forceinline__ unsigned pkbf(float lo, float hi) { unsigned r; asm volatile("v_cvt_pk_bf16_f32 %0, %1, %2" : "=v"(r) : "v"(lo), "v"(hi)); return r; }
__device__ __forceinline__ float bf2f(unsigned short b) { return __uint_as_float((unsigned)b << 16); }
__device__ __forceinline__ float wave_sum(float v) {
#pragma unroll
    for (int o = 1; o < 64; o <<= 1) v += __shfl_xor(v, o);
    return v;
}

struct Params { const float* in[23]; float* out; unsigned char* ws; int ph_lo, ph_hi; };
enum { I_XP = 0, I_XS, I_CP, I_CS, I_WADA, I_BADA, I_GMIXPRE, I_GMIXPOST, I_WIN, I_POOLW, I_POOLSCALE, I_GQA, I_WUQ, I_GKVA, I_WUKV, I_GPOOLOUT, I_GATTNOUT, I_WOUT, I_GFFNPRE, I_GFFNPOST, I_WGATE, I_WUP, I_WDOWN };

struct WSrc { const float* p; int col; };
__device__ __forceinline__ WSrc wmap(const Params& a, int mat, int n) {
    if (mat == 0) {
        if (n >= 960) return {nullptr, 0};
        if (n < 896) return {a.in[I_WIN], n};
        const int pp = n - 896, ch = pp >> 5, w = pp & 31, nn = (w >> 2) & 1, i = 16 * ch + 4 * (w >> 3) + (w & 3); return {a.in[I_WIN], 896 + i + 32 * nn};
    } else if (mat == 1) {
        const int cc = n >> 5, w = n & 31; if (cc >= 36) return {nullptr, 0};
        const int h = cc / 6, j6 = cc - 6 * h;
        if (j6 < 4) return {a.in[I_WUQ], h * DQK + 32 * j6 + w};
        const int nn = (w >> 2) & 1, i = 16 * (j6 - 4) + 4 * (w >> 3) + (w & 3); return {a.in[I_WUQ], h * DQK + DNOPE + i + 32 * nn};
    } else if (mat == 2) return {a.in[I_WUKV], n};
    else if (mat == 3) return {a.in[I_WOUT], n};
    else if (mat == 4) { const int cc = n >> 5, w = n & 31, nn = w >> 4; return {nn ? a.in[I_WUP] : a.in[I_WGATE], 16 * cc + (w & 15)}; }
    return {a.in[I_WDOWN], n};
}
__device__ __forceinline__ float wgain(const Params& a, int mat, int k) {
    if (mat == 1) return a.in[I_GQA][k];
    if (mat == 2) return a.in[I_GKVA][k];
    if (mat == 3) return k < POOLW ? a.in[I_GPOOLOUT][k] : a.in[I_GATTNOUT][k - POOLW];
    return 1.0f;
}
__device__ __forceinline__ void p0_transpose_item(const Params& a, int mat, int K, int Nsrc, int Ndst, bf16* WT, LAS float* scr, int item, int lane) {
    const int nblk = Ndst / 32, kb = item / nblk, nb = item % nblk, k0 = 64 * kb, n0 = 32 * nb;
    const WSrc s = wmap(a, mat, n0 + (lane & 31));
#pragma unroll 8
    for (int i = 0; i < 32; ++i) { const int kk = 2 * i + (lane >> 5); scr[kk * 33 + (lane & 31)] = s.p ? s.p[(size_t)(k0 + kk) * Nsrc + s.col] * wgain(a, mat, k0 + kk) : 0.f; }
    asm volatile("s_waitcnt lgkmcnt(0)" ::: "memory");
    const int c = lane & 7;
#pragma unroll
    for (int j = 0; j < 4; ++j) { const int n = (lane >> 3) + 8 * j; const LAS float* sp = scr + (8 * c) * 33 + n;
        v4u o; o.x = pkbf(sp[0 * 33], sp[1 * 33]); o.y = pkbf(sp[2 * 33], sp[3 * 33]); o.z = pkbf(sp[4 * 33], sp[5 * 33]); o.w = pkbf(sp[6 * 33], sp[7 * 33]);
        *(v4u*)(WT + (size_t)(n0 + n) * K + k0 + 8 * c) = o; }
    asm volatile("s_waitcnt lgkmcnt(0)" ::: "memory");
}
__constant__ double INV_FREQ[32] = {1.0, 0.7498942093324559, 0.5623413251903491, 0.4216965034285822, 0.31622776601683794, 0.23713737056616552, 0.1778279410038923, 0.1333521432163324,
    0.1, 0.07498942093324558, 0.05623413251903491, 0.042169650342858224, 0.03162277660168379, 0.023713737056616554, 0.01778279410038923, 0.01333521432163324,
    0.01, 0.007498942093324558, 0.005623413251903491, 0.004216965034285823, 0.0031622776601683794, 0.0023713737056616554, 0.0017782794100389228, 0.001333521432163324,
    0.001, 0.0007498942093324559, 0.0005623413251903491, 0.00042169650342858224, 0.00031622776601683794, 0.00023713737056616554, 0.00017782794100389227, 0.0001333521432163324};
__device__ __forceinline__ void rope_entry(float* dst, int s, int i) {
    const double ang = (double)s * INV_FREQ[i];
    const double q = __builtin_rint(ang * 0.6366197723675814);
    double r = __builtin_fma(-q, 1.5707963267948966, ang); r = __builtin_fma(-q, 6.123233995736766e-17, r);
    const double r2 = r * r;
    const double sn = r * (1.0 + r2 * (-1.0 / 6 + r2 * (1.0 / 120 + r2 * (-1.0 / 5040 + r2 * (1.0 / 362880 + r2 * (-1.0 / 39916800 + r2 * (1.0 / 6227020800.0)))))));
    const double cn = 1.0 + r2 * (-0.5 + r2 * (1.0 / 24 + r2 * (-1.0 / 720 + r2 * (1.0 / 40320 + r2 * (-1.0 / 3628800 + r2 * (1.0 / 479001600 + r2 * (-1.0 / 87178291200.0)))))));
    const int qi = (int)((long long)q & 3);
    const double c = (qi == 0) ? cn : (qi == 1) ? -sn : (qi == 2) ? -cn : sn;
    const double sv = (qi == 0) ? sn : (qi == 1) ? cn : (qi == 2) ? -sn : -cn;
    dst[0] = (float)c; dst[1] = (float)sv;
}
__device__ __forceinline__ void p0a_prologue(const Params& a, LAS unsigned char* lds) {
    const int tid = threadIdx.x, lane = tid & 63, wave = __builtin_amdgcn_readfirstlane(tid >> 6);
    unsigned char* ws = a.ws;
    const int G = gridDim.x, gw = blockIdx.x * NWAVES + wave, NGW = G * NWAVES, gt = blockIdx.x * NTHREADS + tid, NGT = G * NTHREADS;
    { f32x4* z = (f32x4*)(ws + WS_SS); for (int i = gt; i < 5 * TT / 4; i += NGT) z[i] = (f32x4){0.f, 0.f, 0.f, 0.f}; }
    { float* rt = (float*)(ws + WS_ROPE); for (int i = gt; i < SEQ_S * 32; i += NGT) rope_entry(rt + 2 * (size_t)i, i >> 5, i & 31); }
    {
        LAS float* scr = (LAS float*)(lds + wave * 16384);
        constexpr int I0 = 16 * 32, I1 = 6 * 40, I2 = 4 * 48, I3 = 16 * 32, I4 = 16 * 176, I5 = 44 * 32;
        constexpr int NITEMS = I0 + I1 + I2 + I3 + I4 + I5;
        for (int it = gw; it < NITEMS; it += NGW) {
            int r = it;
            if (r < I0) { p0_transpose_item(a, 0, DM, 960, 1024, (bf16*)(ws + WS_WIN), scr, r, lane); continue; } r -= I0;
            if (r < I1) { p0_transpose_item(a, 1, QLR, LDQ_, 1280, (bf16*)(ws + WS_WUQ), scr, r, lane); continue; } r -= I1;
            if (r < I2) { p0_transpose_item(a, 2, KVLR, 1536, 1536, (bf16*)(ws + WS_WUKV), scr, r, lane); continue; } r -= I2;
            if (r < I3) { p0_transpose_item(a, 3, DM, DM, DM, (bf16*)(ws + WS_WOUT), scr, r, lane); continue; } r -= I3;
            if (r < I4) { p0_transpose_item(a, 4, DM, DFF, 2 * DFF, (bf16*)(ws + WS_WGU), scr, r, lane); continue; } r -= I4;
            p0_transpose_item(a, 5, DFF, DM, DM, (bf16*)(ws + WS_WD), scr, r, lane);
        }
    }
    __syncthreads();
    for (int bb = blockIdx.x; bb < 96; bb += G) {
        float accb[NBATCH];
#pragma unroll
        for (int b = 0; b < NBATCH; ++b) accb[b] = 0.f;
        const float* wa = a.in[I_WADA] + bb * 64 + lane;
        for (int k0 = wave * 128; k0 < wave * 128 + 128; k0 += 16) {
            float w[16];
#pragma unroll
            for (int kk = 0; kk < 16; ++kk) w[kk] = wa[(size_t)(k0 + kk) * 6144];
#pragma unroll
            for (int kk = 0; kk < 16; ++kk) {
#pragma unroll
                for (int b = 0; b < NBATCH; ++b) { const float c = (b < 8) ? a.in[I_CP][b * DM + k0 + kk] : a.in[I_CS][k0 + kk]; accb[b] += (c / (1.0f + __expf(-c))) * w[kk]; } }
        }
        LAS float* red = (LAS float*)lds;
#pragma unroll
        for (int b = 0; b < NBATCH; ++b) red[(wave * NBATCH + b) * 64 + lane] = accb[b];
        __syncthreads();
        for (int idx = tid; idx < NBATCH * 64; idx += NTHREADS) { const int b = idx >> 6, l = idx & 63; float s = a.in[I_BADA][bb * 64 + l];
#pragma unroll
            for (int w = 0; w < 8; ++w) s += red[(w * NBATCH + b) * 64 + l];
            ((float*)(ws + WS_MOD))[b * 6144 + bb * 64 + l] = s; }
        __syncthreads();
    }
}

__device__ __forceinline__ const float* xrow_ptr(const Params& a, int t) { return t < T_P ? a.in[I_XP] + (size_t)t * DM : a.in[I_XS] + (size_t)(t - T_P) * DM; }
__device__ __forceinline__ int batch_of(int t) { return t < T_P ? (t >> 13) : 8; }
__device__ __forceinline__ void st4bf(bf16* p, f32x4 v) { v2u w; w.x = pkbf(v[0], v[1]); w.y = pkbf(v[2], v[3]); *(v2u*)p = w; }
__device__ __forceinline__ f32x4 ld4bf(const bf16* p) { const v2u w = *(const v2u*)p; return (f32x4){__uint_as_float(w.x << 16), __uint_as_float(w.x & 0xffff0000u), __uint_as_float(w.y << 16), __uint_as_float(w.y & 0xffff0000u)}; }

__device__ __forceinline__ void wave_sum2(float& a, float& b) {
#pragma unroll
    for (int o = 1; o < 64; o <<= 1) { const float ta = __shfl_xor(a, o), tb = __shfl_xor(b, o); a += ta; b += tb; }
}
__device__ __forceinline__ float ssq4(f32x4 v) { return (v[0] * v[0] + v[1] * v[1]) + (v[2] * v[2] + v[3] * v[3]); }
#define ROWS_SETUP const int tid = threadIdx.x, lane = tid & 63, wave = __builtin_amdgcn_readfirstlane(tid >> 6); \
    const int NGW = gridDim.x * NWAVES, gw = blockIdx.x * NWAVES + wave, per = ((((R1 - R0) + NGW - 1) / NGW) + 1) & ~1, t_lo = R0 + gw * per, t_hi = min(R1, t_lo + per); (void)tid;
__device__ __forceinline__ void p0b_rows(const Params& a) {
    constexpr int R0 = 0, R1 = TT;
    ROWS_SETUP
    const float* mod = (const float*)(a.ws + WS_MOD); bf16* HB = (bf16*)(a.ws + WS_HB);
    int bcur = -1; f32x4 A0[4], S1[4];
    for (int t = t_lo; t < t_hi; t += 2) {
        const int b = batch_of(t);
        if (b != bcur) { bcur = b;
#pragma unroll
            for (int j = 0; j < 4; ++j) { const int c = 4 * lane + 256 * j; const f32x4 g = *(const f32x4*)(a.in[I_GMIXPRE] + c), sc = *(const f32x4*)(mod + b * 6144 + 1024 + c);
                A0[j] = g * (sc + 1.0f); S1[j] = *(const f32x4*)(mod + b * 6144 + c); } }
        const f32x4* xr = (const f32x4*)xrow_ptr(a, t) + lane; f32x4 v[2][4]; float s0 = 0.f, s1 = 0.f;
#pragma unroll
        for (int j = 0; j < 4; ++j) { v[0][j] = xr[64 * j]; v[1][j] = xr[256 + 64 * j]; }
#pragma unroll
        for (int j = 0; j < 4; ++j) { s0 += ssq4(v[0][j]); s1 += ssq4(v[1][j]); }
        wave_sum2(s0, s1);
        const float r0 = 1.0f / sqrtf(s0 * (1.0f / DM) + EPS), r1 = 1.0f / sqrtf(s1 * (1.0f / DM) + EPS);
#pragma unroll
        for (int j = 0; j < 4; ++j) { st4bf(HB + (size_t)t * DM + 4 * lane + 256 * j, v[0][j] * r0 * A0[j] + S1[j]); st4bf(HB + (size_t)(t + 1) * DM + 4 * lane + 256 * j, v[1][j] * r1 * A0[j] + S1[j]); }
    }
}
__device__ __forceinline__ void p6_rows(const Params& a, int R0, int R1) {
    ROWS_SETUP
    const float* mod = (const float*)(a.ws + WS_MOD); bf16* HB = (bf16*)(a.ws + WS_HB); const bf16* MG = (const bf16*)(a.ws + WS_MG);
    const float* ssm = (const float*)(a.ws + WS_SS) + 3 * (size_t)TT;
    int bcur = -1; f32x4 A1[4], B2[4], S2[4];
    for (int t = t_lo; t < t_hi; t += 2) {
        const int b = batch_of(t);
        if (b != bcur) { bcur = b;
#pragma unroll
            for (int j = 0; j < 4; ++j) { const int c = 4 * lane + 256 * j;
                A1[j] = *(const f32x4*)(mod + b * 6144 + 2048 + c) * *(const f32x4*)(a.in[I_GMIXPOST] + c);
                B2[j] = *(const f32x4*)(a.in[I_GFFNPRE] + c) * (*(const f32x4*)(mod + b * 6144 + 4096 + c) + 1.0f);
                S2[j] = *(const f32x4*)(mod + b * 6144 + 3072 + c); } }
        const float rm0 = 1.0f / sqrtf(ssm[t] * (1.0f / DM) + EPS), rm1 = 1.0f / sqrtf(ssm[t + 1] * (1.0f / DM) + EPS);
        const f32x4* xr = (const f32x4*)xrow_ptr(a, t) + lane; f32x4 v[2][4], mg[2][4]; float s0 = 0.f, s1 = 0.f;
#pragma unroll
        for (int j = 0; j < 4; ++j) { v[0][j] = xr[64 * j]; v[1][j] = xr[256 + 64 * j];
            mg[0][j] = ld4bf(MG + (size_t)t * DM + 4 * lane + 256 * j); mg[1][j] = ld4bf(MG + (size_t)(t + 1) * DM + 4 * lane + 256 * j); }
#pragma unroll
        for (int j = 0; j < 4; ++j) { v[0][j] = v[0][j] + A1[j] * (mg[0][j] * rm0); v[1][j] = v[1][j] + A1[j] * (mg[1][j] * rm1); s0 += ssq4(v[0][j]); s1 += ssq4(v[1][j]); }
        wave_sum2(s0, s1);
        const float r0 = 1.0f / sqrtf(s0 * (1.0f / DM) + EPS), r1 = 1.0f / sqrtf(s1 * (1.0f / DM) + EPS);
        f32x4* orow = (f32x4*)(a.out + (size_t)t * DM) + lane;
#pragma unroll
        for (int j = 0; j < 4; ++j) { orow[64 * j] = v[0][j]; orow[256 + 64 * j] = v[1][j];
            st4bf(HB + (size_t)t * DM + 4 * lane + 256 * j, v[0][j] * r0 * B2[j] + S2[j]); st4bf(HB + (size_t)(t + 1) * DM + 4 * lane + 256 * j, v[1][j] * r1 * B2[j] + S2[j]); }
    }
}
__device__ __forceinline__ void p9_rows(const Params& a, int R0, int R1) {
    ROWS_SETUP
    const float* mod = (const float*)(a.ws + WS_MOD); const bf16* FB = (const bf16*)(a.ws + WS_F);
    const float* ssf = (const float*)(a.ws + WS_SS) + 4 * (size_t)TT;
    int bcur = -1; f32x4 A2[4];
    for (int t = t_lo; t < t_hi; t += 2) {
        const int b = batch_of(t);
        if (b != bcur) { bcur = b;
#pragma unroll
            for (int j = 0; j < 4; ++j) { const int c = 4 * lane + 256 * j; A2[j] = *(const f32x4*)(mod + b * 6144 + 5120 + c) * *(const f32x4*)(a.in[I_GFFNPOST] + c); } }
        const float rf0 = 1.0f / sqrtf(ssf[t] * (1.0f / DM) + EPS), rf1 = 1.0f / sqrtf(ssf[t + 1] * (1.0f / DM) + EPS);
        f32x4* orow = (f32x4*)(a.out + (size_t)t * DM) + lane; f32x4 x1[2][4], f[2][4];
#pragma unroll
        for (int j = 0; j < 4; ++j) { x1[0][j] = orow[64 * j]; x1[1][j] = orow[256 + 64 * j];
            f[0][j] = ld4bf(FB + (size_t)t * DM + 4 * lane + 256 * j); f[1][j] = ld4bf(FB + (size_t)(t + 1) * DM + 4 * lane + 256 * j); }
#pragma unroll
        for (int j = 0; j < 4; ++j) { orow[64 * j] = x1[0][j] + A2[j] * (f[0][j] * rf0); orow[256 + 64 * j] = x1[1][j] + A2[j] * (f[1][j] * rf1); }
    }
}
#undef ROWS_SETUP

__device__ __forceinline__ void pool_phase(const Params& a, LAS unsigned char* lds) {
    const int tid = threadIdx.x, lane = tid & 63, wave = __builtin_amdgcn_readfirstlane(tid >> 6);
    const bf16* U = (const bf16*)(a.ws + WS_U); bf16* MX = (bf16*)(a.ws + WS_MX); const float* ssa = (const float*)(a.ws + WS_SS) + 2 * (size_t)TT;
    LAS float* ps = (LAS float*)lds;
    LAS float* ssl = (LAS float*)(lds + 65536);
    LAS unsigned char* us = lds + 65536 + 1024;
    const int g = wave & 3, half = wave >> 2, d = lane;
    float wreg[64];
#pragma unroll
    for (int c = 0; c < 64; ++c) wreg[c] = a.in[I_POOLW][g * 4096 + c * 64 + d];
    const float pscale = a.in[I_POOLSCALE][64 * g + d];
    for (int tile = blockIdx.x; tile < TT / 64; tile += gridDim.x) {
        const int t0 = tile * 64, sb = t0 < T_P ? (t0 & ~(SEQ_P - 1)) : T_P, se = t0 < T_P ? sb + SEQ_P : TT;
#pragma unroll
        for (int it = 0; it < 5; ++it) { const int idx = tid + NTHREADS * it, rl = idx >> 5, ch8 = idx & 31, tr = t0 - 8 + rl;
            if (tr >= sb && tr < se) *(LAS v4u*)(us + rl * 512 + ch8 * 16) = *(const v4u*)(U + (size_t)tr * POOLW + ch8 * 8); }
        __syncthreads();
#pragma unroll 1
        for (int it = 0; it < 4; ++it) {
            const int idx = tid + NTHREADS * it, tl = idx >> 5, ch8 = idx & 31, t = t0 + tl, w = 2 << (ch8 >> 3);
            const int lo = max(t - (w >> 1), sb), hi = min(t + w - (w >> 1), se);
            float sum[8];
#pragma unroll
            for (int e = 0; e < 8; ++e) sum[e] = 0.f;
            for (int j = lo; j < hi; ++j) { const v4u q = *(const LAS v4u*)(us + (j - t0 + 8) * 512 + ch8 * 16);
#pragma unroll
                for (int e = 0; e < 4; ++e) { sum[2 * e] += __uint_as_float(q[e] << 16); sum[2 * e + 1] += __uint_as_float(q[e] & 0xffff0000u); } }
            const v4u q = *(const LAS v4u*)(us + (tl + 8) * 512 + ch8 * 16); const float inv = 1.0f / (float)(hi - lo);
            f32x4 o0, o1;
#pragma unroll
            for (int e = 0; e < 2; ++e) { o0[2 * e] = sum[2 * e] * inv - __uint_as_float(q[e] << 16); o0[2 * e + 1] = sum[2 * e + 1] * inv - __uint_as_float(q[e] & 0xffff0000u);
                o1[2 * e] = sum[4 + 2 * e] * inv - __uint_as_float(q[2 + e] << 16); o1[2 * e + 1] = sum[5 + 2 * e] * inv - __uint_as_float(q[2 + e] & 0xffff0000u); }
            *(LAS f32x4*)(ps + tl * 256 + ch8 * 8) = o0; *(LAS f32x4*)(ps + tl * 256 + ch8 * 8 + 4) = o1;
        }
        __syncthreads();
        float o[32];
#pragma unroll
        for (int tt = 0; tt < 32; ++tt) { const int tl = half * 32 + tt; float acc = 0.f;
#pragma unroll
            for (int c4 = 0; c4 < 16; ++c4) { const f32x4 pv = *(const LAS f32x4*)(ps + tl * 256 + g * 64 + c4 * 4);
                acc += pv[0] * wreg[4 * c4] + pv[1] * wreg[4 * c4 + 1] + pv[2] * wreg[4 * c4 + 2] + pv[3] * wreg[4 * c4 + 3]; }
            o[tt] = acc * pscale; const float s = wave_sum(o[tt] * o[tt]);
            if (lane == 0) ssl[g * 64 + tl] = s; }
        __syncthreads();
#pragma unroll
        for (int tt = 0; tt < 32; ++tt) { const int tl = half * 32 + tt, t = t0 + tl;
            const float f = sqrtf(ssa[t] * (1.0f / (NH * DV)) + EPS) / sqrtf(((ssl[tl] + ssl[64 + tl]) + (ssl[128 + tl] + ssl[192 + tl])) * (1.0f / POOLW) + EPS);
            MX[(size_t)t * DM + 64 * g + d] = (bf16)(pkbf(o[tt] * f, 0.f) & 0xffffu); }
        __syncthreads();
    }
}
#define XB_TMO      128
#define XB_XCNT(j)  (256  + 64 * (j))
#define XB_XSUB(j)  (1280 + 64 * (j))
#define XB_XGEN(j)  (2304 + 64 * (j))
#define XB_TOP      3328
#define XB_TOPGEN   3392
#define XCD_BAR_WORDS 3456
#define XB_SPIN_CAP (1u << 18)

__device__ __forceinline__ unsigned xb_ld(unsigned* p)              { return __hip_atomic_load(p, __ATOMIC_RELAXED, __HIP_MEMORY_SCOPE_AGENT); }
__device__ __forceinline__ unsigned xb_add(unsigned* p, unsigned v) { return __hip_atomic_fetch_add(p, v, __ATOMIC_RELAXED, __HIP_MEMORY_SCOPE_AGENT); }
__device__ __forceinline__ unsigned xb_xcc_id() { return (unsigned)__builtin_amdgcn_s_getreg((3 << 11) | 20) & 0xFu; }
#define XB_SPIN(cond, bar) do { unsigned _sp = 0; while (cond) { __builtin_amdgcn_s_sleep(1); \
    if ((++_sp & 255u) == 0u) { if (xb_ld(&(bar)[XB_TMO])) break; if (_sp > XB_SPIN_CAP) { atomicAdd(&(bar)[XB_TMO], 1u); break; } } } } while (0)

struct XcdBarrier {
    unsigned* bar; unsigned x;
    volatile LAS unsigned* st;
};

__device__ __forceinline__ XcdBarrier xcd_barrier_post(unsigned* bar, volatile LAS unsigned* st) {
    XcdBarrier b; b.bar = bar; b.x = xb_xcc_id(); b.st = st;
    if (threadIdx.x == 0) (void)xb_add(&bar[XB_XCNT(b.x)], 1u);
    return b;
}
__device__ __forceinline__ void xcd_barrier_complete(unsigned* bar, unsigned x, unsigned& nloc, unsigned& nx) {
    const unsigned G = gridDim.x * gridDim.y * gridDim.z;
    unsigned sum, cnt, mine, sp = 0u;
    for (;;) {
        sum = 0u; cnt = 0u; mine = 0u;
#pragma unroll
        for (unsigned j = 0; j < 16; ++j) { const unsigned c = xb_ld(&bar[XB_XCNT(j)]); sum += c; cnt += (c > 0u) ? 1u : 0u; mine = (j == x) ? c : mine; }
        if (sum == G) break;
        __builtin_amdgcn_s_sleep(1);
        if ((++sp & 255u) == 0u) { if (xb_ld(&bar[XB_TMO])) break; if (sp > XB_SPIN_CAP) { atomicAdd(&bar[XB_TMO], 1u); break; } }
    }
    nloc = mine > 0u ? mine : 1u; nx = cnt > 0u ? cnt : 1u;
}

__device__ __forceinline__ void xcd_barrier(const XcdBarrier& b) {
    asm volatile("s_waitcnt vmcnt(0)" ::: "memory");
    __syncthreads();
    if (threadIdx.x == 0) {
        unsigned* bar = b.bar;
        __builtin_amdgcn_s_waitcnt(0);
        unsigned nloc = b.st[0], nx = b.st[1];
        if (nloc == 0u) { xcd_barrier_complete(bar, b.x, nloc, nx); b.st[0] = nloc; b.st[1] = nx; }
        const unsigned old = xb_add(&bar[XB_XSUB(b.x)], 1u);
        const unsigned gen = old / nloc;
        if (old + 1u == (gen + 1u) * nloc) {
            __builtin_amdgcn_fence(__ATOMIC_RELEASE, "agent");
            asm volatile("s_waitcnt vmcnt(0)" ::: "memory");
            const unsigned og = xb_add(&bar[XB_TOP], 1u);
            const unsigned tg = og / nx;
            if (og + 1u == (tg + 1u) * nx) xb_add(&bar[XB_TOPGEN], 1u);
            else XB_SPIN(xb_ld(&bar[XB_TOPGEN]) == tg, bar);
            __builtin_amdgcn_fence(__ATOMIC_ACQUIRE, "agent");
            xb_add(&bar[XB_XGEN(b.x)], 1u);
            asm volatile("s_waitcnt vmcnt(0)" ::: "memory");
        } else {
            XB_SPIN(xb_ld(&bar[XB_XGEN(b.x)]) == gen, bar);
            __builtin_amdgcn_fence(__ATOMIC_ACQUIRE, "agent");
            asm volatile("s_waitcnt vmcnt(0)" ::: "memory");
        }
    }
    __syncthreads();
}

constexpr int N_PHASES = 11;
__device__ __forceinline__ void attn_phase(const Params& a, unsigned char* lds) {
    const att::bf16_t* Q = (const att::bf16_t*)(a.ws + WS_Q); const att::bf16_t* KN = (const att::bf16_t*)(a.ws + WS_KN); const att::bf16_t* KR = (const att::bf16_t*)(a.ws + WS_KR);
    const att::bf16_t* V = (const att::bf16_t*)(a.ws + WS_V); att::bf16_t* MX = (att::bf16_t*)(a.ws + WS_MX); float* ssa = (float*)(a.ws + WS_SS) + 2 * (size_t)TT;
    const int G = gridDim.x;
    const int x = blockIdx.x & 7, cu = blockIdx.x >> 3;
    const int ns = x < 4 ? 2 : 1, np = x < 4 ? 5 : 7, p0 = x < 4 ? 5 * x : 20 + 7 * (x - 4);
    const int nunits = (G == 256) ? ns + np : ((TT / 256) * NH - (int)blockIdx.x + G - 1) / G;
    for (int i = 0; i < nunits; ++i) {
        int row0, k0, h, seq;
        if (G == 256) {
            if (i < ns) { h = x < 4 ? x : 4 + ((x - 4) >> 1); const int qb = x < 4 ? cu + 32 * i : ((x - 4) & 1) * 32 + cu; row0 = T_P + qb * 256; k0 = T_P; seq = SEQ_S; }
            else { const int p = p0 + (i - ns), sq = p / NH; h = p - sq * NH; row0 = sq * SEQ_P + cu * 256; k0 = sq * SEQ_P; seq = SEQ_P; }
        } else { const int uidx = blockIdx.x + i * G, rb = uidx / NH; h = uidx - rb * NH; row0 = rb * 256; k0 = row0 < T_P ? (row0 & ~(SEQ_P - 1)) : T_P; seq = row0 < T_P ? SEQ_P : SEQ_S; }
        att::attn_unit(Q + (size_t)row0 * LDQ_ + h * DQK, KN + (size_t)k0 * LDKV_ + h * DNOPE, KR + (size_t)k0 * DROPE, V + (size_t)k0 * LDKV_ + h * DV,
                       MX + (size_t)row0 * DM + POOLW + h * DV, ssa + row0, seq, (char*)lds);
    }
}


constexpr int H_SPLIT = 128 * 256;
template <int WHICH> struct HookOrder : pg8::StaticOrder {
    const Params* ap; int tpm, tpn, R0, R1;
    __device__ __forceinline__ void done(const pg8::Unit& u) const {
        if (u.pm == tpm && u.pn == tpn) { if (WHICH == 0) p6_rows(*ap, R0, R1); else p9_rows(*ap, R0, R1); asm volatile("s_waitcnt vmcnt(0)" ::: "memory"); }
    }
};

__global__ void __launch_bounds__(NTHREADS, 2) enc_fwd(Params a) {
    extern __shared__ __attribute__((aligned(16))) unsigned char lds_raw[];
    LAS unsigned char* lds = (LAS unsigned char*)lds_raw;
    const int lo = a.ph_lo, hi = a.ph_hi, G = gridDim.x;
    unsigned char* ws = a.ws;
    float* SS = (float*)(ws + WS_SS);
#define IN(k) (lo <= (k) && (k) < hi)
    unsigned* barw = (unsigned*)(ws + WS_BAR);
    volatile LAS unsigned* MISC = (volatile LAS unsigned*)(lds + MISC_OFF);
    if (threadIdx.x < 16) MISC[threadIdx.x] = 0u;
    if (IN(0) && IN(1) && blockIdx.x == 0) for (int i = threadIdx.x; i < XCD_BAR_WORDS; i += NTHREADS) barw[i] = 0u;
    __syncthreads();
    XcdBarrier xb; xb.bar = barw; xb.x = 0; xb.st = MISC + 8;
#define SEAM(k) do { if (IN(k) && IN((k) + 1)) { if ((k) == 0) { cg::this_grid().sync(); xb = xcd_barrier_post(barw, MISC + 8); } else xcd_barrier(xb); } } while (0)
    if (IN(0)) { p0a_prologue(a, lds); } SEAM(0);
    if (IN(1)) { p0b_rows(a); } SEAM(1);
    if (IN(2)) {
        pg8::Gemm g{(const pg8::bf16_t*)(ws + WS_HB), (const pg8::bf16_t*)(ws + WS_WIN), TT, 1024, DM}; pg8::StaticOrder S; S.init(TT, 1024, G, (int)blockIdx.x);
        pg8::EpiZ E{(pg8::bf16_t*)(ws + WS_U), (pg8::bf16_t*)(ws + WS_CQ), (pg8::bf16_t*)(ws + WS_CKV), (pg8::bf16_t*)(ws + WS_KR), SS, SS + TT, (const float*)(ws + WS_ROPE)};
        pg8::gemm_phase<pg8::EpiZ, pg8::StaticOrder, true, true>(lds, g, S, E);
    } SEAM(2);
    if (IN(3)) {
        { pg8::Gemm g{(const pg8::bf16_t*)(ws + WS_CQ), (const pg8::bf16_t*)(ws + WS_WUQ), TT, 1280, QLR}; pg8::StaticOrder S; S.init(TT, 1280, G, (int)blockIdx.x);
          pg8::EpiQ E{(pg8::bf16_t*)(ws + WS_Q), SS, (const float*)(ws + WS_ROPE)};
          pg8::gemm_phase<pg8::EpiQ, pg8::StaticOrder, true, true>(lds, g, S, E); }
        { pg8::Gemm g{(const pg8::bf16_t*)(ws + WS_CKV), (const pg8::bf16_t*)(ws + WS_WUKV), TT, 1536, KVLR}; pg8::StaticOrder S; S.init(TT, 1536, G, (int)blockIdx.x);
          pg8::EpiKV E{(pg8::bf16_t*)(ws + WS_KN), (pg8::bf16_t*)(ws + WS_V), SS + TT};
          pg8::gemm_phase<pg8::EpiKV, pg8::StaticOrder, true, true>(lds, g, S, E); }
    } SEAM(3);
    if (IN(4)) { attn_phase(a, lds_raw); } SEAM(4);
    if (IN(5)) { pool_phase(a, lds); } SEAM(5);
    if (IN(6)) {
        pg8::Gemm g{(const pg8::bf16_t*)(ws + WS_MX), (const pg8::bf16_t*)(ws + WS_WOUT), TT, DM, DM}; pg8::StaticOrder S; S.init(TT, DM, G, (int)blockIdx.x);
        pg8::EpiRowScaleSS E{(pg8::bf16_t*)(ws + WS_MG), SS + 2 * (size_t)TT, 1.0f / (NH * DV), SS + 3 * (size_t)TT};
        pg8::gemm_phase<pg8::EpiRowScaleSS, pg8::StaticOrder, true, true>(lds, g, S, E);
    } SEAM(6);
    if (IN(7)) { p6_rows(a, 0, H_SPLIT); } SEAM(7);
    if (IN(8)) {
        pg8::Gemm g{(const pg8::bf16_t*)(ws + WS_HB), (const pg8::bf16_t*)(ws + WS_WGU), H_SPLIT, 2 * DFF, DM};
        HookOrder<0> S; S.init(H_SPLIT, 2 * DFF, G, (int)blockIdx.x); S.ap = &a; S.R0 = H_SPLIT; S.R1 = TT;
        { pg8::Unit tu; const int nfull = S.nwg / G; if (nfull > 0 && S.next((int)blockIdx.x % nfull, tu)) { S.tpm = tu.pm; S.tpn = tu.pn; } else { S.tpm = -1; S.tpn = -1; p6_rows(a, H_SPLIT, TT); } }
        pg8::EpiGU E{(pg8::bf16_t*)(ws + WS_ACT)};
        pg8::gemm_phase<pg8::EpiGU, HookOrder<0>, true, true>(lds, g, S, E);
    } SEAM(8);
    if (IN(9)) {
        { pg8::Gemm g{(const pg8::bf16_t*)(ws + WS_HB) + (size_t)H_SPLIT * DM, (const pg8::bf16_t*)(ws + WS_WGU), TT - H_SPLIT, 2 * DFF, DM}; pg8::StaticOrder S; S.init(TT - H_SPLIT, 2 * DFF, G, (int)blockIdx.x);
          pg8::EpiGU E{(pg8::bf16_t*)(ws + WS_ACT) + (size_t)H_SPLIT * DFF};
          pg8::gemm_phase<pg8::EpiGU, pg8::StaticOrder, true, true>(lds, g, S, E); }
        { pg8::Gemm g{(const pg8::bf16_t*)(ws + WS_ACT), (const pg8::bf16_t*)(ws + WS_WD), H_SPLIT, DM, DFF}; pg8::StaticOrder S; S.init(H_SPLIT, DM, G, (int)blockIdx.x);
          pg8::EpiRowScaleSS E{(pg8::bf16_t*)(ws + WS_F), nullptr, 0.f, SS + 4 * (size_t)TT};
          pg8::gemm_phase<pg8::EpiRowScaleSS, pg8::StaticOrder, true, true>(lds, g, S, E); }
    } SEAM(9);
    if (IN(10)) {
        pg8::Gemm g{(const pg8::bf16_t*)(ws + WS_ACT) + (size_t)H_SPLIT * DFF, (const pg8::bf16_t*)(ws + WS_WD), TT - H_SPLIT, DM, DFF};
        HookOrder<1> S; S.init(TT - H_SPLIT, DM, G, (int)blockIdx.x); S.ap = &a; S.R0 = 0; S.R1 = H_SPLIT;
        { pg8::Unit tu; const int nfull = S.nwg / G; if (nfull > 0 && S.next((int)blockIdx.x % nfull, tu)) { S.tpm = tu.pm; S.tpn = tu.pn; } else { S.tpm = -1; S.tpn = -1; p9_rows(a, 0, H_SPLIT); } }
        pg8::EpiRowScaleSS E{(pg8::bf16_t*)(ws + WS_F) + (size_t)H_SPLIT * DM, nullptr, 0.f, SS + 4 * (size_t)TT + H_SPLIT};
        pg8::gemm_phase<pg8::EpiRowScaleSS, HookOrder<1>, true, true>(lds, g, S, E);
    } SEAM(10);
    if (IN(11)) { p9_rows(a, H_SPLIT, TT); }
#undef IN
#undef SEAM
}

extern "C" void kernel_launch(void* const* d_in, const int* in_sizes, int n_in, void* d_out, int out_size, void* d_ws, size_t ws_size, hipStream_t stream) {
    static int grid = 0;
    if (grid == 0) {
        if (n_in != 23 || out_size != TT * DM || ws_size < WS_END) { fprintf(stderr, "kernel_launch: unexpected shapes: n_in %d out %d ws %zu (need %zu)\n", n_in, out_size, ws_size, (size_t)WS_END); grid = -1; return; }
        int dev = 0, cus = 0, per_cu = 0;
        if (hipGetDevice(&dev) != hipSuccess || hipDeviceGetAttribute(&cus, hipDeviceAttributeMultiprocessorCount, dev) != hipSuccess) { grid = -1; return; }
        if (hipFuncSetAttribute((const void*)enc_fwd, hipFuncAttributeMaxDynamicSharedMemorySize, LDS_BYTES) != hipSuccess) { fprintf(stderr, "kernel_launch: hipFuncSetAttribute failed\n"); grid = -1; return; }
        if (hipOccupancyMaxActiveBlocksPerMultiprocessor(&per_cu, (const void*)enc_fwd, NTHREADS, LDS_BYTES) != hipSuccess || per_cu < 1) per_cu = 1;
        (void)hipGetLastError();
        grid = cus;
    }
    if (grid < 0) return;
    Params p{};
    for (int i = 0; i < 23; ++i) p.in[i] = (const float*)d_in[i];
    p.out = (float*)d_out; p.ws = (unsigned char*)d_ws;
#if MK_PER_PHASE
    for (int ph = 0; ph <= N_PHASES; ++ph) { p.ph_lo = ph; p.ph_hi = ph + 1; hipLaunchKernelGGL(enc_fwd, dim3(grid), dim3(NTHREADS), LDS_BYTES, stream, p); }
#else
    p.ph_lo = 0; p.ph_hi = N_PHASES + 1;
    void* args[] = {&p};
    hipError_t e = hipLaunchCooperativeKernel((const void*)enc_fwd, dim3(grid), dim3(NTHREADS), args, LDS_BYTES, stream);
    if (e != hipSuccess) fprintf(stderr, "kernel_launch: cooperative launch failed: %s (grid %d)\n", hipGetErrorString(e), grid);
#endif
}
```
